# Optimizing an MI355X kernel written in HIP

```python
import math
import jax, jax.numpy as jnp
from jax import lax
import numpy as np

D_MODEL = 1024
BATCH = 8
SEQ = 4096
DEPTH = 1

D_MIX = D_MODEL
ATTN_WIDTH = D_MIX // 2
N_DIFF_HEADS = 4
DIFF_HEAD_DIM = ATTN_WIDTH // (2 * N_DIFF_HEADS)
DIFF_V_DIM = 2 * DIFF_HEAD_DIM
ATTN_QK = N_DIFF_HEADS * 2 * DIFF_HEAD_DIM
POOL_WIDTH = D_MIX - ATTN_WIDTH
POOL_WINDOWS = (2, 4, 8, 16)
N_POOL_GROUPS = len(POOL_WINDOWS)
POOL_GROUP_DIM = POOL_WIDTH // N_POOL_GROUPS
D_IN_PROJ = 2 * ATTN_QK + ATTN_WIDTH + POOL_WIDTH

ROPE_THETA = 500000.0
ROPE_DIM = DIFF_HEAD_DIM // 4
Q_BLOCK = 128

N_EXPERTS = 32
TOP_K = 4
D_EXPERT = D_MODEL
SWIGLU_LIMIT = 7.0
SWIGLU_ALPHA = 1.702
MOE_BLOCK = 128

PLE_DIM = 256
EPS = 1e-6

kernel_name = "hybrid_diffattn_pool_moe_ple"


def rms_norm(t, g):
    tf = t.astype(jnp.float32)
    y = tf * lax.rsqrt(jnp.mean(tf * tf, axis=-1, keepdims=True) + EPS)
    return (y * g.astype(jnp.float32)).astype(t.dtype)


def apply_partial_rope(t, cos, sin):
    tf = t.astype(jnp.float32)
    half = ROPE_DIM // 2
    t1 = tf[..., :half]
    t2 = tf[..., half:ROPE_DIM]
    out = jnp.concatenate([t1 * cos - t2 * sin, t2 * cos + t1 * sin, tf[..., ROPE_DIM:]], axis=-1)
    return out.astype(t.dtype)


def diff_attention(q, k, v, positions, q_norm, k_norm, lam_q1, lam_k1, lam_q2, lam_k2, subln, lambda_init):
    B, S, _ = q.shape
    H, d = N_DIFF_HEADS, DIFF_HEAD_DIM
    q = rms_norm(q.reshape(B, S, H, 2, d), q_norm)
    k = rms_norm(k.reshape(B, S, H, 2, d), k_norm)
    v = v.reshape(B, S, H, DIFF_V_DIM)
    freqs = ROPE_THETA ** (-jnp.arange(0, ROPE_DIM, 2, dtype=jnp.float32) / ROPE_DIM)
    ang = positions.astype(jnp.float32)[..., None] * freqs
    cos = jnp.cos(ang)[:, :, None, None, :]
    sin = jnp.sin(ang)[:, :, None, None, :]
    q = apply_partial_rope(q, cos, sin)
    k = apply_partial_rope(k, cos, sin)
    lam = (jnp.exp(jnp.sum(lam_q1.astype(jnp.float32) * lam_k1.astype(jnp.float32)))
           - jnp.exp(jnp.sum(lam_q2.astype(jnp.float32) * lam_k2.astype(jnp.float32)))
           + lambda_init)
    scale = 1.0 / math.sqrt(d)
    nb = S // Q_BLOCK
    qb = q.transpose(0, 2, 3, 1, 4).reshape(B, H, 2, nb, Q_BLOCK, d)
    qb = jnp.moveaxis(qb, 3, 0)
    kt = k.transpose(0, 2, 3, 1, 4)
    vt = v.transpose(0, 2, 1, 3)
    key_idx = jnp.arange(S)

    def block(args):
        qblk, start = args
        s = jnp.einsum('bhcqd,bhckd->bhcqk', qblk, kt).astype(jnp.float32) * scale
        q_idx = start + jnp.arange(Q_BLOCK)
        mask = key_idx[None, :] <= q_idx[:, None]
        s = jnp.where(mask, s, -jnp.inf)
        a = jax.nn.softmax(s, axis=-1)
        w = a[:, :, 0] - lam * a[:, :, 1]
        return jnp.einsum('bhqk,bhkv->bhqv', w.astype(vt.dtype), vt)

    starts = jnp.arange(nb) * Q_BLOCK
    o = lax.map(block, (qb, starts))
    o = o.transpose(1, 0, 3, 2, 4).reshape(B, S, H, DIFF_V_DIM)
    o = rms_norm(o, subln) * (1.0 - lambda_init)
    return o.reshape(B, S, H * DIFF_V_DIM)


def pool_mixer(u, w_pool, pool_scale):
    B, S, _ = u.shape
    ug = u.reshape(B, S, N_POOL_GROUPS, POOL_GROUP_DIM)
    t_idx = jnp.arange(S)
    outs = []
    for g, w in enumerate(POOL_WINDOWS):
        uf = ug[:, :, g].astype(jnp.float32)
        cs = jnp.cumsum(uf, axis=1)
        shifted = jnp.pad(cs, ((0, 0), (w, 0), (0, 0)))[:, :S]
        count = jnp.minimum(t_idx + 1, w).astype(jnp.float32)
        outs.append((cs - shifted) / count[None, :, None] - uf)
    pooled = jnp.stack(outs, axis=2).astype(u.dtype)
    y = jnp.einsum('bsgc,gcd->bsgd', pooled, w_pool)
    return y.reshape(B, S, POOL_WIDTH) * pool_scale


def moe(xn, w_router, b_router, w_gate, b_gate, w_up, b_up, w_down, b_down):
    B, S, D = xn.shape
    N = B * S
    xt = xn.reshape(N, D)
    logits = (xt @ w_router).astype(jnp.float32) + b_router.astype(jnp.float32)
    top_vals, top_idx = lax.top_k(logits, TOP_K)
    gates = jax.nn.softmax(top_vals, axis=-1).astype(xn.dtype)
    NK = N * TOP_K
    expert_flat = top_idx.reshape(NK)
    token_flat = jnp.repeat(jnp.arange(N), TOP_K)
    gate_flat = gates.reshape(NK)
    order = jnp.argsort(expert_flat, stable=True)
    se = expert_flat[order]
    st = token_flat[order]
    sg = gate_flat[order]
    counts = jnp.bincount(expert_flat, length=N_EXPERTS)
    padded = ((counts + MOE_BLOCK - 1) // MOE_BLOCK) * MOE_BLOCK
    pend = jnp.cumsum(padded)
    pstart = pend - padded
    start = jnp.cumsum(counts) - counts
    dest = pstart[se] + (jnp.arange(NK) - start[se])
    n_blocks = -(-NK // MOE_BLOCK) + N_EXPERTS
    P = n_blocks * MOE_BLOCK
    xbuf = jnp.zeros((P, D), xn.dtype).at[dest].set(xt[st])
    block_expert = jnp.clip(jnp.searchsorted(pend, jnp.arange(n_blocks) * MOE_BLOCK, side='right'),
                            0, N_EXPERTS - 1)

    def expert_block(args):
        xb, e = args
        gt = xb @ w_gate[e] + b_gate[e]
        up = xb @ w_up[e] + b_up[e]
        gt = jnp.minimum(gt, SWIGLU_LIMIT)
        up = jnp.clip(up, -SWIGLU_LIMIT, SWIGLU_LIMIT)
        hdn = (up + 1.0) * (gt * jax.nn.sigmoid(SWIGLU_ALPHA * gt))
        return hdn @ w_down[e] + b_down[e]

    ybuf = lax.map(expert_block, (xbuf.reshape(n_blocks, MOE_BLOCK, D), block_expert)).reshape(P, D)
    y = ybuf[dest] * sg[:, None]
    out = jnp.zeros((N, D), xn.dtype).at[st].add(y)
    return out.reshape(B, S, D)


def setup_inputs(seed: int = 0) -> dict:
    key = jax.random.key(seed)
    ks = jax.random.split(key, 32)
    f32 = jnp.float32
    L = DEPTH

    def nrm(k, shape, scale):
        return jax.random.normal(k, shape, f32) * scale

    def gain(k, shape):
        return 1.0 + 0.02 * jax.random.normal(k, shape, f32)

    x = jax.random.normal(ks[0], (BATCH, SEQ, D_MODEL), f32)
    p = jax.random.normal(ks[1], (DEPTH, BATCH, SEQ, PLE_DIM), f32)
    offsets = jax.random.randint(ks[2], (BATCH, 1), 0, SEQ, dtype=jnp.int32)
    positions = (offsets + jnp.arange(SEQ, dtype=jnp.int32)[None, :]).astype(jnp.int32)
    return {
        "x": x,
        "p": p,
        "positions": positions,
        "attn_norm": gain(ks[3], (L, D_MODEL)),
        "w_in": nrm(ks[4], (L, D_MODEL, D_IN_PROJ), D_MODEL ** -0.5),
        "q_norm": gain(ks[5], (L, DIFF_HEAD_DIM)),
        "k_norm": gain(ks[6], (L, DIFF_HEAD_DIM)),
        "lam_q1": nrm(ks[7], (L, DIFF_HEAD_DIM), 0.1),
        "lam_k1": nrm(ks[8], (L, DIFF_HEAD_DIM), 0.1),
        "lam_q2": nrm(ks[9], (L, DIFF_HEAD_DIM), 0.1),
        "lam_k2": nrm(ks[10], (L, DIFF_HEAD_DIM), 0.1),
        "subln": gain(ks[11], (L, DIFF_V_DIM)),
        "w_pool": nrm(ks[12], (L, N_POOL_GROUPS, POOL_GROUP_DIM, POOL_GROUP_DIM), POOL_GROUP_DIM ** -0.5),
        "pool_scale": gain(ks[13], (L, POOL_WIDTH)),
        "w_out": nrm(ks[14], (L, D_MIX, D_MODEL), D_MIX ** -0.5),
        "ffn_norm": gain(ks[15], (L, D_MODEL)),
        "w_router": nrm(ks[16], (L, D_MODEL, N_EXPERTS), D_MODEL ** -0.5),
        "b_router": nrm(ks[17], (L, N_EXPERTS), 0.01),
        "w_gate": nrm(ks[18], (L, N_EXPERTS, D_MODEL, D_EXPERT), D_MODEL ** -0.5),
        "b_gate": nrm(ks[19], (L, N_EXPERTS, D_EXPERT), 0.02),
        "w_up": nrm(ks[20], (L, N_EXPERTS, D_MODEL, D_EXPERT), D_MODEL ** -0.5),
        "b_up": nrm(ks[21], (L, N_EXPERTS, D_EXPERT), 0.02),
        "w_down": nrm(ks[22], (L, N_EXPERTS, D_EXPERT, D_MODEL), D_EXPERT ** -0.5),
        "b_down": nrm(ks[23], (L, N_EXPERTS, D_MODEL), 0.02),
        "ple_gate_norm": gain(ks[24], (L, D_MODEL)),
        "w_ple_gate": nrm(ks[25], (L, D_MODEL, D_MODEL), D_MODEL ** -0.5),
        "w_ple_proj": nrm(ks[26], (L, PLE_DIM, D_MODEL), PLE_DIM ** -0.5),
        "ple_post_norm": gain(ks[27], (L, D_MODEL)),
    }


def reference(x, p, positions, attn_norm, w_in, q_norm, k_norm, lam_q1, lam_k1, lam_q2, lam_k2,
              subln, w_pool, pool_scale, w_out, ffn_norm, w_router, b_router, w_gate, b_gate,
              w_up, b_up, w_down, b_down, ple_gate_norm, w_ple_gate, w_ple_proj, ple_post_norm):
    h = x
    for i in range(DEPTH):
        lambda_init = 0.8 - 0.6 * math.exp(-0.3 * i)
        hn = rms_norm(h, attn_norm[i])
        z = hn @ w_in[i]
        q = z[..., :ATTN_QK]
        k = z[..., ATTN_QK:2 * ATTN_QK]
        v = z[..., 2 * ATTN_QK:2 * ATTN_QK + ATTN_WIDTH]
        u = z[..., 2 * ATTN_QK + ATTN_WIDTH:]
        a_out = diff_attention(q, k, v, positions, q_norm[i], k_norm[i], lam_q1[i], lam_k1[i],
                               lam_q2[i], lam_k2[i], subln[i], lambda_init)
        p_out = pool_mixer(u, w_pool[i], pool_scale[i])
        h = h + jnp.concatenate([a_out, p_out], axis=-1) @ w_out[i]
        h = h + moe(rms_norm(h, ffn_norm[i]), w_router[i], b_router[i], w_gate[i], b_gate[i],
                    w_up[i], b_up[i], w_down[i], b_down[i])
        gate = jax.nn.sigmoid(rms_norm(h, ple_gate_norm[i]) @ w_ple_gate[i])
        e = rms_norm(p[i].astype(h.dtype) @ w_ple_proj[i], ple_post_norm[i])
        h = h + gate * e
    return h
```

```cpp
#include <hip/hip_runtime.h>
#include <hip/hip_cooperative_groups.h>
#include <hip/hip_bf16.h>
#include <cstdio>
#include <cstdint>
#include <cmath>
namespace cg = cooperative_groups;


namespace pg8 {
#define PG8_LAS __attribute__((address_space(3)))
typedef unsigned short bf16_t;
typedef short bf16x8 __attribute__((ext_vector_type(8)));
typedef float f32x4 __attribute__((ext_vector_type(4)));
typedef float f32x2 __attribute__((ext_vector_type(2)));
typedef unsigned u32x4 __attribute__((ext_vector_type(4)));
typedef unsigned u32x2 __attribute__((ext_vector_type(2)));
constexpr int BM = 256, BK = 64, HALF = 128, HTB = HALF * BK * 2, STAGE_BYTES = 8 * HTB, NXCD = 8, WGM = 8;

__host__ __device__ __forceinline__ int lds_byte(int r, int c) { const int st = (r >> 4) * 2 + (c >> 5), rr = r & 15, cc = c & 31, ob = rr * 64 + cc * 2; return st * 1024 + (ob ^ (((ob >> 9) & 1) << 5)); }
__host__ __device__ __forceinline__ void stage_rc(int b, int& R, int& C) { const int st = b / 1024, sb = b % 1024, swz = sb ^ (((sb >> 9) & 1) << 5); R = (st >> 1) * 16 + swz / 64; C = (st & 1) * 32 + (swz % 64) / 2; }
__host__ __device__ __forceinline__ int perm32(int rho) { const int n = rho >> 4, i = rho & 15; return 8 * (i >> 2) + 4 * n + (i & 3); }

struct Unit { int ta, tb, pm, pn, e, nv, ord; };
struct Gemm { const bf16_t* A; const bf16_t* Bt; int K; const PG8_LAS unsigned short* urow; };

struct StaticOrder {
    int nM, nN, nwg, G, c;
    __host__ __device__ void init(int M, int N, int G_, int c_) { nM = M / BM; nN = N / BM; nwg = nM * nN; G = G_; c = c_; }
    __host__ __device__ bool next(int i, Unit& u) const {
        const long L = (long)i * G + c; if (L >= nwg) return false;
        int wgid = (int)L; { const int q = nwg / NXCD, r = nwg % NXCD, xcd = wgid % NXCD, off = wgid / NXCD; wgid = (xcd < r ? xcd * (q + 1) : r * (q + 1) + (xcd - r) * q) + off; }
        const int nig = WGM * nN, gid = wgid / nig, fm = gid * WGM, gsz = (nM - fm) < WGM ? (nM - fm) : WGM;
        u.pm = fm + ((wgid % nig) % gsz); u.pn = (wgid % nig) / gsz; u.ta = u.pm; u.tb = u.pn; u.e = 0; u.nv = 256; u.ord = i; return true;
    }
};

__device__ __forceinline__ unsigned cvt_pk_bf16(float lo, float hi) { unsigned r; asm volatile("v_cvt_pk_bf16_f32 %0, %1, %2" : "=v"(r) : "v"(lo), "v"(hi)); return r; }

struct EpiBf16 {
    static constexpr bool PERM = true;
    bf16_t* O; int ldc; const float* bias; int split_cols; size_t split_stride; float* ss;
    __device__ __forceinline__ void operator()(const f32x4 (&acc)[2][2][4][2], const Unit& u, int wr, int wc, int fr, int fq) const {
        const int row0 = u.pm * BM + wr * 64 + fr; int colt = u.pn * BM; bf16_t* base = O;
        if (split_cols) { const int t = colt / split_cols; base += (size_t)t * split_stride; colt -= t * split_cols; }
        const int col0 = colt + wc * 32 + 8 * fq, bcol0 = u.pn * BM + wc * 32 + 8 * fq;
        f32x4 bv[2][2];
#pragma unroll
        for (int bj = 0; bj < 2; ++bj)
#pragma unroll
            for (int n = 0; n < 2; ++n) bv[bj][n] = bias ? *(const f32x4*)(bias + bcol0 + bj * HALF + 4 * n) : (f32x4){0.f, 0.f, 0.f, 0.f};
#pragma unroll
        for (int ai = 0; ai < 2; ++ai)
#pragma unroll
            for (int m = 0; m < 4; ++m) { bf16_t* rowp = base + (size_t)(row0 + ai * HALF + m * 16) * ldc + col0;
                float q = 0.f;
#pragma unroll
                for (int bj = 0; bj < 2; ++bj) { f32x4 v0 = acc[ai][bj][m][0] + bv[bj][0], v1 = acc[ai][bj][m][1] + bv[bj][1];
                    q += (v0[0] * v0[0] + v0[1] * v0[1]) + (v0[2] * v0[2] + v0[3] * v0[3]) + (v1[0] * v1[0] + v1[1] * v1[1]) + (v1[2] * v1[2] + v1[3] * v1[3]);
                    u32x4 w; w.x = cvt_pk_bf16(v0[0], v0[1]); w.y = cvt_pk_bf16(v0[2], v0[3]); w.z = cvt_pk_bf16(v1[0], v1[1]); w.w = cvt_pk_bf16(v1[2], v1[3]);
                    *(u32x4*)(rowp + bj * HALF) = w; }
                if (ss) { q += __shfl_xor(q, 16); q += __shfl_xor(q, 32); if (fq == 0) atomicAdd(ss + row0 + ai * HALF + m * 16, q); } }
    }
};
struct EpiQKVU {
    static constexpr bool PERM = true;
    bf16_t* QK; bf16_t* VU; const float* cs; const float* qn; const float* kn; float c2;
    __device__ __forceinline__ void operator()(const f32x4 (&acc)[2][2][4][2], const Unit& u, int wr, int wc, int fr, int fq) const {
        const int row0 = u.pm * BM + wr * 64 + fr, tcol = 64 * wc + 8 * fq;
        if (u.pn >= 4) {
#pragma unroll
            for (int ai = 0; ai < 2; ++ai)
#pragma unroll
                for (int m = 0; m < 4; ++m) { bf16_t* rowp = VU + (size_t)(row0 + ai * HALF + m * 16) * 1024 + (u.pn - 4) * BM + tcol;
#pragma unroll
                    for (int bj = 0; bj < 2; ++bj) { const f32x4 v0 = acc[ai][bj][m][0], v1 = acc[ai][bj][m][1];
                        u32x4 w; w.x = cvt_pk_bf16(v0[0], v0[1]); w.y = cvt_pk_bf16(v0[2], v0[3]); w.z = cvt_pk_bf16(v1[0], v1[1]); w.w = cvt_pk_bf16(v1[2], v1[3]);
                        *(u32x4*)(rowp + 32 * bj) = w; } }
        } else {
            const bool isq = u.pn < 2; const float* gn = isq ? qn : kn; const float osc = isq ? c2 : 1.0f;
            f32x4 g4[2][2];
#pragma unroll
            for (int bj = 0; bj < 2; ++bj)
#pragma unroll
                for (int n = 0; n < 2; ++n) g4[bj][n] = *(const f32x4*)(gn + 32 * bj + 8 * fq + 4 * n);
#pragma unroll
            for (int ai = 0; ai < 2; ++ai)
#pragma unroll
                for (int m = 0; m < 4; ++m) { const int row = row0 + ai * HALF + m * 16;
                    f32x4 v[2][2]; float ss = 0.f;
#pragma unroll
                    for (int bj = 0; bj < 2; ++bj)
#pragma unroll
                        for (int n = 0; n < 2; ++n) { v[bj][n] = acc[ai][bj][m][n]; ss += (v[bj][n][0] * v[bj][n][0] + v[bj][n][1] * v[bj][n][1]) + (v[bj][n][2] * v[bj][n][2] + v[bj][n][3] * v[bj][n][3]); }
                    ss += __shfl_xor(ss, 16); ss += __shfl_xor(ss, 32);
                    const float r = 1.0f / sqrtf(ss * (1.f / 64.f) + 1e-6f);
#pragma unroll
                    for (int bj = 0; bj < 2; ++bj)
#pragma unroll
                        for (int n = 0; n < 2; ++n) v[bj][n] = v[bj][n] * g4[bj][n] * r;
#pragma unroll
                    for (int n = 0; n < 2; ++n) { const f32x4 c4 = *(const f32x4*)(cs + (size_t)row * 16 + 4 * n), s4 = *(const f32x4*)(cs + (size_t)row * 16 + 8 + 4 * n);
#pragma unroll
                        for (int j = 0; j < 4; ++j) { const float pv = __shfl_xor(v[0][n][j], 16); const float sg = (fq == 0) ? -s4[j] : s4[j];
                            if (fq < 2) v[0][n][j] = v[0][n][j] * c4[j] + pv * sg; } }
                    bf16_t* rowp = QK + (size_t)row * 1024 + u.pn * BM + tcol;
#pragma unroll
                    for (int bj = 0; bj < 2; ++bj) { const f32x4 v0 = v[bj][0] * osc, v1 = v[bj][1] * osc;
                        u32x4 w; w.x = cvt_pk_bf16(v0[0], v0[1]); w.y = cvt_pk_bf16(v0[2], v0[3]); w.z = cvt_pk_bf16(v1[0], v1[1]); w.w = cvt_pk_bf16(v1[2], v1[3]);
                        *(u32x4*)(rowp + 32 * bj) = w; } }
        }
    }
};
__device__ __forceinline__ float swiglu1(float g, float u) {
    g = fminf(g, 7.0f); u = fminf(fmaxf(u, -7.0f), 7.0f);
    const float sg = __builtin_amdgcn_rcpf(1.0f + __builtin_amdgcn_exp2f(-1.702f * 1.4426950408889634f * g));
    return (u + 1.0f) * (g * sg);
}
__device__ __forceinline__ unsigned pk4_fp8(float a, float b, float c, float d) { int w = 0; w = __builtin_amdgcn_cvt_pk_fp8_f32(a, b, w, false); w = __builtin_amdgcn_cvt_pk_fp8_f32(c, d, w, true); return (unsigned)w; }
struct EpiSwiglu {
    static constexpr bool PERM = true;
    unsigned char* H; const PG8_LAS float* ub;
    __device__ __forceinline__ void operator()(const f32x4 (&acc)[2][2][4][2], const Unit& u, int wr, int wc, int fr, int fq) const {
        const int row0 = u.pm * BM + wr * 64 + fr, hcol0 = u.pn * HALF + wc * 32 + 8 * fq;
        f32x4 g4[2], u4[2];
#pragma unroll
        for (int n = 0; n < 2; ++n) { g4[n] = *(const PG8_LAS f32x4*)(ub + u.ord * 256 + wc * 32 + 8 * fq + 4 * n); u4[n] = *(const PG8_LAS f32x4*)(ub + u.ord * 256 + 128 + wc * 32 + 8 * fq + 4 * n); }
#pragma unroll
        for (int ai = 0; ai < 2; ++ai)
#pragma unroll
            for (int m = 0; m < 4; ++m) { unsigned char* rowp = H + (size_t)(row0 + ai * HALF + m * 16) * 1024 + hcol0;
                float h[8];
#pragma unroll
                for (int n = 0; n < 2; ++n) { const f32x4 gv = acc[ai][0][m][n] * 0.03125f + g4[n], uv = acc[ai][1][m][n] * 0.03125f + u4[n];
#pragma unroll
                    for (int j = 0; j < 4; ++j) h[4 * n + j] = swiglu1(gv[j], uv[j]); }
                u32x2 w; w.x = pk4_fp8(h[0], h[1], h[2], h[3]); w.y = pk4_fp8(h[4], h[5], h[6], h[7]);
                *(u32x2*)rowp = w; }
    }
};
struct EpiDown {
    static constexpr bool PERM = true;
    unsigned char* Y; const PG8_LAS float* ub;
    __device__ __forceinline__ void operator()(const f32x4 (&acc)[2][2][4][2], const Unit& u, int wr, int wc, int fr, int fq) const {
        const int col0 = u.pn * BM + wc * 32 + 8 * fq;
        f32x4 bv[2][2];
#pragma unroll
        for (int bj = 0; bj < 2; ++bj)
#pragma unroll
            for (int n = 0; n < 2; ++n) bv[bj][n] = *(const PG8_LAS f32x4*)(ub + u.ord * 256 + wc * 32 + 8 * fq + bj * HALF + 4 * n);
#pragma unroll
        for (int ai = 0; ai < 2; ++ai)
#pragma unroll
            for (int m = 0; m < 4; ++m) { const int r = wr * 64 + fr + ai * HALF + m * 16; unsigned char* rowp = Y + (size_t)(u.pm + r) * 1024 + col0;
                if (r < u.nv) {
#pragma unroll
                    for (int bj = 0; bj < 2; ++bj) { f32x4 v0 = acc[ai][bj][m][0] * 0.03125f + bv[bj][0], v1 = acc[ai][bj][m][1] * 0.03125f + bv[bj][1];
                        u32x2 w; w.x = pk4_fp8(v0[0], v0[1], v0[2], v0[3]); w.y = pk4_fp8(v1[0], v1[1], v1[2], v1[3]);
                        *(u32x2*)(rowp + bj * HALF) = w; } } }
    }
};
struct EpiResBf16 {
    static constexpr bool PERM = true;
    const float* base; bf16_t* H;
    __device__ __forceinline__ void operator()(const f32x4 (&acc)[2][2][4][2], const Unit& u, int wr, int wc, int fr, int fq) const {
        const int row0 = u.pm * BM + wr * 64 + fr, col0 = u.pn * BM + wc * 32 + 8 * fq;
#pragma unroll
        for (int ai = 0; ai < 2; ++ai)
#pragma unroll
            for (int m = 0; m < 4; ++m) { const size_t off = (size_t)(row0 + ai * HALF + m * 16) * 1024 + col0;
#pragma unroll
                for (int bj = 0; bj < 2; ++bj) { const f32x4 b0 = *(const f32x4*)(base + off + bj * HALF), b1 = *(const f32x4*)(base + off + bj * HALF + 4);
                    const f32x4 v0 = b0 + acc[ai][bj][m][0], v1 = b1 + acc[ai][bj][m][1];
                    u32x4 w; w.x = cvt_pk_bf16(v0[0], v0[1]); w.y = cvt_pk_bf16(v0[2], v0[3]); w.z = cvt_pk_bf16(v1[0], v1[1]); w.w = cvt_pk_bf16(v1[2], v1[3]);
                    *(u32x4*)(H + off + bj * HALF) = w; }
                if (m & 1) asm volatile("" ::: "memory"); }
    }
};
struct EpiFinal {
    static constexpr bool PERM = false;
    float* out; const bf16_t* H2; const bf16_t* ER; const float* ss; const float* pn;
    __device__ __forceinline__ void operator()(const f32x4 (&acc)[2][2][4][2], const Unit& u, int wr, int wc, int fr, int fq) const {
        const int row0 = u.pm * BM + wr * 64 + fr, col0 = u.pn * BM + wc * 32 + 4 * fq;
        f32x4 pv[2][2];
#pragma unroll
        for (int bj = 0; bj < 2; ++bj)
#pragma unroll
            for (int n = 0; n < 2; ++n) pv[bj][n] = *(const f32x4*)(pn + col0 + bj * HALF + n * 16);
#pragma unroll
        for (int ai = 0; ai < 2; ++ai)
#pragma unroll
            for (int m = 0; m < 4; ++m) { const int row = row0 + ai * HALF + m * 16; const size_t off = (size_t)row * 1024 + col0;
                const float re = 1.0f / sqrtf(ss[row] * (1.f / 1024.f) + 1e-6f);
#pragma unroll
                for (int bj = 0; bj < 2; ++bj)
#pragma unroll
                    for (int n = 0; n < 2; ++n) { const size_t o = off + bj * HALF + n * 16; const u32x2 hw = *(const u32x2*)(H2 + o); const u32x2 ew = *(const u32x2*)(ER + o);
                        f32x4 b; b[0] = __uint_as_float(hw.x << 16); b[1] = __uint_as_float(hw.x & 0xffff0000u); b[2] = __uint_as_float(hw.y << 16); b[3] = __uint_as_float(hw.y & 0xffff0000u);
                        f32x4 e; e[0] = __uint_as_float(ew.x << 16); e[1] = __uint_as_float(ew.x & 0xffff0000u); e[2] = __uint_as_float(ew.y << 16); e[3] = __uint_as_float(ew.y & 0xffff0000u);
                        f32x4 r;
#pragma unroll
                        for (int j = 0; j < 4; ++j) { const float sg = __builtin_amdgcn_rcpf(1.0f + __builtin_amdgcn_exp2f((-1.4426950408889634f * 0.03125f) * acc[ai][bj][m][n][j])); r[j] = b[j] + sg * (e[j] * re * pv[bj][n][j]); }
                        *(f32x4*)(out + o) = r; }
                if (m & 1) asm volatile("" ::: "memory"); }
    }
};

typedef int v8i __attribute__((ext_vector_type(8)));
typedef int v4i __attribute__((ext_vector_type(4)));
__device__ __forceinline__ v8i cat8(bf16x8 a, bf16x8 b) { const v4i x = __builtin_bit_cast(v4i, a), y = __builtin_bit_cast(v4i, b); return __builtin_shufflevector(x, y, 0, 1, 2, 3, 4, 5, 6, 7); }
__device__ __forceinline__ void mfma8(f32x4& acc, v8i a, v8i b, int sc) { asm volatile("v_mfma_scale_f32_16x16x128_f8f6f4 %0, %1, %2, %0, %3, %3 op_sel_hi:[0,0,0]" : "+v"(acc) : "v"(a), "v"(b), "v"(sc)); }
__device__ __forceinline__ int tid_opaque() { int t; asm volatile("v_mov_b32 %0, %1" : "=v"(t) : "v"(threadIdx.x)); return t; }
__device__ __forceinline__ void a_offs(const Gemm& g, const Unit& u, int R0, unsigned c2, unsigned (&o)[2][2]) {
    const PG8_LAS unsigned short* t = g.urow + u.ord * 256 + R0;
#pragma unroll
    for (int h = 0; h < 2; ++h) {
        const unsigned r0 = t[h * HALF], r1 = t[h * HALF + 64];
        o[h][0] = (r0 * (unsigned)g.K) * 2u + c2; o[h][1] = (r1 * (unsigned)g.K) * 2u + c2; }
}

template <class Epi, class Sched, bool GATHER, bool ALIGN_EPI, bool F8 = false, bool G64 = false>
__device__ __forceinline__ void gemm_phase(PG8_LAS unsigned char* lds, const Gemm g, const Sched& S, const Epi& E) {
    const int tid = tid_opaque(), wid = __builtin_amdgcn_readfirstlane(tid >> 6), lane = tid & 63, wr = wid >> 2, wc = wid & 3, fr = lane & 15, fq = lane >> 4;
    const int K = g.K, nt = K / BK;
    int R0, C0; stage_rc(tid * 16, R0, C0);
    unsigned voffA[2], voffB[2];
    { const int Rb0 = G64 ? (64 * (R0 >> 5) + perm32(R0 & 31)) : Epi::PERM ? ((R0 & ~31) + perm32(R0 & 31)) : R0;
      voffA[0] = (unsigned)(R0 * K + C0) * 2u; voffA[1] = voffA[0] + (unsigned)(64 * K) * 2u;
      voffB[0] = (unsigned)(Rb0 * K + C0) * 2u; voffB[1] = voffB[0] + (unsigned)((G64 ? 128 : 64) * K) * 2u; }
    const size_t kstep = (size_t)(BK * 2);
    const size_t hstep = (size_t)HALF * K * 2;
    const size_t tstep = 2 * hstep;
    const size_t hstepB = G64 ? (size_t)32 * K * 2 : hstep;
    const unsigned ldsw = (unsigned)wid * 1024u;
    const int aoff = lds_byte(wr * 64 + fr, F8 ? fq * 16 : fq * 8), boff = lds_byte(wc * 32 + fr, F8 ? fq * 16 : fq * 8);
    constexpr int CHS = F8 ? 16 : 1024;
    int sc8 = 0x7f7f7f7f; asm volatile("" : "+v"(sc8));
#define PG8_SA(b, h) (((b) * 2 + (h)) * HTB)
#define PG8_SB(b, h) ((4 + (b) * 2 + (h)) * HTB)
#define PG8_STAGE(bufoff, gbase, voff) do { _Pragma("unroll") for (int _i = 0; _i < 2; ++_i) \
        __builtin_amdgcn_global_load_lds((const unsigned*)((const char*)(gbase) + (voff)[_i]), (PG8_LAS unsigned*)(lds + (bufoff) + ldsw + _i * 8192), 16, 0, 0); } while (0)
#define PG8_STAGE_AC(bufoff, kb, h) do { if constexpr (GATHER) { PG8_STAGE(bufoff, Ab + (kb), co[h]); } else { PG8_STAGE(bufoff, cA + (kb) + (h) * hstep, voffA); } } while (0)
#define PG8_STAGE_AX(bufoff, nx, kb, kbn, h) do { if constexpr (GATHER) { unsigned _o[2]; _o[0] = (nx) ? no[h][0] : co[h][0]; _o[1] = (nx) ? no[h][1] : co[h][1]; PG8_STAGE(bufoff, Ab + ((nx) ? (kbn) : (kb)), _o); } \
        else { PG8_STAGE(bufoff, ((nx) ? nA + (kbn) : cA + (kb)) + (h) * hstep, voffA); } } while (0)
#define PG8_LDA(dst, b, h) do { _Pragma("unroll") for (int m = 0; m < 4; ++m) _Pragma("unroll") for (int k = 0; k < 2; ++k) dst[m][k] = *(const PG8_LAS bf16x8*)(lds + PG8_SA(b, h) + aoff + m * 2048 + k * CHS); } while (0)
#define PG8_LDB(dst, b, h) do { _Pragma("unroll") for (int n = 0; n < 2; ++n) _Pragma("unroll") for (int k = 0; k < 2; ++k) dst[n][k] = *(const PG8_LAS bf16x8*)(lds + PG8_SB(b, h) + boff + n * 2048 + k * CHS); } while (0)
#define PG8_MMA(ai, bj, At, Bt) do { __builtin_amdgcn_s_setprio(1); _Pragma("unroll") for (int m = 0; m < 4; ++m) _Pragma("unroll") for (int n = 0; n < 2; ++n) { \
        if constexpr (F8) { mfma8(acc[ai][bj][m][n], cat8(Bt[n][0], Bt[n][1]), cat8(At[m][0], At[m][1]), sc8); } \
        else { _Pragma("unroll") for (int k = 0; k < 2; ++k) acc[ai][bj][m][n] = __builtin_amdgcn_mfma_f32_16x16x32_bf16(Bt[n][k], At[m][k], acc[ai][bj][m][n], 0, 0, 0); } } \
        __builtin_amdgcn_s_setprio(0); } while (0)
#define PG8_WAIT_V(n) asm volatile("s_waitcnt vmcnt(" #n ")" ::: "memory")
#define PG8_WAIT_L(n) asm volatile("s_waitcnt lgkmcnt(" #n ")" ::: "memory")
#define PG8_BAR __builtin_amdgcn_s_barrier()
#define PG8_SCHED __builtin_amdgcn_sched_barrier(0)
    Unit cur, nxt; int ui = 0;
    if (!S.next(0, cur)) return;
    f32x4 acc[2][2][4][2];
#pragma unroll
    for (int a = 0; a < 2; ++a)
#pragma unroll
        for (int b = 0; b < 2; ++b)
#pragma unroll
            for (int m = 0; m < 4; ++m)
#pragma unroll
                for (int n = 0; n < 2; ++n) acc[a][b][m][n] = (f32x4){0.f, 0.f, 0.f, 0.f};
    bf16x8 At[4][2], B0[2][2], B1[2][2];
    const char* const Ab = (const char*)g.A;
    const char* cA = Ab + (GATHER ? (size_t)0 : (size_t)cur.ta * tstep);
    const char* cB = (const char*)g.Bt + (size_t)cur.tb * tstep;
    unsigned co[2][2], no[2][2];
    const unsigned c2 = (unsigned)C0 * 2u;
    if constexpr (GATHER) a_offs(g, cur, R0, c2, co);
    PG8_STAGE(PG8_SB(0, 0), cB, voffB); PG8_STAGE(PG8_SB(0, 1), cB + hstepB, voffB); PG8_STAGE_AC(PG8_SA(0, 0), 0, 0); PG8_STAGE_AC(PG8_SA(0, 1), 0, 1);
    if (wr == 1) PG8_BAR;
    PG8_WAIT_V(2); PG8_BAR;
    PG8_STAGE(PG8_SB(1, 0), cB + kstep, voffB); PG8_STAGE_AC(PG8_SA(1, 0), kstep, 0); PG8_STAGE(PG8_SB(1, 1), cB + hstepB + kstep, voffB);
    PG8_WAIT_V(6); PG8_BAR;
    for (;;) {
        const bool has_next = S.next(ui + 1, nxt);
        const char* nB = has_next ? (const char*)g.Bt + (size_t)nxt.tb * tstep : cB;
        const char* nA = (has_next && !GATHER) ? Ab + (size_t)nxt.ta * tstep : cA;
        if constexpr (GATHER) {
            if (has_next) a_offs(g, nxt, R0, c2, no);
            else {
#pragma unroll
                for (int h = 0; h < 2; ++h) { no[h][0] = co[h][0]; no[h][1] = co[h][1]; } } }
        for (int t = 0; t < nt; t += 2) {
            const bool last = (t == nt - 2);
            const size_t k1 = (size_t)(t + 1) * kstep, k2 = (size_t)(t + 2) * kstep, k3 = (size_t)(t + 3) * kstep;
            const char* b2 = last ? nB : cB + k2;
            const char* b3 = b2 + kstep;
            PG8_LDB(B0, 0, 0); PG8_LDB(B1, 0, 1); PG8_SCHED; PG8_LDA(At, 0, 0); PG8_STAGE_AC(PG8_SA(1, 1), k1, 1);
            PG8_WAIT_V(8); PG8_WAIT_L(0); PG8_BAR; PG8_MMA(0, 0, At, B0); PG8_MMA(0, 1, At, B1); PG8_BAR; PG8_SCHED;
            PG8_LDA(At, 0, 1); PG8_STAGE(PG8_SB(0, 0), b2, voffB); PG8_STAGE(PG8_SB(0, 1), b2 + hstepB, voffB); PG8_STAGE_AX(PG8_SA(0, 0), last, k2, (size_t)0, 0);
            PG8_WAIT_V(8); PG8_WAIT_L(0); PG8_BAR; PG8_MMA(1, 0, At, B0); PG8_MMA(1, 1, At, B1); PG8_BAR; PG8_SCHED;
            PG8_LDB(B0, 1, 0); PG8_LDB(B1, 1, 1); PG8_SCHED; PG8_LDA(At, 1, 0); PG8_STAGE_AX(PG8_SA(0, 1), last, k2, (size_t)0, 1);
            PG8_WAIT_V(8); PG8_WAIT_L(0); PG8_BAR; PG8_MMA(0, 0, At, B0); PG8_MMA(0, 1, At, B1); PG8_BAR; PG8_SCHED;
            PG8_LDA(At, 1, 1); PG8_STAGE(PG8_SB(1, 0), b3, voffB); PG8_STAGE(PG8_SB(1, 1), b3 + hstepB, voffB); PG8_STAGE_AX(PG8_SA(1, 0), last, k3, kstep, 0);
            PG8_WAIT_V(8); PG8_WAIT_L(0); PG8_BAR; PG8_MMA(1, 0, At, B0); PG8_MMA(1, 1, At, B1); PG8_BAR; PG8_SCHED;
        }
        if constexpr (ALIGN_EPI) { if (wr == 0) PG8_BAR; }
        if constexpr (F8) asm volatile("s_nop 15\n\ts_nop 15" ::: "memory");
        { const int te = tid_opaque() & 63; E(acc, cur, wr, wc, te & 15, te >> 4); }
        if (!has_next) break;
#pragma unroll
        for (int a = 0; a < 2; ++a)
#pragma unroll
            for (int b = 0; b < 2; ++b)
#pragma unroll
                for (int m = 0; m < 4; ++m)
#pragma unroll
                    for (int n = 0; n < 2; ++n) acc[a][b][m][n] = (f32x4){0.f, 0.f, 0.f, 0.f};
        cur = nxt; cB = nB; cA = nA; ++ui;
        if constexpr (GATHER) {
#pragma unroll
            for (int h = 0; h < 2; ++h) { co[h][0] = no[h][0]; co[h][1] = no[h][1]; } }
        if constexpr (ALIGN_EPI) { if (wr == 1) PG8_BAR; }
    }
    PG8_WAIT_V(0);
    if constexpr (!ALIGN_EPI) { if (wr == 0) PG8_BAR; }
    PG8_BAR;
#undef PG8_SA
#undef PG8_SB
#undef PG8_STAGE
#undef PG8_STAGE_AC
#undef PG8_STAGE_AX
#undef PG8_LDA
#undef PG8_LDB
#undef PG8_MMA
#undef PG8_WAIT_V
#undef PG8_WAIT_L
#undef PG8_BAR
#undef PG8_SCHED
}
}

namespace attn_body {
using bf16=__hip_bfloat16;
using bf16x8=__attribute__((ext_vector_type(8)))short;
using s16x4=__attribute__((ext_vector_type(4)))short;
using f32x16=__attribute__((ext_vector_type(16)))float;
using u32x4=__attribute__((ext_vector_type(4)))unsigned;
constexpr int SEQ=4096,D=64,DM=1024;
constexpr int NW=8,QBLK=32,QB=QBLK*NW,KVBLK=64,NQB=SEQ/QB;
__device__ __forceinline__ int crow(int r,int hi){return (r&3)+8*(r>>2)+4*hi;}
#define SBAR() __builtin_amdgcn_sched_barrier(0)
__device__ __forceinline__ void cmask(f32x16&p0,f32x16&p1,int jb,int qrel,int hi){
  const float NEG=-INFINITY; int kb=64*jb+4*hi;
  #pragma unroll
  for(int r=0;r<16;++r){int kv=kb+(r&3)+8*(r>>2); if(kv>qrel)p0[r]=NEG; if(kv+32>qrel)p1[r]=NEG;}
}
constexpr int NSLOT=3, SLOTB=8192;
constexpr int LDS_K=0, LDS_V=NSLOT*SLOTB, LDS_WS=2*NSLOT*SLOTB, LDS_OST=LDS_WS+NW*64*4, LDS_BYTES=LDS_OST+NW*4096;
constexpr float C2=0.125f*1.4426950408889634f;
__device__ __forceinline__ void glds16(const void*gsrc,unsigned lds_dst){unsigned keep;
  asm volatile("s_mov_b32 %0, m0\n\ts_mov_b32 m0, %2\n\ts_nop 0\n\tglobal_load_lds_dwordx4 %1, off\n\ts_mov_b32 m0, %0":"=&s"(keep):"v"(gsrc),"s"(lds_dst):"memory");}
__device__ __forceinline__ float max3f(float a,float b,float c){float r;asm("v_max3_f32 %0, %1, %2, %3":"=v"(r):"v"(a),"v"(b),"v"(c));return r;}
__device__ __forceinline__ float max2f(float a,float b){float r;asm("v_max_f32_e32 %0, %1, %2":"=v"(r):"v"(a),"v"(b));return r;}
__device__ __forceinline__ float fadd_s(float a,float b){float r;asm("v_add_f32_e32 %0, %1, %2":"=v"(r):"v"(a),"v"(b));return r;}
__device__ __forceinline__ float fsub_s(float a,float b){float r;asm("v_sub_f32_e32 %0, %1, %2":"=v"(r):"v"(a),"v"(b));return r;}
typedef float f32x2_t __attribute__((ext_vector_type(2))); typedef __bf16 bf16x2_t __attribute__((ext_vector_type(2)));
__device__ __forceinline__ unsigned cvtpk_s(float lo,float hi){f32x2_t v={lo,hi};bf16x2_t b=__builtin_convertvector(v,bf16x2_t);return __builtin_bit_cast(unsigned,b);}
#define WAIT_BAR(N) asm volatile("s_waitcnt vmcnt(" #N ") lgkmcnt(0)\n\ts_barrier":::"memory")

__device__ __forceinline__ void qkt(f32x16&p0,f32x16&p1,const char*Kslot,const bf16x8*qr,const f32x16&negm,int r32,int hi){
  const char*kb=Kslot+hi*1024+r32*16;
  #pragma unroll
  for(int d0=0;d0<4;++d0){
    const bf16x8 b0=*reinterpret_cast<const bf16x8*>(kb+d0*2048);
    const bf16x8 b1=*reinterpret_cast<const bf16x8*>(kb+d0*2048+512);
    if(d0==0){p0=__builtin_amdgcn_mfma_f32_32x32x16_bf16(b0,qr[0],negm,0,0,0);p1=__builtin_amdgcn_mfma_f32_32x32x16_bf16(b1,qr[0],negm,0,0,0);}
    else{p0=__builtin_amdgcn_mfma_f32_32x32x16_bf16(b0,qr[d0],p0,0,0,0);p1=__builtin_amdgcn_mfma_f32_32x32x16_bf16(b1,qr[d0],p1,0,0,0);}}
}
typedef __attribute__((address_space(3))) const char* lds_cptr;
typedef short v4i16_t __attribute__((ext_vector_type(4)));
__device__ __forceinline__ void kload8(bf16x8*kf,lds_cptr kp){
  kf[0]=*(const __attribute__((address_space(3))) bf16x8*)(kp);      kf[1]=*(const __attribute__((address_space(3))) bf16x8*)(kp+512);
  kf[2]=*(const __attribute__((address_space(3))) bf16x8*)(kp+2048); kf[3]=*(const __attribute__((address_space(3))) bf16x8*)(kp+2560);
  kf[4]=*(const __attribute__((address_space(3))) bf16x8*)(kp+4096); kf[5]=*(const __attribute__((address_space(3))) bf16x8*)(kp+4608);
  kf[6]=*(const __attribute__((address_space(3))) bf16x8*)(kp+6144); kf[7]=*(const __attribute__((address_space(3))) bf16x8*)(kp+6656);
}
__device__ __forceinline__ void kload2(bf16x8*kf,lds_cptr kp,int j){ kf[2*j]=*(const __attribute__((address_space(3))) bf16x8*)(kp+j*2048); kf[2*j+1]=*(const __attribute__((address_space(3))) bf16x8*)(kp+j*2048+512); }
__device__ __forceinline__ s16x4 vtr(lds_cptr p){ return __builtin_bit_cast(s16x4,__builtin_amdgcn_ds_read_tr16_b64_v4i16((__attribute__((address_space(3))) v4i16_t*)p)); }
__device__ __forceinline__ float rowmax(const f32x16&p0,const f32x16&p1){
  float a=max3f(p0[0],p0[1],p1[0]),b=max3f(p0[2],p0[3],p1[1]);a=max3f(a,p1[2],p1[3]);
  #pragma unroll
  for(int r=4;r<16;r+=4){a=max3f(a,p0[r],p0[r+1]);b=max3f(b,p0[r+2],p0[r+3]);a=max3f(a,p1[r],p1[r+1]);b=max3f(b,p1[r+2],p1[r+3]);}
  const float m=max2f(a,b);
  auto rr=__builtin_amdgcn_permlane32_swap(__float_as_uint(m),__float_as_uint(m),false,false);
  return max2f(__uint_as_float(rr[0]),__uint_as_float(rr[1]));
}
__device__ __forceinline__ void pv(f32x16*o,int vb,bf16x8 pa0,bf16x8 pa1,bf16x8 pa2,bf16x8 pa3){
  #pragma unroll
  for(int d0=0;d0<2;++d0){s16x4 lo[4],hi[4];
    #pragma unroll
    for(int ks=0;ks<4;++ks){
      asm volatile("ds_read_b64_tr_b16 %0,%1 offset:%c2":"=&v"(lo[ks]):"v"(vb),"i"(d0*4096+ks*1024):"memory");
      asm volatile("ds_read_b64_tr_b16 %0,%1 offset:%c2":"=&v"(hi[ks]):"v"(vb),"i"(d0*4096+ks*1024+512):"memory");}
    asm volatile("s_waitcnt lgkmcnt(0)":::"memory");SBAR();
    #define PK(k) (bf16x8){lo[k][0],lo[k][1],lo[k][2],lo[k][3],hi[k][0],hi[k][1],hi[k][2],hi[k][3]}
    o[d0]=__builtin_amdgcn_mfma_f32_32x32x16_bf16(pa0,PK(0),o[d0],0,0,0);
    o[d0]=__builtin_amdgcn_mfma_f32_32x32x16_bf16(pa1,PK(1),o[d0],0,0,0);
    o[d0]=__builtin_amdgcn_mfma_f32_32x32x16_bf16(pa2,PK(2),o[d0],0,0,0);
    o[d0]=__builtin_amdgcn_mfma_f32_32x32x16_bf16(pa3,PK(3),o[d0],0,0,0);
    #undef PK
  }
}
#define ATTN_STORE16(p,v) (*(u32x4*)(p)=(v))
template<int THRL> __device__ __forceinline__ void attn_unit(int b,int qc,int kc,int vc,int oc,int qb,const bf16*Q,const bf16*__restrict__ K,const bf16*__restrict__ V,bf16*O,char*shm){
  const int tid=threadIdx.x,lane=tid&63,r32=lane&31,hi=lane>>5; const int wid=__builtin_amdgcn_readfirstlane(tid>>6);
  const long rowbase=(long)b*SEQ; const int q0=qb*QB;
  const bf16*Qw=Q+(rowbase+q0+wid*QBLK)*DM+qc;
  const bf16*Kh=K+rowbase*DM+kc,*Vh=V+rowbase*DM+vc;
  const unsigned lds0=(unsigned)(uintptr_t)shm;
  float*wsf=(float*)(shm+LDS_WS)+wid*64;
  const bf16*ksrc=Kh+(long)lane*DM+wid*8;
  const bf16*vsrc=Vh+(long)(16*(wid&3)+(lane>>2))*DM+(wid>>2)*32+(lane&3)*8;
  const unsigned kdst=lds0+LDS_K+wid*1024, vdst=lds0+LDS_V+wid*1024;
  #define DMA_K(t,slot) glds16(ksrc+(long)(t)*KVBLK*DM,(unsigned)__builtin_amdgcn_readfirstlane(kdst+(slot)))
  #define DMA_V(t,slot) glds16(vsrc+(long)(t)*KVBLK*DM,(unsigned)__builtin_amdgcn_readfirstlane(vdst+(slot)))
  const int vb0=(int)(lds0+LDS_V)+((lane>>4)&1)*32+(lane&3)*8+(4*hi+((lane&15)>>2))*64;
  const char*Kbase=shm+LDS_K; bf16x8 kf[8];
  const lds_cptr shm3=(lds_cptr)shm; const lds_cptr kp0=shm3+LDS_K+hi*1024+r32*16; const lds_cptr vp0=shm3+LDS_V+((lane>>4)&1)*32+(lane&3)*8+(4*hi+((lane&15)>>2))*64;
  const int NT=(q0+QB)/KVBLK;
  DMA_K(0,0);DMA_V(0,0);DMA_K(1,SLOTB);
  bf16x8 qr[4];
  #pragma unroll
  for(int d0=0;d0<4;++d0)qr[d0]=*reinterpret_cast<const bf16x8*>(&Qw[(long)r32*DM+d0*16+hi*8]);
  float mhat=0.f,l_reg=0.f;f32x16 o[2];o[0]=f32x16{};o[1]=f32x16{};f32x16 negm=f32x16{};asm volatile("":"+v"(negm));
  const int qrel=wid*QBLK+r32;
  #define CMASK(P0,P1,t) do{int jb_=(t)-(NT-4); if(jb_>=0)cmask(P0,P1,jb_,qrel,hi);}while(0)
  bool resc=false;
  #define START(P0,P1) do{ const float rm=rowmax(P0,P1); resc=false; \
    { const float dl=rm; mhat=fadd_s(mhat,dl); \
      _Pragma("unroll") for(int r=0;r<16;++r){P0[r]=fsub_s(P0[r],dl);P1[r]=fsub_s(P1[r],dl);} \
      _Pragma("unroll") for(int r=0;r<16;++r)negm[r]=-mhat; asm volatile("":"+v"(negm)); } \
    _Pragma("unroll") for(int r=0;r<16;++r)P0[r]=__builtin_amdgcn_exp2f(P0[r]); }while(0)
  #define RESC() do{ if(resc){ asm volatile("s_waitcnt lgkmcnt(0)":::"memory"); \
      _Pragma("unroll") for(int d_=0;d_<2;++d_) _Pragma("unroll") for(int r=0;r<16;++r)o[d_][r]*=wsf[crow(r,hi)]; } }while(0)
  f32x16 pA0,pA1,pB0,pB1;
  int sl_prev=0,sl_cur=0,sl_next=SLOTB;
  #define ROT() do{sl_prev=sl_cur;sl_cur=sl_next;sl_next=(sl_next==(NSLOT-1)*SLOTB)?0:sl_next+SLOTB;}while(0)
  DMA_K(2,2*SLOTB);
  WAIT_BAR(3);
  qkt(pA0,pA1,Kbase,qr,negm,r32,hi);asm volatile("s_nop 15\n\ts_nop 7":"+v"(pA0),"+v"(pA1));CMASK(pA0,pA1,0);
  START(pA0,pA1);
  _Pragma("unroll") for(int r=0;r<16;++r)pA1[r]=__builtin_amdgcn_exp2f(pA1[r]);
  WAIT_BAR(0);
  DMA_K(3,0);DMA_V(1,SLOTB);
  ROT();
  kload8(kf,kp0+sl_cur);
  WAIT_BAR(2);
  s16x4 vlo[8],vhi[8]; u32x4 pw0,pw1,pw2,pw3;
  #define PKW(P,B) cvtpk_s(P[B],P[B+1])
  #define PAF(k) __builtin_bit_cast(bf16x8,pw##k)
  #define VFR(i) (bf16x8){vlo[i][0],vlo[i][1],vlo[i][2],vlo[i][3],vhi[i][0],vhi[i][1],vhi[i][2],vhi[i][3]}
  #define PIN(x) asm volatile("":"+v"(x))
  #define MX3(a,b,c) __builtin_fmaxf(__builtin_fmaxf((a),(b)),(c))
  #define GAPA(MF,A0,A1,A2,A3,W0,W1,PW) do{ MF; sacc+=A0; sacc+=A1; sacc+=A2; sacc+=A3; PIN(sacc); W0; W1; PIN(PW); SBAR(); }while(0)
  #define EX(v) __builtin_amdgcn_exp2f(v)
  #define GAPB(MF,X,B) do{ MF; X[B]=EX(X[B]); X[B+1]=EX(X[B+1]); X[B+2]=EX(X[B+2]); X[B+3]=EX(X[B+3]); PIN(X); SBAR(); }while(0)
  #define VRD(i) do{ vlo[i]=vtr(vp_+(((i)>>2)*4096+((i)&3)*1024)); vhi[i]=vtr(vp_+(((i)>>2)*4096+((i)&3)*1024+512)); }while(0)
  #define KRD(G,j) do{ if(G){ kload2(kf,kp0+sl_next,j); SBAR(); } }while(0)
  #define STEP(C0,C1,P0,P1,t,GK,GV,GL) do{ SBAR(); \
    const lds_cptr vp_=vp0+sl_prev; \
    VRD(0); SBAR(); float sacc=(P0[0]+P0[1]); \
    GAPA(C0=__builtin_amdgcn_mfma_f32_32x32x16_bf16(kf[0],qr[0],negm,0,0,0), P0[2],P0[3],P0[4],P0[5],     pw0[0]=PKW(P0,0), pw0[1]=PKW(P0,2), pw0); \
    VRD(4); SBAR(); GAPA(C1=__builtin_amdgcn_mfma_f32_32x32x16_bf16(kf[1],qr[0],negm,0,0,0), P0[6],P0[7],P0[8],P0[9],     pw0[2]=PKW(P0,4), pw0[3]=PKW(P0,6), pw0); \
    VRD(1); SBAR(); GAPA(C0=__builtin_amdgcn_mfma_f32_32x32x16_bf16(kf[2],qr[1],C0,0,0,0),   P0[10],P0[11],P0[12],P0[13], pw1[0]=PKW(P0,8), pw1[1]=PKW(P0,10), pw1); \
    VRD(5); SBAR(); GAPA(C1=__builtin_amdgcn_mfma_f32_32x32x16_bf16(kf[3],qr[1],C1,0,0,0),   P0[14],P0[15],P1[0],P1[1],   pw1[2]=PKW(P0,12),pw1[3]=PKW(P0,14), pw1); \
    VRD(2); SBAR(); GAPA(C0=__builtin_amdgcn_mfma_f32_32x32x16_bf16(kf[4],qr[2],C0,0,0,0),   P1[2],P1[3],P1[4],P1[5],     pw2[0]=PKW(P1,0), pw2[1]=PKW(P1,2), pw2); \
    VRD(6); SBAR(); GAPA(C1=__builtin_amdgcn_mfma_f32_32x32x16_bf16(kf[5],qr[2],C1,0,0,0),   P1[6],P1[7],P1[8],P1[9],     pw2[2]=PKW(P1,4), pw2[3]=PKW(P1,6), pw2); \
    VRD(3); SBAR(); GAPA(C0=__builtin_amdgcn_mfma_f32_32x32x16_bf16(kf[6],qr[3],C0,0,0,0),   P1[10],P1[11],P1[12],P1[13], pw3[0]=PKW(P1,8), pw3[1]=PKW(P1,10), pw3); \
    VRD(7); SBAR(); GAPA(C1=__builtin_amdgcn_mfma_f32_32x32x16_bf16(kf[7],qr[3],C1,0,0,0),   P1[14],P1[15],0.f,0.f,       pw3[2]=PKW(P1,12),pw3[3]=PKW(P1,14), pw3); \
    l_reg+=sacc; \
    if(GK){DMA_K((t)+3,sl_cur);} if(GV){DMA_V((t)+1,sl_next);} \
    CMASK(C0,C1,t); \
    { float a=MX3(C0[0],C0[1],C1[0]),b=MX3(C0[2],C0[3],C1[1]); a=MX3(a,C1[2],C1[3]); \
      _Pragma("unroll") for(int r=4;r<16;r+=4){a=MX3(a,C0[r],C0[r+1]);b=MX3(b,C0[r+2],C0[r+3]);a=MX3(a,C1[r],C1[r+1]);b=MX3(b,C1[r+2],C1[r+3]);} \
      float rm=__builtin_fmaxf(a,b); { auto rr=__builtin_amdgcn_permlane32_swap(__float_as_uint(rm),__float_as_uint(rm),false,false); rm=__builtin_fmaxf(__uint_as_float(rr[0]),__uint_as_float(rr[1])); } \
      resc=false; \
      if(__builtin_expect(__any(rm>(float)THRL),0)){ const float dl=__builtin_fmaxf(rm,0.f); mhat+=dl; \
        _Pragma("unroll") for(int r=0;r<16;++r){C0[r]-=dl;C1[r]-=dl;} \
        _Pragma("unroll") for(int r=0;r<16;++r)negm[r]=-mhat; asm volatile("":"+v"(negm)); \
        const float f=__builtin_amdgcn_exp2f(-dl); l_reg*=f; if(hi==0)wsf[r32]=f; resc=true; } } \
    SBAR(); \
    GAPB(o[0]=__builtin_amdgcn_mfma_f32_32x32x16_bf16(PAF(0),VFR(0),o[0],0,0,0), C0,0); \
    GAPB(o[1]=__builtin_amdgcn_mfma_f32_32x32x16_bf16(PAF(0),VFR(4),o[1],0,0,0), C0,4); \
    KRD(GL,0); GAPB(o[0]=__builtin_amdgcn_mfma_f32_32x32x16_bf16(PAF(1),VFR(1),o[0],0,0,0), C0,8); \
    KRD(GL,1); GAPB(o[1]=__builtin_amdgcn_mfma_f32_32x32x16_bf16(PAF(1),VFR(5),o[1],0,0,0), C0,12); \
    KRD(GL,2); GAPB(o[0]=__builtin_amdgcn_mfma_f32_32x32x16_bf16(PAF(2),VFR(2),o[0],0,0,0), C1,0); \
    KRD(GL,3); GAPB(o[1]=__builtin_amdgcn_mfma_f32_32x32x16_bf16(PAF(2),VFR(6),o[1],0,0,0), C1,4); \
    GAPB(o[0]=__builtin_amdgcn_mfma_f32_32x32x16_bf16(PAF(3),VFR(3),o[0],0,0,0), C1,8); \
    GAPB(o[1]=__builtin_amdgcn_mfma_f32_32x32x16_bf16(PAF(3),VFR(7),o[1],0,0,0), C1,12); \
    }while(0)
  int t=1;
  #undef CMASK
  #define CMASK(P0,P1,t) do{}while(0)
  for(;t+5<NT;t+=2){
    STEP(pB0,pB1,pA0,pA1,t,true,true,true);     WAIT_BAR(2); RESC(); ROT();
    STEP(pA0,pA1,pB0,pB1,t+1,true,true,true);   WAIT_BAR(2); RESC(); ROT();
  }
  #undef CMASK
  #define CMASK(P0,P1,t) do{int jb_=(t)-(NT-4); if(jb_>=0)cmask(P0,P1,jb_,qrel,hi);}while(0)
  #define ENDW(tt) do{ if((tt)+3<NT){WAIT_BAR(2);} else if((tt)+2<NT){WAIT_BAR(1);} else {WAIT_BAR(0);} }while(0)
  for(;t+1<NT;t+=2){
    STEP(pB0,pB1,pA0,pA1,t,(t+3<NT),(t+1<NT),(t+1<NT));       ENDW(t);   RESC(); ROT();
    STEP(pA0,pA1,pB0,pB1,t+1,(t+4<NT),(t+2<NT),(t+2<NT));     ENDW(t+1); RESC(); ROT();
  }
  STEP(pB0,pB1,pA0,pA1,NT-1,false,false,false); RESC();
  { float sacc=pB0[0]+pB0[1]; _Pragma("unroll") for(int r=2;r<16;++r)sacc+=pB0[r]; _Pragma("unroll") for(int r=0;r<16;++r)sacc+=pB1[r]; l_reg+=sacc;
    pw0=(u32x4){PKW(pB0,0),PKW(pB0,2),PKW(pB0,4),PKW(pB0,6)};pw1=(u32x4){PKW(pB0,8),PKW(pB0,10),PKW(pB0,12),PKW(pB0,14)};pw2=(u32x4){PKW(pB1,0),PKW(pB1,2),PKW(pB1,4),PKW(pB1,6)};pw3=(u32x4){PKW(pB1,8),PKW(pB1,10),PKW(pB1,12),PKW(pB1,14)};
    SBAR(); pv(o,vb0+sl_cur,PAF(0),PAF(1),PAF(2),PAF(3)); }
  #undef PKW
  #undef PAF
  #undef VFR
  #undef PIN
  #undef MX3
  #undef GAPA
  #undef GAPB
  #undef EX
  #undef VRD
  #undef KRD
  #undef STEP
  #undef ENDW
  {auto rr=__builtin_amdgcn_permlane32_swap(__float_as_uint(l_reg),__float_as_uint(l_reg),false,false);l_reg=__uint_as_float(rr[0])+__uint_as_float(rr[1]);}
  if(hi==0)wsf[32+r32]=l_reg;asm volatile("s_waitcnt lgkmcnt(0)":::"memory");
  float rli[16];
  #pragma unroll
  for(int r=0;r<16;++r)rli[r]=__builtin_amdgcn_rcpf(wsf[32+crow(r,hi)]);
  bf16*Ow=O+(rowbase+q0+wid*QBLK)*DM+oc;
  { bf16*stg=(bf16*)(shm+LDS_OST)+wid*2048;
    #pragma unroll
    for(int r=0;r<16;++r){const int orow=crow(r,hi);
      #pragma unroll
      for(int d0=0;d0<2;++d0)stg[orow*64+d0*32+r32]=__float2bfloat16(o[d0][r]*rli[r]);}
    asm volatile("s_waitcnt lgkmcnt(0)":::"memory");
    #pragma unroll
    for(int i=0;i<4;++i){const int row=i*8+(lane>>3),ch=lane&7; const u32x4 v=*(const u32x4*)(stg+row*64+ch*8); ATTN_STORE16(Ow+(long)row*DM+ch*8,v);} }
  asm volatile("s_waitcnt lgkmcnt(0)\n\ts_barrier":::"memory");
  #undef DMA_K
  #undef DMA_V
  #undef CMASK
  #undef START
  #undef RESC
  #undef ROT
}
constexpr int ATTN_LDS_BYTES=LDS_BYTES;
#undef SBAR
#undef WAIT_BAR
}

namespace attn2 {
using namespace attn_body;
constexpr int NKS=4, SLOTK=8192, NVS=3, SLOTV=16384;
constexpr int A2_K=0, A2_V=NKS*SLOTK, A2_WS=A2_V+NVS*SLOTV, A2_OST=A2_WS+NW*64*4, A2_BYTES=A2_OST+NW*4096;
#define SBAR() __builtin_amdgcn_sched_barrier(0)
#define WAIT_BAR(N) asm volatile("s_waitcnt vmcnt(" #N ") lgkmcnt(0)\n\ts_barrier":::"memory")
typedef __attribute__((address_space(3))) const bf16x8* lds_b8;
typedef float f32x4_t __attribute__((ext_vector_type(4)));
__device__ __forceinline__ bf16x8 KL(lds_cptr p){ return *(lds_b8)p; }
__device__ __forceinline__ void glds16s(const void*sbase,unsigned voff,unsigned lds_dst){unsigned keep;
  asm volatile("s_mov_b32 %0, m0\n\ts_mov_b32 m0, %3\n\ts_nop 0\n\tglobal_load_lds_dwordx4 %1, %2\n\ts_mov_b32 m0, %0":"=&s"(keep):"v"(voff),"s"(sbase),"s"(lds_dst):"memory");}
__device__ __forceinline__ void pv4(f32x16*o,int vb,bf16x8 pa0,bf16x8 pa1,bf16x8 pa2,bf16x8 pa3){
  #pragma unroll
  for(int d0=0;d0<4;++d0){s16x4 lo[4],hi[4];
    #pragma unroll
    for(int ks=0;ks<4;++ks){
      asm volatile("ds_read_b64_tr_b16 %0,%1 offset:%c2":"=&v"(lo[ks]):"v"(vb),"i"(d0*4096+ks*1024):"memory");
      asm volatile("ds_read_b64_tr_b16 %0,%1 offset:%c2":"=&v"(hi[ks]):"v"(vb),"i"(d0*4096+ks*1024+512):"memory");}
    asm volatile("s_waitcnt lgkmcnt(0)":::"memory");SBAR();
    #define PK(k) (bf16x8){lo[k][0],lo[k][1],lo[k][2],lo[k][3],hi[k][0],hi[k][1],hi[k][2],hi[k][3]}
    o[d0]=__builtin_amdgcn_mfma_f32_32x32x16_bf16(pa0,PK(0),o[d0],0,0,0);
    o[d0]=__builtin_amdgcn_mfma_f32_32x32x16_bf16(pa1,PK(1),o[d0],0,0,0);
    o[d0]=__builtin_amdgcn_mfma_f32_32x32x16_bf16(pa2,PK(2),o[d0],0,0,0);
    o[d0]=__builtin_amdgcn_mfma_f32_32x32x16_bf16(pa3,PK(3),o[d0],0,0,0);
    #undef PK
  }
}
template<int THRL,long A_OFF,long SG_OFF> __device__ __forceinline__ void attn_unit(int b,int qc,int kc,int vc,int oc,int qb,const bf16*Q,const bf16*__restrict__ K,const bf16*__restrict__ V,bf16*O,char*shm){
  const int MODE=(oc>>7)&1;
  const int tid=threadIdx.x,lane=tid&63,r32=lane&31,hi=lane>>5; const int wid=__builtin_amdgcn_readfirstlane(tid>>6);
  const long rowbase=(long)b*SEQ; const int q0=qb*QB;
  const bf16*Qw=Q+(rowbase+q0+wid*QBLK)*DM+qc;
  const bf16*Kh=K+rowbase*DM+kc,*Vh=V+rowbase*DM+vc;
  const unsigned lds0=(unsigned)(uintptr_t)shm;
  float*wsf=(float*)(shm+A2_WS)+wid*64;
  const unsigned koff=(unsigned)(lane*DM+wid*8)*2u;
  const unsigned voff=(unsigned)((16*(wid&3)+(lane>>2))*DM+(wid>>2)*32+(lane&3)*8)*2u;
  const unsigned kdst=lds0+A2_K+wid*1024, vdst=lds0+A2_V+wid*1024;
  #define DMA_K(t) glds16s(Kh+(long)(t)*KVBLK*DM,koff,(unsigned)__builtin_amdgcn_readfirstlane(kdst+(((t)&3)*SLOTK)))
  #define DMA_V(t,slot) do{ glds16s(Vh+(long)(t)*KVBLK*DM,voff,(unsigned)__builtin_amdgcn_readfirstlane(vdst+(slot))); glds16s(Vh+(long)(t)*KVBLK*DM+64,voff,(unsigned)__builtin_amdgcn_readfirstlane(vdst+(slot)+8192)); }while(0)
  const char*Kbase=shm+A2_K;
  const lds_cptr shm3=(lds_cptr)shm; const lds_cptr kp0=shm3+A2_K+hi*1024+r32*16; const lds_cptr vp0=shm3+A2_V+((lane>>4)&1)*32+(lane&3)*8+(4*hi+((lane&15)>>2))*64;
  const int NT=(q0+QB)/KVBLK;
  DMA_K(0);DMA_V(0,0);DMA_K(1);
  bf16x8 qr[4];
  #pragma unroll
  for(int d0=0;d0<4;++d0)qr[d0]=*reinterpret_cast<const bf16x8*>(&Qw[(long)r32*DM+d0*16+hi*8]);
  float mhat=0.f,l_reg=0.f;f32x16 o[4];o[0]=f32x16{};o[1]=f32x16{};o[2]=f32x16{};o[3]=f32x16{};f32x16 negm=f32x16{};asm volatile("":"+v"(negm));
  const int qrel=wid*QBLK+r32;
  #define CMASK(P0,P1,t) do{int jb_=(t)-(NT-4); if(jb_>=0)cmask(P0,P1,jb_,qrel,hi);}while(0)
  bool resc=false;
  #define START(P0,P1) do{ const float rm=rowmax(P0,P1); resc=false; \
    { const float dl=rm; mhat=fadd_s(mhat,dl); \
      _Pragma("unroll") for(int r=0;r<16;++r){P0[r]=fsub_s(P0[r],dl);P1[r]=fsub_s(P1[r],dl);} \
      _Pragma("unroll") for(int r=0;r<16;++r)negm[r]=-mhat; asm volatile("":"+v"(negm)); } \
    _Pragma("unroll") for(int r=0;r<16;++r)P0[r]=__builtin_amdgcn_exp2f(P0[r]); }while(0)
  #define RESC() do{ if(resc){ asm volatile("s_waitcnt lgkmcnt(0)":::"memory"); \
      _Pragma("unroll") for(int d_=0;d_<4;++d_) _Pragma("unroll") for(int r=0;r<16;++r)o[d_][r]*=wsf[crow(r,hi)]; } }while(0)
  f32x16 pA0,pA1,pB0,pB1;
  int vs_prev=0,vs_cur=0,vs_next=SLOTV;
  #define ROT() do{vs_prev=vs_cur;vs_cur=vs_next;vs_next=(vs_next==(NVS-1)*SLOTV)?0:vs_next+SLOTV;}while(0)
  DMA_K(2);
  WAIT_BAR(4);
  qkt(pA0,pA1,Kbase,qr,negm,r32,hi);asm volatile("s_nop 15\n\ts_nop 7":"+v"(pA0),"+v"(pA1));CMASK(pA0,pA1,0);
  START(pA0,pA1);
  _Pragma("unroll") for(int r=0;r<16;++r)pA1[r]=__builtin_amdgcn_exp2f(pA1[r]);
  WAIT_BAR(0);
  DMA_K(3);DMA_V(1,SLOTV);
  ROT();
  bf16x8 kn0=KL(kp0+SLOTK),kn1=KL(kp0+SLOTK+512);
  s16x4 vlo[8],vhi[8]; u32x4 pw0,pw1,pw2,pw3;
  #define PKW(P,B) cvtpk_s(P[B],P[B+1])
  #define PAF(k) __builtin_bit_cast(bf16x8,pw##k)
  #define VFR(i) (bf16x8){vlo[i][0],vlo[i][1],vlo[i][2],vlo[i][3],vhi[i][0],vhi[i][1],vhi[i][2],vhi[i][3]}
  #define PIN(x) asm volatile("":"+v"(x))
  #define MX3(a,b,c) __builtin_fmaxf(__builtin_fmaxf((a),(b)),(c))
  #define GAPA(MF,A0,A1,A2,A3,W0,W1,PW) do{ MF; sacc+=A0; sacc+=A1; sacc+=A2; sacc+=A3; PIN(sacc); W0; W1; PIN(PW); SBAR(); }while(0)
  #define EX(v) __builtin_amdgcn_exp2f(v)
  #define GAPB(MF,X,B) do{ MF; X[B]=EX(X[B]); X[B+1]=EX(X[B+1]); PIN(X); SBAR(); }while(0)
  #define VRD(i) do{ vlo[i]=vtr(vp_+(((i)>>2)*4096+((i)&3)*1024)); vhi[i]=vtr(vp_+(((i)>>2)*4096+((i)&3)*1024+512)); }while(0)
  #define VRH(i) do{ vlo[i]=vtr(vp_+(8192+((i)>>2)*4096+((i)&3)*1024)); vhi[i]=vtr(vp_+(8192+((i)>>2)*4096+((i)&3)*1024+512)); SBAR(); }while(0)
  #define STEP(C0,C1,P0,P1,t,GK,GV,GL) do{ SBAR(); \
    const lds_cptr vp_=vp0+vs_prev; const lds_cptr kq_=kp0+(((t)&3)*SLOTK); \
    bf16x8 ka0=kn0,ka1=kn1,kb0,kb1; \
    kb0=KL(kq_+2048); kb1=KL(kq_+2560); VRD(0); SBAR(); float sacc=(P0[0]+P0[1]); \
    GAPA(C0=__builtin_amdgcn_mfma_f32_32x32x16_bf16(ka0,qr[0],negm,0,0,0), P0[2],P0[3],P0[4],P0[5],     pw0[0]=PKW(P0,0), pw0[1]=PKW(P0,2), pw0); \
    VRD(4); SBAR(); GAPA(C1=__builtin_amdgcn_mfma_f32_32x32x16_bf16(ka1,qr[0],negm,0,0,0), P0[6],P0[7],P0[8],P0[9],     pw0[2]=PKW(P0,4), pw0[3]=PKW(P0,6), pw0); \
    ka0=KL(kq_+4096); ka1=KL(kq_+4608); VRD(1); SBAR(); GAPA(C0=__builtin_amdgcn_mfma_f32_32x32x16_bf16(kb0,qr[1],C0,0,0,0),   P0[10],P0[11],P0[12],P0[13], pw1[0]=PKW(P0,8), pw1[1]=PKW(P0,10), pw1); \
    VRD(5); SBAR(); GAPA(C1=__builtin_amdgcn_mfma_f32_32x32x16_bf16(kb1,qr[1],C1,0,0,0),   P0[14],P0[15],P1[0],P1[1],   pw1[2]=PKW(P0,12),pw1[3]=PKW(P0,14), pw1); \
    kb0=KL(kq_+6144); kb1=KL(kq_+6656); VRD(2); SBAR(); GAPA(C0=__builtin_amdgcn_mfma_f32_32x32x16_bf16(ka0,qr[2],C0,0,0,0),   P1[2],P1[3],P1[4],P1[5],     pw2[0]=PKW(P1,0), pw2[1]=PKW(P1,2), pw2); \
    VRD(6); SBAR(); GAPA(C1=__builtin_amdgcn_mfma_f32_32x32x16_bf16(ka1,qr[2],C1,0,0,0),   P1[6],P1[7],P1[8],P1[9],     pw2[2]=PKW(P1,4), pw2[3]=PKW(P1,6), pw2); \
    VRD(3); SBAR(); GAPA(C0=__builtin_amdgcn_mfma_f32_32x32x16_bf16(kb0,qr[3],C0,0,0,0),   P1[10],P1[11],P1[12],P1[13], pw3[0]=PKW(P1,8), pw3[1]=PKW(P1,10), pw3); \
    VRD(7); SBAR(); GAPA(C1=__builtin_amdgcn_mfma_f32_32x32x16_bf16(kb1,qr[3],C1,0,0,0),   P1[14],P1[15],0.f,0.f,       pw3[2]=PKW(P1,12),pw3[3]=PKW(P1,14), pw3); \
    l_reg+=sacc; \
    if(GK){DMA_K((t)+3);} if(GV){DMA_V((t)+1,vs_next);} \
    CMASK(C0,C1,t); \
    { float a=MX3(C0[0],C0[1],C1[0]),b=MX3(C0[2],C0[3],C1[1]); a=MX3(a,C1[2],C1[3]); \
      _Pragma("unroll") for(int r=4;r<16;r+=4){a=MX3(a,C0[r],C0[r+1]);b=MX3(b,C0[r+2],C0[r+3]);a=MX3(a,C1[r],C1[r+1]);b=MX3(b,C1[r+2],C1[r+3]);} \
      float rm=__builtin_fmaxf(a,b); { auto rr=__builtin_amdgcn_permlane32_swap(__float_as_uint(rm),__float_as_uint(rm),false,false); rm=__builtin_fmaxf(__uint_as_float(rr[0]),__uint_as_float(rr[1])); } \
      resc=false; \
      if(__builtin_expect(__any(rm>(float)THRL),0)){ const float dl=__builtin_fmaxf(rm,0.f); mhat+=dl; \
        _Pragma("unroll") for(int r=0;r<16;++r){C0[r]-=dl;C1[r]-=dl;} \
        _Pragma("unroll") for(int r=0;r<16;++r)negm[r]=-mhat; asm volatile("":"+v"(negm)); \
        const float f=__builtin_amdgcn_exp2f(-dl); l_reg*=f; if(hi==0)wsf[r32]=f; resc=true; } } \
    SBAR(); \
    GAPB(o[0]=__builtin_amdgcn_mfma_f32_32x32x16_bf16(PAF(0),VFR(0),o[0],0,0,0), C0,0);  VRH(0); \
    GAPB(o[1]=__builtin_amdgcn_mfma_f32_32x32x16_bf16(PAF(0),VFR(4),o[1],0,0,0), C0,2);  VRH(4); \
    GAPB(o[0]=__builtin_amdgcn_mfma_f32_32x32x16_bf16(PAF(1),VFR(1),o[0],0,0,0), C0,4);  VRH(1); \
    GAPB(o[1]=__builtin_amdgcn_mfma_f32_32x32x16_bf16(PAF(1),VFR(5),o[1],0,0,0), C0,6);  VRH(5); \
    GAPB(o[0]=__builtin_amdgcn_mfma_f32_32x32x16_bf16(PAF(2),VFR(2),o[0],0,0,0), C0,8);  VRH(2); \
    GAPB(o[1]=__builtin_amdgcn_mfma_f32_32x32x16_bf16(PAF(2),VFR(6),o[1],0,0,0), C0,10); VRH(6); \
    GAPB(o[0]=__builtin_amdgcn_mfma_f32_32x32x16_bf16(PAF(3),VFR(3),o[0],0,0,0), C0,12); VRH(3); \
    GAPB(o[1]=__builtin_amdgcn_mfma_f32_32x32x16_bf16(PAF(3),VFR(7),o[1],0,0,0), C0,14); VRH(7); \
    GAPB(o[2]=__builtin_amdgcn_mfma_f32_32x32x16_bf16(PAF(0),VFR(0),o[2],0,0,0), C1,0); \
    GAPB(o[3]=__builtin_amdgcn_mfma_f32_32x32x16_bf16(PAF(0),VFR(4),o[3],0,0,0), C1,2); \
    if(GL){ kn0=KL(kp0+((((t)+1)&3)*SLOTK)); kn1=KL(kp0+((((t)+1)&3)*SLOTK)+512); SBAR(); } \
    GAPB(o[2]=__builtin_amdgcn_mfma_f32_32x32x16_bf16(PAF(1),VFR(1),o[2],0,0,0), C1,4); \
    GAPB(o[3]=__builtin_amdgcn_mfma_f32_32x32x16_bf16(PAF(1),VFR(5),o[3],0,0,0), C1,6); \
    GAPB(o[2]=__builtin_amdgcn_mfma_f32_32x32x16_bf16(PAF(2),VFR(2),o[2],0,0,0), C1,8); \
    GAPB(o[3]=__builtin_amdgcn_mfma_f32_32x32x16_bf16(PAF(2),VFR(6),o[3],0,0,0), C1,10); \
    GAPB(o[2]=__builtin_amdgcn_mfma_f32_32x32x16_bf16(PAF(3),VFR(3),o[2],0,0,0), C1,12); \
    GAPB(o[3]=__builtin_amdgcn_mfma_f32_32x32x16_bf16(PAF(3),VFR(7),o[3],0,0,0), C1,14); \
    }while(0)
  int t=1;
  #undef CMASK
  #define CMASK(P0,P1,t) do{}while(0)
  for(;t+5<NT;t+=2){
    STEP(pB0,pB1,pA0,pA1,t,true,true,true);     WAIT_BAR(3); RESC(); ROT();
    STEP(pA0,pA1,pB0,pB1,t+1,true,true,true);   WAIT_BAR(3); RESC(); ROT();
  }
  #undef CMASK
  #define CMASK(P0,P1,t) do{int jb_=(t)-(NT-4); if(jb_>=0)cmask(P0,P1,jb_,qrel,hi);}while(0)
  #define ENDW(tt) do{ if((tt)+3<NT){WAIT_BAR(3);} else if((tt)+2<NT){WAIT_BAR(2);} else {WAIT_BAR(0);} }while(0)
  for(;t+1<NT;t+=2){
    STEP(pB0,pB1,pA0,pA1,t,(t+3<NT),(t+1<NT),(t+1<NT));       ENDW(t);   RESC(); ROT();
    STEP(pA0,pA1,pB0,pB1,t+1,(t+4<NT),(t+2<NT),(t+2<NT));     ENDW(t+1); RESC(); ROT();
  }
  STEP(pB0,pB1,pA0,pA1,NT-1,false,false,false); RESC();
  { float sacc=pB0[0]+pB0[1]; _Pragma("unroll") for(int r=2;r<16;++r)sacc+=pB0[r]; _Pragma("unroll") for(int r=0;r<16;++r)sacc+=pB1[r]; l_reg+=sacc;
    pw0=(u32x4){PKW(pB0,0),PKW(pB0,2),PKW(pB0,4),PKW(pB0,6)};pw1=(u32x4){PKW(pB0,8),PKW(pB0,10),PKW(pB0,12),PKW(pB0,14)};pw2=(u32x4){PKW(pB1,0),PKW(pB1,2),PKW(pB1,4),PKW(pB1,6)};pw3=(u32x4){PKW(pB1,8),PKW(pB1,10),PKW(pB1,12),PKW(pB1,14)};
    SBAR(); pv4(o,(int)(unsigned)(uintptr_t)vp0+vs_cur,PAF(0),PAF(1),PAF(2),PAF(3)); }
  #undef PKW
  #undef PAF
  #undef VFR
  #undef PIN
  #undef MX3
  #undef GAPA
  #undef GAPB
  #undef EX
  #undef VRD
  #undef VRH
  #undef STEP
  #undef ENDW
  {auto rr=__builtin_amdgcn_permlane32_swap(__float_as_uint(l_reg),__float_as_uint(l_reg),false,false);l_reg=__uint_as_float(rr[0])+__uint_as_float(rr[1]);}
  if(hi==0)wsf[32+r32]=l_reg;asm volatile("s_waitcnt lgkmcnt(0)":::"memory");
  float rli[16];
  #pragma unroll
  for(int r=0;r<16;++r)rli[r]=__builtin_amdgcn_rcpf(wsf[32+crow(r,hi)]);
  bf16*Ow=O+(rowbase+q0+wid*QBLK)*DM+oc;
  bf16*stg=(bf16*)(shm+A2_OST)+wid*2048;
  if(MODE==0){
    #pragma unroll
    for(int hf=0;hf<2;++hf){
      #pragma unroll
      for(int r=0;r<16;++r){const int orow=crow(r,hi);
        #pragma unroll
        for(int d0=0;d0<2;++d0)stg[orow*64+d0*32+r32]=__float2bfloat16(o[2*hf+d0][r]*rli[r]);}
      asm volatile("s_waitcnt lgkmcnt(0)":::"memory");
      #pragma unroll
      for(int i=0;i<4;++i){const int row=i*8+(lane>>3),ch=lane&7; const u32x4 v=*(const u32x4*)(stg+row*64+ch*8); ATTN_STORE16(Ow+(long)row*DM+hf*64+ch*8,v);}
      asm volatile("s_waitcnt lgkmcnt(0)":::"memory"); }
  } else {
    const bf16*O1w=Ow-128; bf16*Aw=(bf16*)((char*)O+A_OFF)+(rowbase+q0+wid*QBLK)*DM+(oc>>8)*128; const float*subln=(const float*)((const char*)O+SG_OFF); const float lam=subln[128];
    asm volatile("s_waitcnt vmcnt(0)":::"memory");
    float dv[2][4][8]; float ssq[4]={0.f,0.f,0.f,0.f};
    #pragma unroll
    for(int hf=0;hf<2;++hf){
      #pragma unroll
      for(int r=0;r<16;++r){const int orow=crow(r,hi);
        #pragma unroll
        for(int d0=0;d0<2;++d0)stg[orow*64+d0*32+r32]=__float2bfloat16(o[2*hf+d0][r]*rli[r]);}
      asm volatile("s_waitcnt lgkmcnt(0)":::"memory");
      #pragma unroll
      for(int i=0;i<4;++i){const int row=i*8+(lane>>3),ch=lane&7; const u32x4 v=*(const u32x4*)(stg+row*64+ch*8); const u32x4 a=*(const u32x4*)(O1w+(long)row*DM+hf*64+ch*8);
        #pragma unroll
        for(int j=0;j<4;++j){ const float d0_=__uint_as_float(a[j]<<16)-lam*__uint_as_float(v[j]<<16), d1_=__uint_as_float(a[j]&0xffff0000u)-lam*__uint_as_float(v[j]&0xffff0000u);
          dv[hf][i][2*j]=d0_; dv[hf][i][2*j+1]=d1_; ssq[i]+=d0_*d0_+d1_*d1_; } }
      asm volatile("s_waitcnt lgkmcnt(0)":::"memory"); }
    #pragma unroll
    for(int i=0;i<4;++i){ float q_=ssq[i]; q_+=__shfl_xor(q_,1); q_+=__shfl_xor(q_,2); q_+=__shfl_xor(q_,4); ssq[i]=1.0f/sqrtf(q_*(1.f/128.f)+1e-6f); }
    #pragma unroll
    for(int hf=0;hf<2;++hf){ const int ch=lane&7;
      const f32x4_t g0=*(const f32x4_t*)(subln+hf*64+ch*8), g1=*(const f32x4_t*)(subln+hf*64+ch*8+4);
      #pragma unroll
      for(int i=0;i<4;++i){const int row=i*8+(lane>>3); const float r_=ssq[i]; u32x4 w;
        w[0]=cvtpk_s(dv[hf][i][0]*r_*g0[0],dv[hf][i][1]*r_*g0[1]); w[1]=cvtpk_s(dv[hf][i][2]*r_*g0[2],dv[hf][i][3]*r_*g0[3]);
        w[2]=cvtpk_s(dv[hf][i][4]*r_*g1[0],dv[hf][i][5]*r_*g1[1]); w[3]=cvtpk_s(dv[hf][i][6]*r_*g1[2],dv[hf][i][7]*r_*g1[3]);
        ATTN_STORE16(Aw+(long)row*DM+hf*64+ch*8,w);} }
  }
  asm volatile("s_waitcnt lgkmcnt(0)\n\ts_barrier":::"memory");
  #undef DMA_K
  #undef DMA_V
  #undef CMASK
  #undef START
  #undef RESC
  #undef ROT
}
#undef SBAR
#undef WAIT_BAR
}

constexpr int NWAVES = 8;
constexpr int NB = 8, SEQ = 4096, DMODEL = 1024, NTOK = NB * SEQ;
constexpr int DINP = 2048, NEXP = 32, TOPK = 4, PLE = 256;
constexpr float EPS = 1e-6f;
constexpr int PMAXROWS = NTOK * TOPK + NEXP * 256;

constexpr size_t MiB = 1u << 20, KiB = 1u << 10;
constexpr size_t WS_CTL = 0, CTL_ZERO_BYTES = 192 * KiB;
constexpr size_t WS_SS = 64 * KiB;
constexpr size_t WS_TOKE = 192 * KiB, WS_TOKG = WS_TOKE + 512 * KiB, WS_TOKP = WS_TOKG + 512 * KiB;
constexpr size_t WS_WRS = 2304 * KiB;
constexpr size_t WS_SG = 2432 * KiB;
constexpr size_t WS_CS = 4 * MiB;
constexpr size_t WS_WGU = 6 * MiB;
constexpr size_t WS_WD = 70 * MiB;
constexpr size_t WS_WG = 102 * MiB;
constexpr size_t WS_WP = 104 * MiB;
constexpr size_t WS_XN = 105 * MiB;
constexpr size_t WS_R = 169 * MiB;
constexpr size_t WS_QK = WS_R, WS_VU = WS_R + 64 * MiB, WS_ACAT = WS_R + 128 * MiB, WS_O16 = WS_R + 192 * MiB, WS_WIN = WS_R + 256 * MiB, WS_WOUT = WS_R + 260 * MiB;
constexpr size_t WS_HDN = 137 * MiB;
constexpr size_t WS_Y = 273 * MiB;
constexpr size_t WS_XN3 = 137 * MiB, WS_PB = 432 * MiB, WS_ER = 448 * MiB;
constexpr size_t WS_END = WS_Y + 128 * MiB;
constexpr size_t WS_H2B = 169 * MiB;
constexpr size_t WS_TOP = 522 * MiB;
constexpr size_t WS_ELIST = 520 * MiB;
static_assert(WS_END <= WS_PB && WS_ER + 64 * MiB <= 560 * MiB && WS_WOUT + 2 * MiB <= WS_PB && WS_END <= 560 * MiB && WS_WOUT + 2 * MiB <= 560 * MiB && WS_HDN + (size_t)PMAXROWS * 1024 <= WS_Y, "d_ws map");
constexpr int CW_CNT = 0;
constexpr int CW_BAR = 1024;

constexpr int RING_OFF = 0, RING_BYTES = 131072;
constexpr int LDSCTL_OFF = RING_BYTES;
constexpr int TBL_OFF = LDSCTL_OFF + 512;
constexpr int TILE_E_OFF = LDSCTL_OFF + 1024;
constexpr int MAXU = 18;
constexpr int UROW_OFF = LDSCTL_OFF + 2048;
constexpr int UBIAS_OFF = UROW_OFF + MAXU * 512;
constexpr int LDS_BYTES = 163840;
static_assert(UBIAS_OFF + MAXU * 1024 <= LDS_BYTES, "LDS map");

#define GAS __attribute__((address_space(1)))
#define LAS __attribute__((address_space(3)))
typedef unsigned short bf16;
typedef unsigned v4u __attribute__((ext_vector_type(4)));
typedef unsigned v2u __attribute__((ext_vector_type(2)));
typedef float f32x4 __attribute__((ext_vector_type(4)));
typedef float f32x16 __attribute__((ext_vector_type(16)));
#define LDS_WAIT() asm volatile("s_waitcnt lgkmcnt(0)" ::: "memory")
#define VM_WAIT() asm volatile("s_waitcnt vmcnt(0)" ::: "memory")
__device__ __forceinline__ unsigned f2bf(float f) { unsigned u = __builtin_bit_cast(unsigned, f); return (u + 0x7fffu + ((u >> 16) & 1u)) >> 16; }
__device__ __forceinline__ unsigned pk2(float lo, float hi) { return f2bf(lo) | (f2bf(hi) << 16); }
__device__ __forceinline__ float bflo(unsigned w) { return __uint_as_float(w << 16); }
__device__ __forceinline__ float bfhi(unsigned w) { return __uint_as_float(w & 0xffff0000u); }
typedef float f32x2 __attribute__((ext_vector_type(2)));
__device__ __forceinline__ f32x4 fp8x4_to_f32(unsigned w) { const f32x2 lo = __builtin_amdgcn_cvt_pk_f32_fp8((int)w, false), hi = __builtin_amdgcn_cvt_pk_f32_fp8((int)w, true); return (f32x4){lo.x, lo.y, hi.x, hi.y}; }
__device__ __forceinline__ float wave_sum(float v) {
#pragma unroll
    for (int o = 1; o < 64; o <<= 1) v += __shfl_xor(v, o);
    return v;
}


#define XB_TMO      128
#define XB_XCNT(j)  (256  + 64 * (j))
#define XB_XSUB(j)  (1280 + 64 * (j))
#define XB_XGEN(j)  (2304 + 64 * (j))
#define XB_TOP      3328
#define XB_TOPGEN   3392
#define XCD_BAR_WORDS 3456
#define XB_SPIN_CAP (1u << 22)
__device__ __forceinline__ unsigned xb_ld(unsigned* p)              { return __hip_atomic_load(p, __ATOMIC_RELAXED, __HIP_MEMORY_SCOPE_AGENT); }
__device__ __forceinline__ unsigned xb_add(unsigned* p, unsigned v) { return __hip_atomic_fetch_add(p, v, __ATOMIC_RELAXED, __HIP_MEMORY_SCOPE_AGENT); }
__device__ __forceinline__ unsigned xb_xcc_id() { return (unsigned)__builtin_amdgcn_s_getreg((3 << 11) | 20) & 0xFu; }
#define XB_SPIN(cond, bar) do { unsigned _sp = 0; while (cond) { __builtin_amdgcn_s_sleep(1); \
    if ((++_sp & 255u) == 0u) { if (xb_ld(&(bar)[XB_TMO])) break; if (_sp > XB_SPIN_CAP) { atomicAdd(&(bar)[XB_TMO], 1u); break; } } } } while (0)
struct XcdBarrier { unsigned* bar; unsigned x; volatile LAS unsigned* st; };
__device__ __forceinline__ XcdBarrier xcd_barrier_post(unsigned* bar, volatile LAS unsigned* st) {
    XcdBarrier b; b.bar = bar; b.x = xb_xcc_id(); b.st = st;
    if (threadIdx.x == 0) (void)xb_add(&bar[XB_XCNT(b.x)], 1u);
    return b;
}
__device__ __forceinline__ void xcd_barrier_complete(unsigned* bar, unsigned x, unsigned& nloc, unsigned& nx) {
    const unsigned G = gridDim.x * gridDim.y * gridDim.z;
    unsigned sum, cnt, mine, sp = 0u;
    for (;;) {
        sum = 0u; cnt = 0u; mine = 0u;
#pragma unroll
        for (unsigned j = 0; j < 16; ++j) { const unsigned c = xb_ld(&bar[XB_XCNT(j)]); sum += c; cnt += (c > 0u) ? 1u : 0u; mine = (j == x) ? c : mine; }
        if (sum == G) break;
        __builtin_amdgcn_s_sleep(1);
        if ((++sp & 255u) == 0u) { if (xb_ld(&bar[XB_TMO])) break; if (sp > XB_SPIN_CAP) { atomicAdd(&bar[XB_TMO], 1u); break; } }
    }
    nloc = mine > 0u ? mine : 1u; nx = cnt > 0u ? cnt : 1u;
}
__device__ __forceinline__ void xcd_barrier(const XcdBarrier& b) {
    asm volatile("s_waitcnt vmcnt(0)" ::: "memory");
    __syncthreads();
    if (threadIdx.x == 0) {
        unsigned* bar = b.bar;
        __builtin_amdgcn_s_waitcnt(0);
        unsigned nloc = b.st[0], nx = b.st[1];
        if (nloc == 0u) { xcd_barrier_complete(bar, b.x, nloc, nx); b.st[0] = nloc; b.st[1] = nx; }
        const unsigned old = xb_add(&bar[XB_XSUB(b.x)], 1u);
        const unsigned gen = old / nloc;
        if (old + 1u == (gen + 1u) * nloc) {
            __builtin_amdgcn_fence(__ATOMIC_RELEASE, "agent");
            asm volatile("s_waitcnt vmcnt(0)" ::: "memory");
            const unsigned og = xb_add(&bar[XB_TOP], 1u);
            const unsigned tg = og / nx;
            if (og + 1u == (tg + 1u) * nx) xb_add(&bar[XB_TOPGEN], 1u);
            else XB_SPIN(xb_ld(&bar[XB_TOPGEN]) == tg, bar);
            __builtin_amdgcn_fence(__ATOMIC_ACQUIRE, "agent");
            xb_add(&bar[XB_XGEN(b.x)], 1u);
            asm volatile("s_waitcnt vmcnt(0)" ::: "memory");
        } else {
            XB_SPIN(xb_ld(&bar[XB_XGEN(b.x)]) == gen, bar);
            __builtin_amdgcn_fence(__ATOMIC_ACQUIRE, "agent");
            asm volatile("s_waitcnt vmcnt(0)" ::: "memory");
        }
    }
    __syncthreads();
}

struct Args { const float* in[28]; float* out; unsigned char* ws; };
enum { I_X = 0, I_P, I_POS, I_ATTN_NORM, I_WIN, I_QNORM, I_KNORM, I_LQ1, I_LK1, I_LQ2, I_LK2, I_SUBLN, I_WPOOL, I_PSCALE, I_WOUT, I_FFN_NORM, I_WROUTER, I_BROUTER,
       I_WGATE, I_BGATE, I_WUP, I_BUP, I_WDOWN, I_BDOWN, I_PLE_GNORM, I_WPLE_GATE, I_WPLE_PROJ, I_PLE_PNORM };

__device__ __forceinline__ void tr_load(const float* W, int ldw, int k0, int n0, LAS float* scr, int lane) {
    float t[32];
#pragma unroll
    for (int i = 0; i < 32; ++i) t[i] = __builtin_nontemporal_load(W + (size_t)(k0 + 2 * i + (lane >> 5)) * ldw + n0 + (lane & 31));
#pragma unroll
    for (int i = 0; i < 32; ++i) scr[(2 * i + (lane >> 5)) * 33 + (lane & 31)] = t[i];
    LDS_WAIT(); asm volatile("" ::: "memory");
}
__device__ __forceinline__ void tr_item(const float* W, int ldw, int k0, int n0, bf16* WT, int ldt, int drow0, int dcol0, LAS float* scr, int lane) {
    tr_load(W, ldw, k0, n0, scr, lane);
    const int c = lane & 7;
#pragma unroll
    for (int j = 0; j < 4; ++j) { const int n = (lane >> 3) + 8 * j; const LAS float* s = scr + (8 * c) * 33 + n;
        v4u o; o.x = pk2(s[0 * 33], s[1 * 33]); o.y = pk2(s[2 * 33], s[3 * 33]); o.z = pk2(s[4 * 33], s[5 * 33]); o.w = pk2(s[6 * 33], s[7 * 33]);
        *(GAS v4u*)(WT + (size_t)(drow0 + n) * ldt + dcol0 + k0 + 8 * c) = o; }
    LDS_WAIT(); asm volatile("" ::: "memory");
}
__device__ __forceinline__ void tr_item8(const float* W, int ldw, int k0, int n0, unsigned char* WT, int ldt, int drow0, float sc, LAS float* scr, int lane) {
    tr_load(W, ldw, k0, n0, scr, lane);
    const int c = lane & 7;
#pragma unroll
    for (int j = 0; j < 4; ++j) { const int n = (lane >> 3) + 8 * j; const LAS float* s = scr + (8 * c) * 33 + n;
        v2u o; o.x = pg8::pk4_fp8(s[0 * 33] * sc, s[1 * 33] * sc, s[2 * 33] * sc, s[3 * 33] * sc); o.y = pg8::pk4_fp8(s[4 * 33] * sc, s[5 * 33] * sc, s[6 * 33] * sc, s[7 * 33] * sc);
        *(GAS v2u*)(WT + (size_t)(drow0 + n) * ldt + k0 + 8 * c) = o; }
    LDS_WAIT(); asm volatile("" ::: "memory");
}

struct MoeOrder {
    const LAS int* tbl;
    const LAS unsigned char* te;
    int tile0, ntile, npn, G, vc; bool gu;
    __device__ __forceinline__ bool next(int i, pg8::Unit& u) const {
        const int U = i * G + vc; if (U >= ntile * npn) return false;
        const int tl = U / npn, pn = U - tl * npn, tau = tile0 + tl;
        const int e = (int)te[tau];
        const int tloc = tau - tbl[32 + e];
        u.e = e; u.pn = pn; u.tb = e * npn + pn; u.ord = i;
        if (gu) { u.ta = tau; u.pm = tau; u.nv = 256; }
        else { u.ta = tau; u.pm = tbl[65 + e] + tloc * 256; const int rem = tbl[e] - tloc * 256; u.nv = rem < 256 ? rem : 256; }
        return true;
    }
};

__global__ void __launch_bounds__(NWAVES * 64, 2) mk_fwd(Args args) {
    extern __shared__ __attribute__((aligned(16))) unsigned char lds[];
    cg::grid_group grid = cg::this_grid();
    LAS unsigned char* L = (LAS unsigned char*)lds;
    const int wave = __builtin_amdgcn_readfirstlane(threadIdx.x >> 6);
    const int G = gridDim.x;
    const int vcu = (G % 8 == 0) ? ((int)blockIdx.x % 8) * (G / 8) + (int)blockIdx.x / 8 : (int)blockIdx.x;
    const int gw = vcu * NWAVES + wave, NGW = G * NWAVES;
    unsigned char* ws = args.ws;
    unsigned* ctl = (unsigned*)(ws + WS_CTL);
    float* out = args.out;
    LAS int* tbl = (LAS int*)(L + TBL_OFF);
    LAS unsigned char* tile_e = (LAS unsigned char*)(L + TILE_E_OFF);
    volatile LAS unsigned* MISC = (volatile LAS unsigned*)(L + LDSCTL_OFF);
    if (threadIdx.x < 64) MISC[threadIdx.x] = 0u;
    __syncthreads();
    XcdBarrier xbar = xcd_barrier_post(ctl + CW_BAR, MISC + 8);
#define GRID_BAR() do { xcd_barrier(xbar); } while (0)

    {
        const int tid = pg8::tid_opaque(), lane = tid & 63;
        LAS float* scr = (LAS float*)(L + RING_OFF + wave * 16384);
        constexpr int IT_WIN = 16 * 64, IT_WOUT = 8 * 32, IT_EXP = 512, IT_WG = 512, IT_WP = 4 * 32;
        constexpr int NITEMS = IT_WIN + IT_WOUT + NEXP * 3 * IT_EXP + IT_WG + IT_WP;
        for (int it = gw; it < NITEMS; it += NGW) {
            int r = it;
            if (r < IT_WIN) { const int kb = r / 64, nb = r % 64; tr_item(args.in[I_WIN], DINP, 64 * kb, 32 * nb, (bf16*)(ws + WS_WIN), 1024, 32 * nb, 0, scr, lane); continue; } r -= IT_WIN;
            if (r < IT_WOUT) { const int kb = r / 32, nb = r % 32; tr_item(args.in[I_WOUT], 1024, 64 * kb, 32 * nb, (bf16*)(ws + WS_WOUT), 1024, 32 * nb, 0, scr, lane); continue; } r -= IT_WOUT;
            if (r < NEXP * 3 * IT_EXP) {
                const int e = r / (3 * IT_EXP), rr = r % (3 * IT_EXP), mat = rr / IT_EXP, q = rr % IT_EXP, kb = q / 32, nb = q % 32, n0 = 32 * nb;
                if (mat == 2) tr_item8(args.in[I_WDOWN] + (size_t)e * 1024 * 1024, 1024, 64 * kb, n0, ws + WS_WD, 1024, e * 1024 + n0, 32.0f, scr, lane);
                else tr_item8(args.in[mat == 0 ? I_WGATE : I_WUP] + (size_t)e * 1024 * 1024, 1024, 64 * kb, n0, ws + WS_WGU, 1024, e * 2048 + (n0 >> 7) * 256 + mat * 128 + (n0 & 127), 32.0f, scr, lane);
                continue; } r -= NEXP * 3 * IT_EXP;
            if (r < IT_WG) { const int kb = r / 32, nb = r % 32; tr_item8(args.in[I_WPLE_GATE], 1024, 64 * kb, 32 * nb, ws + WS_WG, 1024, 32 * nb, 32.0f, scr, lane); continue; } r -= IT_WG;
            { const int kb = r / 32, nb = r % 32; tr_item(args.in[I_WPLE_PROJ], 1024, 64 * kb, 32 * nb, (bf16*)(ws + WS_WP), 256, 32 * nb, 0, scr, lane); }
        }
        {
            const float* wpool = args.in[I_WPOOL]; const float* ps = args.in[I_PSCALE]; const float* wout = args.in[I_WOUT]; bf16* WT = (bf16*)(ws + WS_WOUT);
            for (int tile = wave * G + vcu; tile < 16 * 32; tile += NWAVES * G) {
                const int gc0 = (tile >> 5) * 32, n0 = (tile & 31) * 32, g = gc0 >> 7, hf = lane >> 5, li = lane & 31;
                const float* ap = wpool + (size_t)(gc0 + li) * 128 + 64 * hf; const float* pp = ps + g * 128 + 64 * hf;
                const float* bp = wout + (size_t)(512 + g * 128 + 64 * hf) * 1024 + n0 + li;
                f32x16 acc = f32x16{};
#pragma unroll 8
                for (int q = 0; q < 16; ++q) {
                    const f32x4 a4 = *(const GAS f32x4*)(ap + 4 * q), p4 = *(const GAS f32x4*)(pp + 4 * q);
                    const float b0 = bp[(size_t)(4 * q + 0) * 1024], b1 = bp[(size_t)(4 * q + 1) * 1024], b2 = bp[(size_t)(4 * q + 2) * 1024], b3 = bp[(size_t)(4 * q + 3) * 1024];
                    acc = __builtin_amdgcn_mfma_f32_32x32x2f32(a4.x * p4.x, b0, acc, 0, 0, 0);
                    acc = __builtin_amdgcn_mfma_f32_32x32x2f32(a4.y * p4.y, b1, acc, 0, 0, 0);
                    acc = __builtin_amdgcn_mfma_f32_32x32x2f32(a4.z * p4.z, b2, acc, 0, 0, 0);
                    acc = __builtin_amdgcn_mfma_f32_32x32x2f32(a4.w * p4.w, b3, acc, 0, 0, 0);
                }
#pragma unroll
                for (int r4 = 0; r4 < 4; ++r4) { v2u w; w.x = pk2(acc[4 * r4], acc[4 * r4 + 1]); w.y = pk2(acc[4 * r4 + 2], acc[4 * r4 + 3]);
                    *(GAS v2u*)(WT + (size_t)(n0 + li) * 1024 + 512 + gc0 + 8 * r4 + 4 * hf) = w; }
            }
        }
        if (gw == 0) { float* SG = (float*)(ws + WS_SG); SG[lane] = args.in[I_SUBLN][lane] * 0.8f; SG[64 + lane] = args.in[I_SUBLN][64 + lane] * 0.8f;
            const float s1 = wave_sum(args.in[I_LQ1][lane] * args.in[I_LK1][lane]), s2 = wave_sum(args.in[I_LQ2][lane] * args.in[I_LK2][lane]); if (lane == 0) SG[128] = expf(s1) - expf(s2) + 0.2f; }
        { const float* wr = args.in[I_WROUTER]; const float* fn = args.in[I_FFN_NORM]; bf16* WRh = (bf16*)(ws + WS_WRS); bf16* WRl = WRh + 32 * 1024;
          for (int idx = blockIdx.x * 512 + tid; idx < 1024 * 32; idx += G * 512) {
              const int j = idx & 7, e = (idx >> 3) & 31, hf_ = (idx >> 8) & 1, q = (idx >> 9) & 31, kh_ = idx >> 14, k = 512 * kh_ + 16 * q + 8 * hf_ + j; const float v = wr[k * 32 + e] * fn[k];
              const unsigned h = f2bf(v); WRh[idx] = (bf16)h; WRl[idx] = (bf16)f2bf(v - __uint_as_float(h << 16)); } }
        { const int* pos = (const int*)args.in[I_POS]; float* cs = (float*)(ws + WS_CS);
          for (int idx = blockIdx.x * 512 + tid; idx < NTOK * 8; idx += G * 512) {
              const int t = idx >> 3, i = idx & 7;
              const float fr = i == 0 ? 1.0f : i == 1 ? 0.1939227432012558f : i == 2 ? 0.03760603070259094f : i == 3 ? 0.007292664609849453f : i == 4 ? 0.0014142135623842478f :
                               i == 5 ? 0.00027424818836152554f : i == 6 ? 5.318296098266728e-05f : 1.0313386155758053e-05f;
              const float ang = (float)pos[t] * fr;
              const double a = (double)ang, k = __builtin_rint(a * 0.15915494309189535), rr = a - k * 6.283185307179586;
              const float rf = (float)rr;
              cs[t * 16 + i] = cosf(rf); cs[t * 16 + 8 + i] = sinf(rf);
          } }
        { const float* x = args.in[I_X]; const float* gn = args.in[I_ATTN_NORM]; bf16* XN = (bf16*)(ws + WS_XN);
          f32x4 gg[4];
#pragma unroll
          for (int j = 0; j < 4; ++j) gg[j] = *((const GAS f32x4*)gn + lane + 64 * j);
          for (int m0 = gw; m0 < NTOK; m0 += 2 * NGW) {
              f32x4 v[2][4]; float s[2] = {0.f, 0.f};
#pragma unroll
              for (int u = 0; u < 2; ++u) { const int m = (m0 + u * NGW < NTOK) ? m0 + u * NGW : m0; const GAS f32x4* xr = (const GAS f32x4*)(x + (size_t)m * 1024) + lane;
#pragma unroll
                  for (int j = 0; j < 4; ++j) v[u][j] = xr[64 * j]; }
#pragma unroll
              for (int u = 0; u < 2; ++u) {
#pragma unroll
                  for (int j = 0; j < 4; ++j) s[u] += (v[u][j].x * v[u][j].x + v[u][j].y * v[u][j].y) + (v[u][j].z * v[u][j].z + v[u][j].w * v[u][j].w); }
#pragma unroll
              for (int u = 0; u < 2; ++u) { const int m = m0 + u * NGW; if (m < NTOK) {
                  const float r = 1.0f / sqrtf(wave_sum(s[u]) * (1.f / 1024.f) + EPS);
                  GAS unsigned long long* o8 = (GAS unsigned long long*)(XN + (size_t)m * 1024) + lane;
#pragma unroll
                  for (int j = 0; j < 4; ++j) o8[64 * j] = (unsigned long long)pk2(v[u][j].x * r * gg[j].x, v[u][j].y * r * gg[j].y) | ((unsigned long long)pk2(v[u][j].z * r * gg[j].z, v[u][j].w * r * gg[j].w) << 32); } }
          } }
        { const int tid = pg8::tid_opaque();
        const float* p = args.in[I_P]; bf16* PB = (bf16*)(ws + WS_PB);
        for (size_t idx = (size_t)blockIdx.x * 512 + tid; idx < (size_t)NTOK * PLE / 4; idx += (size_t)G * 512) {
            const f32x4 a = *((const GAS f32x4*)p + idx); v2u w; w.x = pk2(a.x, a.y); w.y = pk2(a.z, a.w); *((GAS v2u*)PB + idx) = w; }
        }
    }
    grid.sync();


    {
        pg8::Gemm g{(const pg8::bf16_t*)(ws + WS_XN), (const pg8::bf16_t*)(ws + WS_WIN), 1024, nullptr}; pg8::StaticOrder S; S.init(NTOK, DINP, G, (int)blockIdx.x);
        pg8::EpiQKVU E{(pg8::bf16_t*)(ws + WS_QK), (pg8::bf16_t*)(ws + WS_VU), (const float*)(ws + WS_CS), args.in[I_QNORM], args.in[I_KNORM], attn_body::C2};
        pg8::gemm_phase<pg8::EpiQKVU, pg8::StaticOrder, false, true, false, true>(L + RING_OFF, g, S, E);
    }
    {
        pg8::Gemm g{(const pg8::bf16_t*)(ws + WS_PB), (const pg8::bf16_t*)(ws + WS_WP), 256, nullptr}; pg8::StaticOrder S; S.init(NTOK, 1024, G, (int)blockIdx.x);
        pg8::EpiBf16 E{(pg8::bf16_t*)(ws + WS_ER), 1024, nullptr, 0, 0, (float*)(ws + WS_SS)};
        pg8::gemm_phase<pg8::EpiBf16, pg8::StaticOrder, false, true>(L + RING_OFF, g, S, E);
    }
    GRID_BAR();

    {
        const int tid = pg8::tid_opaque(), lane = tid & 63;
        const bf16* VU = (const bf16*)(ws + WS_VU); bf16* ACAT = (bf16*)(ws + WS_ACAT);
        const int grp = lane >> 4, w = 2 << grp;
        for (int chunk = gw; chunk < NTOK / 16; chunk += NGW) {
            const int m0 = chunk * 16, t0 = m0 & (SEQ - 1);
            v4u rows[31];
#pragma unroll
            for (int k = 0; k < 15; ++k) { rows[k] = (v4u){0u, 0u, 0u, 0u}; if (15 - k < w && t0 > 0) rows[k] = *(const GAS v4u*)(VU + (size_t)(m0 + k - 15) * 1024 + 512 + lane * 8); }
#pragma unroll
            for (int k = 15; k < 31; ++k) rows[k] = *(const GAS v4u*)(VU + (size_t)(m0 + k - 15) * 1024 + 512 + lane * 8);
#pragma unroll
            for (int j = 0; j < 16; ++j) {
                float a2[8], a4[8], a8[8], a16[8], u0[8];
#pragma unroll
                for (int i = 0; i < 8; ++i) { a2[i] = 0.f; }
#pragma unroll
                for (int d = 0; d < 16; ++d) { const v4u r = rows[15 + j - d];
                    const float f[8] = {bflo(r.x), bfhi(r.x), bflo(r.y), bfhi(r.y), bflo(r.z), bfhi(r.z), bflo(r.w), bfhi(r.w)};
#pragma unroll
                    for (int i = 0; i < 8; ++i) { if (d == 0) u0[i] = f[i]; a2[i] += f[i]; if (d == 1) a4[i] = a2[i]; if (d == 3) a8[i] = a2[i]; if (d == 7) a16[i] = a2[i]; } }
                const int t = t0 + j, cnt = (t + 1 < w) ? t + 1 : w; const float ic = 1.0f / (float)cnt;
                float pz[8];
#pragma unroll
                for (int i = 0; i < 8; ++i) { const float sel = grp == 0 ? a4[i] : grp == 1 ? a8[i] : grp == 2 ? a16[i] : a2[i]; pz[i] = sel * ic - u0[i]; }
                v4u op; op.x = pk2(pz[0], pz[1]); op.y = pk2(pz[2], pz[3]); op.z = pk2(pz[4], pz[5]); op.w = pk2(pz[6], pz[7]);
                *(GAS v4u*)(ACAT + (size_t)(m0 + j) * 1024 + 512 + lane * 8) = op;
            }
        }
    }
    GRID_BAR();

    {
        const attn_body::bf16* Q = (const attn_body::bf16*)(ws + WS_QK); const attn_body::bf16* V = (const attn_body::bf16*)(ws + WS_VU); attn_body::bf16* O = (attn_body::bf16*)(ws + WS_O16);
        constexpr int NUNITS = NB * 8 * attn_body::NQB;
        const int per = (NUNITS + G - 1) / G;
        for (int u = 0; u < per; ++u) {
            int bh, qb;
            if (G == 256) { bh = vcu >> 3; const int s = vcu & 7; qb = (u < 2) ? s : 15 - s; }
            else { const int P = (u >> 1) * G + vcu; if (P >= NUNITS / 2) break; bh = P & 31; qb = 15 - (P >> 5); }
            const int hc = 2 * (bh & 3) + (u & 1);
            attn2::attn_unit<8, (long)WS_ACAT - (long)WS_O16, (long)WS_SG - (long)WS_O16>(bh >> 2, hc * 64, 512 + hc * 64, (hc >> 1) * 128, hc * 128, qb, Q, Q, V, O, (char*)lds + RING_OFF);
        }
    }
    GRID_BAR();

    {
        pg8::Gemm g{(const pg8::bf16_t*)(ws + WS_ACAT), (const pg8::bf16_t*)(ws + WS_WOUT), 1024, nullptr}; pg8::StaticOrder S; S.init(NTOK, 1024, G, (int)blockIdx.x);
        pg8::EpiResBf16 E{args.in[I_X], (pg8::bf16_t*)out};
        pg8::gemm_phase<pg8::EpiResBf16, pg8::StaticOrder, false, true>(L + RING_OFF, g, S, E);
    }
    GRID_BAR();

    {
        const int tid = pg8::tid_opaque(), lane = tid & 63;
        LAS float* r1s = (LAS float*)(L + RING_OFF);
        LAS int* cntl = (LAS int*)(L + RING_OFF + 512);
        LAS int* basel = (LAS int*)(L + RING_OFF + 640);
        LAS float* Pl = (LAS float*)(L + RING_OFF + 1024);
        const float* fn = args.in[I_FFN_NORM]; const bf16* WRh = (const bf16*)(ws + WS_WRS); const bf16* WRl = WRh + 32 * 1024; unsigned char* XN8 = ws + WS_XN; const bf16* H1B = (const bf16*)out;
        int* toke = (int*)(ws + WS_TOKE); float* tokg = (float*)(ws + WS_TOKG); int* tokp = (int*)(ws + WS_TOKP); unsigned short* elist = (unsigned short*)(ws + WS_ELIST);
        if (tid < 32) cntl[tid] = 0;
        __syncthreads();
        for (int chunk = blockIdx.x; chunk < NTOK / 128; chunk += G) {
            const int tok0 = chunk * 128;
            for (int j0 = 0; j0 < 16; j0 += 4) {
                f32x4 v[4][4];
#pragma unroll
                for (int u = 0; u < 4; ++u) { const GAS v2u* xr = (const GAS v2u*)(H1B + (size_t)(tok0 + wave * 16 + j0 + u) * 1024) + lane;
#pragma unroll
                    for (int q = 0; q < 4; ++q) { const v2u w_ = xr[64 * q]; v[u][q] = (f32x4){bflo(w_.x), bfhi(w_.x), bflo(w_.y), bfhi(w_.y)}; } }
#pragma unroll
                for (int u = 0; u < 4; ++u) { const int m = tok0 + wave * 16 + j0 + u; float s = 0.f;
#pragma unroll
                    for (int q = 0; q < 4; ++q) s += (v[u][q].x * v[u][q].x + v[u][q].y * v[u][q].y) + (v[u][q].z * v[u][q].z + v[u][q].w * v[u][q].w);
                    const float r = 1.0f / sqrtf(wave_sum(s) * (1.f / 1024.f) + EPS);
                    GAS unsigned* o4 = (GAS unsigned*)(XN8 + (size_t)m * 1024) + lane;
#pragma unroll
                    for (int q = 0; q < 4; ++q) { const f32x4 gg = *((const GAS f32x4*)fn + lane + 64 * q);
                        o4[64 * q] = pg8::pk4_fp8(v[u][q].x * r * gg.x, v[u][q].y * r * gg.y, v[u][q].z * r * gg.z, v[u][q].w * r * gg.w); }
                    if (lane == 0) r1s[wave * 16 + j0 + u] = r; }
            }
            {
                const int g = wave & 3, kh = wave >> 2, hf = lane >> 5, li = lane & 31;
                LAS unsigned char* tile = L + RING_OFF + 36864 + wave * 8704;
                const bf16* ablk = H1B + (size_t)(tok0 + 32 * g + (lane >> 4)) * 1024 + kh * 512 + 8 * (lane & 15);
                const bf16* bh = WRh + (size_t)(kh * 32) * 512 + lane * 8; const bf16* bl = WRl + (size_t)(kh * 32) * 512 + lane * 8;
                f32x16 acc = f32x16{};
                v4u R[8];
#pragma unroll
                for (int i = 0; i < 8; ++i) R[i] = *(const GAS v4u*)(ablk + (size_t)(4 * i) * 1024);
                for (int b = 0; b < 4; ++b) {
#pragma unroll
                    for (int i = 0; i < 8; ++i) *(LAS v4u*)(tile + (4 * i + (lane >> 4)) * 272 + 16 * (lane & 15)) = R[i];
                    pg8::bf16x8 wh[8], wl[8];
#pragma unroll
                    for (int s_ = 0; s_ < 8; ++s_) { wh[s_] = *(const GAS pg8::bf16x8*)(bh + (size_t)(8 * b + s_) * 512); wl[s_] = *(const GAS pg8::bf16x8*)(bl + (size_t)(8 * b + s_) * 512); }
                    if (b < 3) {
#pragma unroll
                        for (int i = 0; i < 8; ++i) R[i] = *(const GAS v4u*)(ablk + (size_t)(4 * i) * 1024 + 128 * (b + 1)); }
#pragma unroll
                    for (int s_ = 0; s_ < 8; ++s_) {
                        const pg8::bf16x8 ah = *(const LAS pg8::bf16x8*)(tile + li * 272 + 32 * s_ + 16 * hf);
                        acc = __builtin_amdgcn_mfma_f32_32x32x16_bf16(ah, wl[s_], acc, 0, 0, 0);
                        acc = __builtin_amdgcn_mfma_f32_32x32x16_bf16(ah, wh[s_], acc, 0, 0, 0);
                    }
                }
                LAS float* Pw = Pl + (size_t)((kh * 4 + g) * 32) * 33;
#pragma unroll
                for (int r = 0; r < 16; ++r) Pw[((r & 3) + 8 * (r >> 2) + 4 * hf) * 33 + li] = acc[r];
            }
            __syncthreads();
            int ek[4] = {0, 0, 0, 0}, rk[4] = {0, 0, 0, 0};
            if (tid < 128) {
                const int g = tid >> 5, i = tid & 31; const float r1 = r1s[tid];
                const LAS float* p0 = Pl + (size_t)((0 * 4 + g) * 32 + i) * 33; const LAS float* p1 = Pl + (size_t)((1 * 4 + g) * 32 + i) * 33;
                float v[32];
#pragma unroll
                for (int e = 0; e < 32; ++e) v[e] = (p0[e] + p1[e]) * r1 + args.in[I_BROUTER][e];
                float tv[4];
#pragma unroll
                for (int k = 0; k < 4; ++k) {
                    float best = v[0]; int bi = 0;
#pragma unroll
                    for (int e = 1; e < 32; ++e) { if (v[e] > best) { best = v[e]; bi = e; } }
                    tv[k] = best; ek[k] = bi;
#pragma unroll
                    for (int e = 0; e < 32; ++e) v[e] = (e == bi) ? -INFINITY : v[e];
                }
                const float e1 = expf(tv[1] - tv[0]), e2 = expf(tv[2] - tv[0]), e3 = expf(tv[3] - tv[0]); const float inv = 1.0f / (1.0f + e1 + e2 + e3);
                const float gt[4] = {inv, e1 * inv, e2 * inv, e3 * inv};
#pragma unroll
                for (int k = 0; k < 4; ++k) { rk[k] = atomicAdd((int*)(cntl + ek[k]), 1); toke[(size_t)(tok0 + tid) * 4 + k] = ek[k]; tokg[(size_t)(tok0 + tid) * 4 + k] = gt[k]; }
            }
            __syncthreads();
            if (tid < 32) { basel[tid] = atomicAdd((int*)ctl + CW_CNT + tid, cntl[tid]); cntl[tid] = 0; }
            __syncthreads();
            if (tid < 128) {
#pragma unroll
                for (int k = 0; k < 4; ++k) { const int rank = basel[ek[k]] + rk[k]; tokp[(size_t)(tok0 + tid) * 4 + k] = rank; elist[(size_t)ek[k] * NTOK + rank] = (unsigned short)(tok0 + tid); }
            }
            __syncthreads();
        }
    }
    GRID_BAR();

    {
        const int tid = pg8::tid_opaque();
        if (tid == 0) {
            int pt = 0, cr = 0;
            for (int e = 0; e < NEXP; ++e) { const int c = (int)__hip_atomic_load(ctl + CW_CNT + e, __ATOMIC_RELAXED, __HIP_MEMORY_SCOPE_AGENT); tbl[e] = c; tbl[32 + e] = pt; tbl[65 + e] = cr; pt += (c + 255) >> 8; cr += c; }
            tbl[64] = pt; tbl[97] = cr;
        }
        __syncthreads();
        for (int t = tid; t < 576; t += 512) { int e = 0;
            for (int j = 1; j < NEXP; ++j) e += (tbl[32 + j] <= t) ? 1 : 0;
            tile_e[t] = (unsigned char)e; }
        __syncthreads();
    }


    {
        const int T = tbl[64];
        LAS unsigned short* urow = (LAS unsigned short*)(L + UROW_OFF); LAS float* ubias = (LAS float*)(L + UBIAS_OFF);
        {
            MoeOrder S{tbl, tile_e, 0, T, 8, G, vcu, true};
            {
                const int tid = pg8::tid_opaque(); pg8::Unit u; const unsigned short* elist = (const unsigned short*)(ws + WS_ELIST);
                for (int i = 0; i < MAXU && S.next(i, u); ++i) {
                    if (tid < 256) { const int r = (u.ta - tbl[32 + u.e]) * 256 + tid; urow[i * 256 + tid] = (r < tbl[u.e]) ? elist[(size_t)u.e * NTOK + r] : (unsigned short)0; }
                    else { const int j = tid - 256; ubias[i * 256 + j] = (j < 128 ? args.in[I_BGATE] : args.in[I_BUP])[u.e * 1024 + u.pn * 128 + (j & 127)]; } }
                __syncthreads();
            }
            pg8::Gemm g{(const pg8::bf16_t*)(ws + WS_XN), (const pg8::bf16_t*)(ws + WS_WGU), 512, urow};
            pg8::EpiSwiglu E{ws + WS_HDN, ubias};
            pg8::gemm_phase<pg8::EpiSwiglu, MoeOrder, true, true, true>(L + RING_OFF, g, S, E);
        }
        GRID_BAR();
        {
            MoeOrder S{tbl, tile_e, 0, T, 4, G, vcu, false};
            {   const int tid = pg8::tid_opaque(); pg8::Unit u;
                for (int i = 0; i < MAXU && S.next(i, u); ++i) { if (tid < 256) ubias[i * 256 + tid] = args.in[I_BDOWN][u.e * 1024 + u.pn * 256 + tid]; }
                __syncthreads();
            }
            pg8::Gemm g{(const pg8::bf16_t*)(ws + WS_HDN), (const pg8::bf16_t*)(ws + WS_WD), 512, nullptr};
            pg8::EpiDown E{ws + WS_Y, ubias};
            pg8::gemm_phase<pg8::EpiDown, MoeOrder, false, true, true>(L + RING_OFF, g, S, E);
        }
        GRID_BAR();
    }

    {
        const int tid = pg8::tid_opaque(), lane = tid & 63;
        const int* toke = (const int*)(ws + WS_TOKE); const float* tokg = (const float*)(ws + WS_TOKG); const int* tokp = (const int*)(ws + WS_TOKP);
        const unsigned char* Y = ws + WS_Y; unsigned char* XN = ws + WS_XN3; const bf16* H1B = (const bf16*)out; bf16* H2B = (bf16*)(ws + WS_H2B); const float* gn = args.in[I_PLE_GNORM];
        f32x4 gg[4];
#pragma unroll
        for (int j = 0; j < 4; ++j) gg[j] = *((const GAS f32x4*)gn + lane + 64 * j);
        for (int m0 = gw; m0 < NTOK; m0 += 2 * NGW) {
            int rowk[2][4]; float gk[2][4]; f32x4 v[2][4];
#pragma unroll
            for (int u = 0; u < 2; ++u) { const int m = (m0 + u * NGW < NTOK) ? m0 + u * NGW : m0;
#pragma unroll
                for (int k = 0; k < 4; ++k) { const int e = toke[(size_t)m * 4 + k]; gk[u][k] = tokg[(size_t)m * 4 + k]; rowk[u][k] = tbl[65 + e] + tokp[(size_t)m * 4 + k]; }
                const GAS v2u* xr = (const GAS v2u*)(H1B + (size_t)m * 1024) + lane;
#pragma unroll
                for (int j = 0; j < 4; ++j) { const v2u w_ = xr[64 * j]; v[u][j] = (f32x4){bflo(w_.x), bfhi(w_.x), bflo(w_.y), bfhi(w_.y)}; } }
#pragma unroll
            for (int u = 0; u < 2; ++u)
#pragma unroll
                for (int k = 0; k < 4; ++k) { const GAS unsigned* yr = (const GAS unsigned*)(Y + (size_t)rowk[u][k] * 1024) + lane; const float g_ = gk[u][k];
#pragma unroll
                    for (int j = 0; j < 4; ++j) { const f32x4 y4 = fp8x4_to_f32(yr[64 * j]); v[u][j] += y4 * g_; } }
#pragma unroll
            for (int u = 0; u < 2; ++u) { const int m = m0 + u * NGW; if (m < NTOK) {
                GAS v2u* xw = (GAS v2u*)(H2B + (size_t)m * 1024) + lane; float s = 0.f;
#pragma unroll
                for (int j = 0; j < 4; ++j) { v2u w_; w_.x = pk2(v[u][j].x, v[u][j].y); w_.y = pk2(v[u][j].z, v[u][j].w); xw[64 * j] = w_; s += (v[u][j].x * v[u][j].x + v[u][j].y * v[u][j].y) + (v[u][j].z * v[u][j].z + v[u][j].w * v[u][j].w); }
                const float r = 1.0f / sqrtf(wave_sum(s) * (1.f / 1024.f) + EPS);
                GAS unsigned* o4 = (GAS unsigned*)(XN + (size_t)m * 1024) + lane;
#pragma unroll
                for (int j = 0; j < 4; ++j) o4[64 * j] = pg8::pk4_fp8(v[u][j].x * r * gg[j].x, v[u][j].y * r * gg[j].y, v[u][j].z * r * gg[j].z, v[u][j].w * r * gg[j].w); } }
        }
    }
    GRID_BAR();

    {
        pg8::Gemm g{(const pg8::bf16_t*)(ws + WS_XN3), (const pg8::bf16_t*)(ws + WS_WG), 512, nullptr}; pg8::StaticOrder S; S.init(NTOK, 1024, G, (int)blockIdx.x);
        pg8::EpiFinal E{out, (const pg8::bf16_t*)(ws + WS_H2B), (const pg8::bf16_t*)(ws + WS_ER), (const float*)(ws + WS_SS), args.in[I_PLE_PNORM]};
        pg8::gemm_phase<pg8::EpiFinal, pg8::StaticOrder, false, true, true>(L + RING_OFF, g, S, E);
    }
}

extern "C" void kernel_launch(void* const* d_in, const int* in_sizes, int n_in, void* d_out, int out_size, void* d_ws, size_t ws_size, hipStream_t stream) {
    static int grid = 0;
    if (grid == 0) {
        if (n_in != 28 || in_sizes[0] != NTOK * DMODEL || out_size != NTOK * DMODEL || ws_size < WS_TOP) { fprintf(stderr, "kernel_launch: unexpected shapes (n_in %d, ws %zu)\n", n_in, ws_size); grid = -1; return; }
        int dev = 0, cus = 0, per_cu = 0;
        (void)hipGetDevice(&dev); (void)hipDeviceGetAttribute(&cus, hipDeviceAttributeMultiprocessorCount, dev);
        (void)hipFuncSetAttribute((const void*)mk_fwd, hipFuncAttributeMaxDynamicSharedMemorySize, LDS_BYTES);
        if (hipOccupancyMaxActiveBlocksPerMultiprocessor(&per_cu, (const void*)mk_fwd, NWAVES * 64, LDS_BYTES) != hipSuccess || per_cu < 1) per_cu = 1;
        (void)hipGetLastError();
        grid = cus * (per_cu > 1 ? 1 : per_cu);
    }
    if (grid < 0) return;
    (void)hipMemsetAsync((char*)d_ws + WS_CTL, 0, CTL_ZERO_BYTES, stream);
    Args a{};
    for (int i = 0; i < 28; ++i) a.in[i] = (const float*)d_in[i];
    a.out = (float*)d_out; a.ws = (unsigned char*)d_ws;
    void* kargs[] = {&a};
    hipError_t e = hipLaunchCooperativeKernel((const void*)mk_fwd, dim3(grid), dim3(NWAVES * 64), kargs, LDS_BYTES, stream);
    if (e != hipSuccess) fprintf(stderr, "cooperative launch failed: %s (grid %d)\n", hipGetErrorString(e), grid);
}
```

```cpp
#include <hip/hip_runtime.h>
#include <hip/hip_cooperative_groups.h>
#include <hip/hip_bf16.h>
#include <cstdio>
#include <cstdint>
#include <cmath>
namespace cg = cooperative_groups;


namespace pg8 {
#define PG8_LAS __attribute__((address_space(3)))
typedef unsigned short bf16_t;
typedef short bf16x8 __attribute__((ext_vector_type(8)));
typedef float f32x4 __attribute__((ext_vector_type(4)));
typedef float f32x2 __attribute__((ext_vector_type(2)));
typedef unsigned u32x4 __attribute__((ext_vector_type(4)));
typedef unsigned u32x2 __attribute__((ext_vector_type(2)));
constexpr int BM = 256, BK = 64, HALF = 128, HTB = HALF * BK * 2, STAGE_BYTES = 8 * HTB, NXCD = 8, WGM = 8;

__host__ __device__ __forceinline__ int lds_byte(int r, int c) { const int st = (r >> 4) * 2 + (c >> 5), rr = r & 15, cc = c & 31, ob = rr * 64 + cc * 2; return st * 1024 + (ob ^ (((ob >> 9) & 1) << 5)); }
__host__ __device__ __forceinline__ void stage_rc(int b, int& R, int& C) { const int st = b / 1024, sb = b % 1024, swz = sb ^ (((sb >> 9) & 1) << 5); R = (st >> 1) * 16 + swz / 64; C = (st & 1) * 32 + (swz % 64) / 2; }
__host__ __device__ __forceinline__ int perm32(int rho) { const int n = rho >> 4, i = rho & 15; return 8 * (i >> 2) + 4 * n + (i & 3); }

struct Unit { int ta, tb, pm, pn, e, nv, ord; };
struct Gemm { const bf16_t* A; const bf16_t* Bt; int K; const PG8_LAS unsigned short* urow; };

struct StaticOrder {
    int nM, nN, nwg, G, c;
    __host__ __device__ void init(int M, int N, int G_, int c_) { nM = M / BM; nN = N / BM; nwg = nM * nN; G = G_; c = c_; }
    __host__ __device__ bool next(int i, Unit& u) const {
        const long L = (long)i * G + c; if (L >= nwg) return false;
        int wgid = (int)L; { const int q = nwg / NXCD, r = nwg % NXCD, xcd = wgid % NXCD, off = wgid / NXCD; wgid = (xcd < r ? xcd * (q + 1) : r * (q + 1) + (xcd - r) * q) + off; }
        const int nig = WGM * nN, gid = wgid / nig, fm = gid * WGM, gsz = (nM - fm) < WGM ? (nM - fm) : WGM;
        u.pm = fm + ((wgid % nig) % gsz); u.pn = (wgid % nig) / gsz; u.ta = u.pm; u.tb = u.pn; u.e = 0; u.nv = 256; u.ord = i; return true;
    }
};

__device__ __forceinline__ unsigned cvt_pk_bf16(float lo, float hi) { unsigned r; asm volatile("v_cvt_pk_bf16_f32 %0, %1, %2" : "=v"(r) : "v"(lo), "v"(hi)); return r; }

struct EpiBf16 {
    static constexpr bool PERM = true;
    bf16_t* O; int ldc; const float* bias; int split_cols; size_t split_stride; float* ss;
    __device__ __forceinline__ void operator()(const f32x4 (&acc)[2][2][4][2], const Unit& u, int wr, int wc, int fr, int fq) const {
        const int row0 = u.pm * BM + wr * 64 + fr; int colt = u.pn * BM; bf16_t* base = O;
        if (split_cols) { const int t = colt / split_cols; base += (size_t)t * split_stride; colt -= t * split_cols; }
        const int col0 = colt + wc * 32 + 8 * fq, bcol0 = u.pn * BM + wc * 32 + 8 * fq;
        f32x4 bv[2][2];
#pragma unroll
        for (int bj = 0; bj < 2; ++bj)
#pragma unroll
            for (int n = 0; n < 2; ++n) bv[bj][n] = bias ? *(const f32x4*)(bias + bcol0 + bj * HALF + 4 * n) : (f32x4){0.f, 0.f, 0.f, 0.f};
#pragma unroll
        for (int ai = 0; ai < 2; ++ai)
#pragma unroll
            for (int m = 0; m < 4; ++m) { bf16_t* rowp = base + (size_t)(row0 + ai * HALF + m * 16) * ldc + col0;
                float q = 0.f;
#pragma unroll
                for (int bj = 0; bj < 2; ++bj) { f32x4 v0 = acc[ai][bj][m][0] + bv[bj][0], v1 = acc[ai][bj][m][1] + bv[bj][1];
                    q += (v0[0] * v0[0] + v0[1] * v0[1]) + (v0[2] * v0[2] + v0[3] * v0[3]) + (v1[0] * v1[0] + v1[1] * v1[1]) + (v1[2] * v1[2] + v1[3] * v1[3]);
                    u32x4 w; w.x = cvt_pk_bf16(v0[0], v0[1]); w.y = cvt_pk_bf16(v0[2], v0[3]); w.z = cvt_pk_bf16(v1[0], v1[1]); w.w = cvt_pk_bf16(v1[2], v1[3]);
                    *(u32x4*)(rowp + bj * HALF) = w; }
                if (ss) { q += __shfl_xor(q, 16); q += __shfl_xor(q, 32); if (fq == 0) atomicAdd(ss + row0 + ai * HALF + m * 16, q); } }
    }
};
struct EpiQKVU {
    static constexpr bool PERM = true;
    bf16_t* QK; bf16_t* VU; const float* cs; const float* qn; const float* kn; float c2;
    __device__ __forceinline__ void operator()(const f32x4 (&acc)[2][2][4][2], const Unit& u, int wr, int wc, int fr, int fq) const {
        const int row0 = u.pm * BM + wr * 64 + fr, tcol = 64 * wc + 8 * fq;
        if (u.pn >= 4) {
#pragma unroll
            for (int ai = 0; ai < 2; ++ai)
#pragma unroll
                for (int m = 0; m < 4; ++m) { bf16_t* rowp = VU + (size_t)(row0 + ai * HALF + m * 16) * 1024 + (u.pn - 4) * BM + tcol;
#pragma unroll
                    for (int bj = 0; bj < 2; ++bj) { const f32x4 v0 = acc[ai][bj][m][0], v1 = acc[ai][bj][m][1];
                        u32x4 w; w.x = cvt_pk_bf16(v0[0], v0[1]); w.y = cvt_pk_bf16(v0[2], v0[3]); w.z = cvt_pk_bf16(v1[0], v1[1]); w.w = cvt_pk_bf16(v1[2], v1[3]);
                        *(u32x4*)(rowp + 32 * bj) = w; } }
        } else {
            const bool isq = u.pn < 2; const float* gn = isq ? qn : kn; const float osc = isq ? c2 : 1.0f;
            f32x4 g4[2][2];
#pragma unroll
            for (int bj = 0; bj < 2; ++bj)
#pragma unroll
                for (int n = 0; n < 2; ++n) g4[bj][n] = *(const f32x4*)(gn + 32 * bj + 8 * fq + 4 * n);
#pragma unroll
            for (int ai = 0; ai < 2; ++ai)
#pragma unroll
                for (int m = 0; m < 4; ++m) { const int row = row0 + ai * HALF + m * 16;
                    f32x4 v[2][2]; float ss = 0.f;
#pragma unroll
                    for (int bj = 0; bj < 2; ++bj)
#pragma unroll
                        for (int n = 0; n < 2; ++n) { v[bj][n] = acc[ai][bj][m][n]; ss += (v[bj][n][0] * v[bj][n][0] + v[bj][n][1] * v[bj][n][1]) + (v[bj][n][2] * v[bj][n][2] + v[bj][n][3] * v[bj][n][3]); }
                    ss += __shfl_xor(ss, 16); ss += __shfl_xor(ss, 32);
                    const float r = 1.0f / sqrtf(ss * (1.f / 64.f) + 1e-6f);
#pragma unroll
                    for (int bj = 0; bj < 2; ++bj)
#pragma unroll
                        for (int n = 0; n < 2; ++n) v[bj][n] = v[bj][n] * g4[bj][n] * r;
#pragma unroll
                    for (int n = 0; n < 2; ++n) { const f32x4 c4 = *(const f32x4*)(cs + (size_t)row * 16 + 4 * n), s4 = *(const f32x4*)(cs + (size_t)row * 16 + 8 + 4 * n);
#pragma unroll
                        for (int j = 0; j < 4; ++j) { const float pv = __shfl_xor(v[0][n][j], 16); const float sg = (fq == 0) ? -s4[j] : s4[j];
                            if (fq < 2) v[0][n][j] = v[0][n][j] * c4[j] + pv * sg; } }
                    bf16_t* rowp = QK + (size_t)row * 1024 + u.pn * BM + tcol;
#pragma unroll
                    for (int bj = 0; bj < 2; ++bj) { const f32x4 v0 = v[bj][0] * osc, v1 = v[bj][1] * osc;
                        u32x4 w; w.x = cvt_pk_bf16(v0[0], v0[1]); w.y = cvt_pk_bf16(v0[2], v0[3]); w.z = cvt_pk_bf16(v1[0], v1[1]); w.w = cvt_pk_bf16(v1[2], v1[3]);
                        *(u32x4*)(rowp + 32 * bj) = w; } }
        }
    }
};
__device__ __forceinline__ f32x2 swiglu2(f32x2 g, f32x2 u) {
    g.x = fminf(g.x, 7.0f); g.y = fminf(g.y, 7.0f);
    u.x = __builtin_amdgcn_fmed3f(u.x, -7.0f, 7.0f); u.y = __builtin_amdgcn_fmed3f(u.y, -7.0f, 7.0f);
    f32x2 e = g * (-1.702f * 1.4426950408889634f);
    e.x = __builtin_amdgcn_exp2f(e.x); e.y = __builtin_amdgcn_exp2f(e.y);
    f32x2 d = e + 1.0f;
    d.x = __builtin_amdgcn_rcpf(d.x); d.y = __builtin_amdgcn_rcpf(d.y);
    return (u + 1.0f) * (g * d);
}
__device__ __forceinline__ unsigned pk4_fp8(float a, float b, float c, float d) { int w = 0; w = __builtin_amdgcn_cvt_pk_fp8_f32(a, b, w, false); w = __builtin_amdgcn_cvt_pk_fp8_f32(c, d, w, true); return (unsigned)w; }
struct EpiSwiglu {
    static constexpr bool PERM = true;
    unsigned char* H; const PG8_LAS float* ub;
    __device__ __forceinline__ void operator()(const f32x4 (&acc)[2][2][4][2], const Unit& u, int wr, int wc, int fr, int fq) const {
        const int row0 = u.pm * BM + wr * 64 + fr, hcol0 = u.pn * HALF + wc * 32 + 8 * fq;
        f32x4 g4[2], u4[2];
#pragma unroll
        for (int n = 0; n < 2; ++n) { g4[n] = *(const PG8_LAS f32x4*)(ub + u.ord * 256 + wc * 32 + 8 * fq + 4 * n); u4[n] = *(const PG8_LAS f32x4*)(ub + u.ord * 256 + 128 + wc * 32 + 8 * fq + 4 * n); }
#pragma unroll
        for (int ai = 0; ai < 2; ++ai)
#pragma unroll
            for (int m = 0; m < 4; ++m) { unsigned char* rowp = H + (size_t)(row0 + ai * HALF + m * 16) * 1024 + hcol0;
                float h[8];
#pragma unroll
                for (int n = 0; n < 2; ++n) { const f32x4 gv = acc[ai][0][m][n] * 0.03125f + g4[n], uv = acc[ai][1][m][n] * 0.03125f + u4[n];
                    const f32x2 h0 = swiglu2((f32x2){gv[0], gv[1]}, (f32x2){uv[0], uv[1]}), h1 = swiglu2((f32x2){gv[2], gv[3]}, (f32x2){uv[2], uv[3]});
                    h[4 * n] = h0.x; h[4 * n + 1] = h0.y; h[4 * n + 2] = h1.x; h[4 * n + 3] = h1.y; }
                u32x2 w; w.x = pk4_fp8(h[0], h[1], h[2], h[3]); w.y = pk4_fp8(h[4], h[5], h[6], h[7]);
                *(u32x2*)rowp = w; }
    }
};
struct EpiDown {
    static constexpr bool PERM = true;
    unsigned char* Y; const PG8_LAS float* ub;
    __device__ __forceinline__ void operator()(const f32x4 (&acc)[2][2][4][2], const Unit& u, int wr, int wc, int fr, int fq) const {
        const int col0 = u.pn * BM + wc * 32 + 8 * fq;
        f32x4 bv[2][2];
#pragma unroll
        for (int bj = 0; bj < 2; ++bj)
#pragma unroll
            for (int n = 0; n < 2; ++n) bv[bj][n] = *(const PG8_LAS f32x4*)(ub + u.ord * 256 + wc * 32 + 8 * fq + bj * HALF + 4 * n);
#pragma unroll
        for (int ai = 0; ai < 2; ++ai)
#pragma unroll
            for (int m = 0; m < 4; ++m) { const int r = wr * 64 + fr + ai * HALF + m * 16; unsigned char* rowp = Y + (size_t)(u.pm + r) * 1024 + col0;
                if (r < u.nv) {
#pragma unroll
                    for (int bj = 0; bj < 2; ++bj) { f32x4 v0 = acc[ai][bj][m][0] * 0.03125f + bv[bj][0], v1 = acc[ai][bj][m][1] * 0.03125f + bv[bj][1];
                        u32x2 w; w.x = pk4_fp8(v0[0], v0[1], v0[2], v0[3]); w.y = pk4_fp8(v1[0], v1[1], v1[2], v1[3]);
                        *(u32x2*)(rowp + bj * HALF) = w; } } }
    }
};
struct EpiResBf16 {
    static constexpr bool PERM = true;
    const float* base; bf16_t* H;
    __device__ __forceinline__ void operator()(const f32x4 (&acc)[2][2][4][2], const Unit& u, int wr, int wc, int fr, int fq) const {
        const int row0 = u.pm * BM + wr * 64 + fr, col0 = u.pn * BM + wc * 32 + 8 * fq;
#pragma unroll
        for (int ai = 0; ai < 2; ++ai)
#pragma unroll
            for (int m = 0; m < 4; ++m) { const size_t off = (size_t)(row0 + ai * HALF + m * 16) * 1024 + col0;
#pragma unroll
                for (int bj = 0; bj < 2; ++bj) { const f32x4 b0 = *(const f32x4*)(base + off + bj * HALF), b1 = *(const f32x4*)(base + off + bj * HALF + 4);
                    const f32x4 v0 = b0 + acc[ai][bj][m][0], v1 = b1 + acc[ai][bj][m][1];
                    u32x4 w; w.x = cvt_pk_bf16(v0[0], v0[1]); w.y = cvt_pk_bf16(v0[2], v0[3]); w.z = cvt_pk_bf16(v1[0], v1[1]); w.w = cvt_pk_bf16(v1[2], v1[3]);
                    *(u32x4*)(H + off + bj * HALF) = w; }
                if (m & 1) asm volatile("" ::: "memory"); }
    }
};
struct EpiFinal {
    static constexpr bool PERM = false;
    float* out; const bf16_t* H2; const bf16_t* ER; const float* ss; const float* pn;
    __device__ __forceinline__ void operator()(const f32x4 (&acc)[2][2][4][2], const Unit& u, int wr, int wc, int fr, int fq) const {
        const int row0 = u.pm * BM + wr * 64 + fr, col0 = u.pn * BM + wc * 32 + 4 * fq;
        f32x4 pv[2][2];
#pragma unroll
        for (int bj = 0; bj < 2; ++bj)
#pragma unroll
            for (int n = 0; n < 2; ++n) pv[bj][n] = *(const f32x4*)(pn + col0 + bj * HALF + n * 16);
#pragma unroll
        for (int ai = 0; ai < 2; ++ai)
#pragma unroll
            for (int m = 0; m < 4; ++m) { const int row = row0 + ai * HALF + m * 16; const size_t off = (size_t)row * 1024 + col0;
                const float re = 1.0f / sqrtf(ss[row] * (1.f / 1024.f) + 1e-6f);
#pragma unroll
                for (int bj = 0; bj < 2; ++bj)
#pragma unroll
                    for (int n = 0; n < 2; ++n) { const size_t o = off + bj * HALF + n * 16; const u32x2 hw = *(const u32x2*)(H2 + o); const u32x2 ew = *(const u32x2*)(ER + o);
                        f32x4 b; b[0] = __uint_as_float(hw.x << 16); b[1] = __uint_as_float(hw.x & 0xffff0000u); b[2] = __uint_as_float(hw.y << 16); b[3] = __uint_as_float(hw.y & 0xffff0000u);
                        f32x4 e; e[0] = __uint_as_float(ew.x << 16); e[1] = __uint_as_float(ew.x & 0xffff0000u); e[2] = __uint_as_float(ew.y << 16); e[3] = __uint_as_float(ew.y & 0xffff0000u);
                        f32x4 r;
#pragma unroll
                        for (int j = 0; j < 4; ++j) { const float sg = __builtin_amdgcn_rcpf(1.0f + __builtin_amdgcn_exp2f((-1.4426950408889634f * 0.03125f) * acc[ai][bj][m][n][j])); r[j] = b[j] + sg * (e[j] * re * pv[bj][n][j]); }
                        *(f32x4*)(out + o) = r; }
                if (m & 1) asm volatile("" ::: "memory"); }
    }
};

typedef int v8i __attribute__((ext_vector_type(8)));
typedef int v4i __attribute__((ext_vector_type(4)));
__device__ __forceinline__ v8i cat8(bf16x8 a, bf16x8 b) { const v4i x = __builtin_bit_cast(v4i, a), y = __builtin_bit_cast(v4i, b); return __builtin_shufflevector(x, y, 0, 1, 2, 3, 4, 5, 6, 7); }
__device__ __forceinline__ void mfma8(f32x4& acc, v8i a, v8i b, int sc) { asm volatile("v_mfma_scale_f32_16x16x128_f8f6f4 %0, %1, %2, %0, %3, %3 op_sel_hi:[0,0,0]" : "+v"(acc) : "v"(a), "v"(b), "v"(sc)); }
__device__ __forceinline__ int tid_opaque() { int t; asm volatile("v_mov_b32 %0, %1" : "=v"(t) : "v"(threadIdx.x)); return t; }
__device__ __forceinline__ void a_offs(const Gemm& g, const Unit& u, int R0, unsigned c2, unsigned (&o)[2][2]) {
    const PG8_LAS unsigned short* t = g.urow + u.ord * 256 + R0;
#pragma unroll
    for (int h = 0; h < 2; ++h) {
        const unsigned r0 = t[h * HALF], r1 = t[h * HALF + 64];
        o[h][0] = (r0 * (unsigned)g.K) * 2u + c2; o[h][1] = (r1 * (unsigned)g.K) * 2u + c2; }
}

template <class Epi, class Sched, bool GATHER, bool ALIGN_EPI, bool F8 = false, bool G64 = false>
__device__ __forceinline__ void gemm_phase(PG8_LAS unsigned char* lds, const Gemm g, const Sched& S, const Epi& E) {
    const int tid = tid_opaque(), wid = __builtin_amdgcn_readfirstlane(tid >> 6), lane = tid & 63, wr = wid >> 2, wc = wid & 3, fr = lane & 15, fq = lane >> 4;
    const int K = g.K, nt = K / BK;
    int R0, C0; stage_rc(tid * 16, R0, C0);
    unsigned voffA[2], voffB[2];
    { const int Rb0 = G64 ? (64 * (R0 >> 5) + perm32(R0 & 31)) : Epi::PERM ? ((R0 & ~31) + perm32(R0 & 31)) : R0;
      voffA[0] = (unsigned)(R0 * K + C0) * 2u; voffA[1] = voffA[0] + (unsigned)(64 * K) * 2u;
      voffB[0] = (unsigned)(Rb0 * K + C0) * 2u; voffB[1] = voffB[0] + (unsigned)((G64 ? 128 : 64) * K) * 2u; }
    const size_t kstep = (size_t)(BK * 2);
    const size_t hstep = (size_t)HALF * K * 2;
    const size_t tstep = 2 * hstep;
    const size_t hstepB = G64 ? (size_t)32 * K * 2 : hstep;
    const unsigned ldsw = (unsigned)wid * 1024u;
    const int aoff = lds_byte(wr * 64 + fr, F8 ? fq * 16 : fq * 8), boff = lds_byte(wc * 32 + fr, F8 ? fq * 16 : fq * 8);
    constexpr int CHS = F8 ? 16 : 1024;
    int sc8 = 0x7f7f7f7f; asm volatile("" : "+v"(sc8));
#define PG8_SA(b, h) (((b) * 2 + (h)) * HTB)
#define PG8_SB(b, h) ((4 + (b) * 2 + (h)) * HTB)
#define PG8_STAGE(bufoff, gbase, voff) do { _Pragma("unroll") for (int _i = 0; _i < 2; ++_i) \
        __builtin_amdgcn_global_load_lds((const unsigned*)((const char*)(gbase) + (voff)[_i]), (PG8_LAS unsigned*)(lds + (bufoff) + ldsw + _i * 8192), 16, 0, 0); } while (0)
#define PG8_STAGE_AC(bufoff, kb, h) do { if constexpr (GATHER) { PG8_STAGE(bufoff, Ab + (kb), co[h]); } else { PG8_STAGE(bufoff, cA + (kb) + (h) * hstep, voffA); } } while (0)
#define PG8_STAGE_AX(bufoff, nx, kb, kbn, h) do { if constexpr (GATHER) { unsigned _o[2]; _o[0] = (nx) ? no[h][0] : co[h][0]; _o[1] = (nx) ? no[h][1] : co[h][1]; PG8_STAGE(bufoff, Ab + ((nx) ? (kbn) : (kb)), _o); } \
        else { PG8_STAGE(bufoff, ((nx) ? nA + (kbn) : cA + (kb)) + (h) * hstep, voffA); } } while (0)
#define PG8_LDA(dst, b, h) do { _Pragma("unroll") for (int m = 0; m < 4; ++m) _Pragma("unroll") for (int k = 0; k < 2; ++k) dst[m][k] = *(const PG8_LAS bf16x8*)(lds + PG8_SA(b, h) + aoff + m * 2048 + k * CHS); } while (0)
#define PG8_LDB(dst, b, h) do { _Pragma("unroll") for (int n = 0; n < 2; ++n) _Pragma("unroll") for (int k = 0; k < 2; ++k) dst[n][k] = *(const PG8_LAS bf16x8*)(lds + PG8_SB(b, h) + boff + n * 2048 + k * CHS); } while (0)
#define PG8_MMA(ai, bj, At, Bt) do { __builtin_amdgcn_s_setprio(1); _Pragma("unroll") for (int m = 0; m < 4; ++m) _Pragma("unroll") for (int n = 0; n < 2; ++n) { \
        if constexpr (F8) { mfma8(acc[ai][bj][m][n], cat8(Bt[n][0], Bt[n][1]), cat8(At[m][0], At[m][1]), sc8); } \
        else { _Pragma("unroll") for (int k = 0; k < 2; ++k) acc[ai][bj][m][n] = __builtin_amdgcn_mfma_f32_16x16x32_bf16(Bt[n][k], At[m][k], acc[ai][bj][m][n], 0, 0, 0); } } \
        __builtin_amdgcn_s_setprio(0); } while (0)
#define PG8_WAIT_V(n) asm volatile("s_waitcnt vmcnt(" #n ")" ::: "memory")
#define PG8_WAIT_L(n) asm volatile("s_waitcnt lgkmcnt(" #n ")" ::: "memory")
#define PG8_BAR __builtin_amdgcn_s_barrier()
#define PG8_SCHED __builtin_amdgcn_sched_barrier(0)
    Unit cur, nxt; int ui = 0;
    if (!S.next(0, cur)) return;
    f32x4 acc[2][2][4][2];
#pragma unroll
    for (int a = 0; a < 2; ++a)
#pragma unroll
        for (int b = 0; b < 2; ++b)
#pragma unroll
            for (int m = 0; m < 4; ++m)
#pragma unroll
                for (int n = 0; n < 2; ++n) acc[a][b][m][n] = (f32x4){0.f, 0.f, 0.f, 0.f};
    bf16x8 At[4][2], B0[2][2], B1[2][2];
    const char* const Ab = (const char*)g.A;
    const char* cA = Ab + (GATHER ? (size_t)0 : (size_t)cur.ta * tstep);
    const char* cB = (const char*)g.Bt + (size_t)cur.tb * tstep;
    unsigned co[2][2], no[2][2];
    const unsigned c2 = (unsigned)C0 * 2u;
    if constexpr (GATHER) a_offs(g, cur, R0, c2, co);
    PG8_STAGE(PG8_SB(0, 0), cB, voffB); PG8_STAGE(PG8_SB(0, 1), cB + hstepB, voffB); PG8_STAGE_AC(PG8_SA(0, 0), 0, 0); PG8_STAGE_AC(PG8_SA(0, 1), 0, 1);
    if (wr == 1) PG8_BAR;
    PG8_WAIT_V(2); PG8_BAR;
    PG8_STAGE(PG8_SB(1, 0), cB + kstep, voffB); PG8_STAGE_AC(PG8_SA(1, 0), kstep, 0); PG8_STAGE(PG8_SB(1, 1), cB + hstepB + kstep, voffB);
    PG8_WAIT_V(6); PG8_BAR;
    for (;;) {
        const bool has_next = S.next(ui + 1, nxt);
        const char* nB = has_next ? (const char*)g.Bt + (size_t)nxt.tb * tstep : cB;
        const char* nA = (has_next && !GATHER) ? Ab + (size_t)nxt.ta * tstep : cA;
        if constexpr (GATHER) {
            if (has_next) a_offs(g, nxt, R0, c2, no);
            else {
#pragma unroll
                for (int h = 0; h < 2; ++h) { no[h][0] = co[h][0]; no[h][1] = co[h][1]; } } }
        for (int t = 0; t < nt; t += 2) {
            const bool last = (t == nt - 2);
            const size_t k1 = (size_t)(t + 1) * kstep, k2 = (size_t)(t + 2) * kstep, k3 = (size_t)(t + 3) * kstep;
            const char* b2 = last ? nB : cB + k2;
            const char* b3 = b2 + kstep;
            PG8_LDB(B0, 0, 0); PG8_LDB(B1, 0, 1); PG8_SCHED; PG8_LDA(At, 0, 0); PG8_STAGE_AC(PG8_SA(1, 1), k1, 1);
            PG8_WAIT_V(8); PG8_WAIT_L(0); PG8_BAR; PG8_MMA(0, 0, At, B0); PG8_MMA(0, 1, At, B1); PG8_BAR; PG8_SCHED;
            PG8_LDA(At, 0, 1); PG8_STAGE(PG8_SB(0, 0), b2, voffB); PG8_STAGE(PG8_SB(0, 1), b2 + hstepB, voffB); PG8_STAGE_AX(PG8_SA(0, 0), last, k2, (size_t)0, 0);
            PG8_WAIT_V(8); PG8_WAIT_L(0); PG8_BAR; PG8_MMA(1, 0, At, B0); PG8_MMA(1, 1, At, B1); PG8_BAR; PG8_SCHED;
            PG8_LDB(B0, 1, 0); PG8_LDB(B1, 1, 1); PG8_SCHED; PG8_LDA(At, 1, 0); PG8_STAGE_AX(PG8_SA(0, 1), last, k2, (size_t)0, 1);
            PG8_WAIT_V(8); PG8_WAIT_L(0); PG8_BAR; PG8_MMA(0, 0, At, B0); PG8_MMA(0, 1, At, B1); PG8_BAR; PG8_SCHED;
            PG8_LDA(At, 1, 1); PG8_STAGE(PG8_SB(1, 0), b3, voffB); PG8_STAGE(PG8_SB(1, 1), b3 + hstepB, voffB); PG8_STAGE_AX(PG8_SA(1, 0), last, k3, kstep, 0);
            PG8_WAIT_V(8); PG8_WAIT_L(0); PG8_BAR; PG8_MMA(1, 0, At, B0); PG8_MMA(1, 1, At, B1); PG8_BAR; PG8_SCHED;
        }
        if constexpr (ALIGN_EPI) { if (wr == 0) PG8_BAR; }
        if constexpr (F8) asm volatile("s_nop 15\n\ts_nop 15" ::: "memory");
        { const int te = tid_opaque() & 63; E(acc, cur, wr, wc, te & 15, te >> 4); }
        if (!has_next) break;
#pragma unroll
        for (int a = 0; a < 2; ++a)
#pragma unroll
            for (int b = 0; b < 2; ++b)
#pragma unroll
                for (int m = 0; m < 4; ++m)
#pragma unroll
                    for (int n = 0; n < 2; ++n) acc[a][b][m][n] = (f32x4){0.f, 0.f, 0.f, 0.f};
        cur = nxt; cB = nB; cA = nA; ++ui;
        if constexpr (GATHER) {
#pragma unroll
            for (int h = 0; h < 2; ++h) { co[h][0] = no[h][0]; co[h][1] = no[h][1]; } }
        if constexpr (ALIGN_EPI) { if (wr == 1) PG8_BAR; }
    }
    PG8_WAIT_V(0);
    if constexpr (!ALIGN_EPI) { if (wr == 0) PG8_BAR; }
    PG8_BAR;
#undef PG8_SA
#undef PG8_SB
#undef PG8_STAGE
#undef PG8_STAGE_AC
#undef PG8_STAGE_AX
#undef PG8_LDA
#undef PG8_LDB
#undef PG8_MMA
#undef PG8_WAIT_V
#undef PG8_WAIT_L
#undef PG8_BAR
#undef PG8_SCHED
}
}

namespace attn_body {
using bf16=__hip_bfloat16;
using bf16x8=__attribute__((ext_vector_type(8)))short;
using s16x4=__attribute__((ext_vector_type(4)))short;
using f32x16=__attribute__((ext_vector_type(16)))float;
using u32x4=__attribute__((ext_vector_type(4)))unsigned;
constexpr int SEQ=4096,D=64,DM=1024;
constexpr int NW=8,QBLK=32,QB=QBLK*NW,KVBLK=64,NQB=SEQ/QB;
__device__ __forceinline__ int crow(int r,int hi){return (r&3)+8*(r>>2)+4*hi;}
#define SBAR() __builtin_amdgcn_sched_barrier(0)
__device__ __forceinline__ void cmask(f32x16&p0,f32x16&p1,int jb,int qrel,int hi){
  const float NEG=-INFINITY; int kb=64*jb+4*hi;
  #pragma unroll
  for(int r=0;r<16;++r){int kv=kb+(r&3)+8*(r>>2); if(kv>qrel)p0[r]=NEG; if(kv+32>qrel)p1[r]=NEG;}
}
constexpr int NSLOT=3, SLOTB=8192;
constexpr int LDS_K=0, LDS_V=NSLOT*SLOTB, LDS_WS=2*NSLOT*SLOTB, LDS_OST=LDS_WS+NW*64*4, LDS_BYTES=LDS_OST+NW*4096;
constexpr float C2=0.125f*1.4426950408889634f;
__device__ __forceinline__ void glds16(const void*gsrc,unsigned lds_dst){unsigned keep;
  asm volatile("s_mov_b32 %0, m0\n\ts_mov_b32 m0, %2\n\ts_nop 0\n\tglobal_load_lds_dwordx4 %1, off\n\ts_mov_b32 m0, %0":"=&s"(keep):"v"(gsrc),"s"(lds_dst):"memory");}
__device__ __forceinline__ float max3f(float a,float b,float c){float r;asm("v_max3_f32 %0, %1, %2, %3":"=v"(r):"v"(a),"v"(b),"v"(c));return r;}
__device__ __forceinline__ float max2f(float a,float b){float r;asm("v_max_f32_e32 %0, %1, %2":"=v"(r):"v"(a),"v"(b));return r;}
__device__ __forceinline__ float fadd_s(float a,float b){float r;asm("v_add_f32_e32 %0, %1, %2":"=v"(r):"v"(a),"v"(b));return r;}
__device__ __forceinline__ float fsub_s(float a,float b){float r;asm("v_sub_f32_e32 %0, %1, %2":"=v"(r):"v"(a),"v"(b));return r;}
typedef float f32x2_t __attribute__((ext_vector_type(2))); typedef __bf16 bf16x2_t __attribute__((ext_vector_type(2)));
__device__ __forceinline__ unsigned cvtpk_s(float lo,float hi){f32x2_t v={lo,hi};bf16x2_t b=__builtin_convertvector(v,bf16x2_t);return __builtin_bit_cast(unsigned,b);}
#define WAIT_BAR(N) asm volatile("s_waitcnt vmcnt(" #N ") lgkmcnt(0)\n\ts_barrier":::"memory")

__device__ __forceinline__ void qkt(f32x16&p0,f32x16&p1,const char*Kslot,const bf16x8*qr,const f32x16&negm,int r32,int hi){
  const char*kb=Kslot+hi*1024+r32*16;
  #pragma unroll
  for(int d0=0;d0<4;++d0){
    const bf16x8 b0=*reinterpret_cast<const bf16x8*>(kb+d0*2048);
    const bf16x8 b1=*reinterpret_cast<const bf16x8*>(kb+d0*2048+512);
    if(d0==0){p0=__builtin_amdgcn_mfma_f32_32x32x16_bf16(b0,qr[0],negm,0,0,0);p1=__builtin_amdgcn_mfma_f32_32x32x16_bf16(b1,qr[0],negm,0,0,0);}
    else{p0=__builtin_amdgcn_mfma_f32_32x32x16_bf16(b0,qr[d0],p0,0,0,0);p1=__builtin_amdgcn_mfma_f32_32x32x16_bf16(b1,qr[d0],p1,0,0,0);}}
}
typedef __attribute__((address_space(3))) const char* lds_cptr;
typedef short v4i16_t __attribute__((ext_vector_type(4)));
__device__ __forceinline__ void kload8(bf16x8*kf,lds_cptr kp){
  kf[0]=*(const __attribute__((address_space(3))) bf16x8*)(kp);      kf[1]=*(const __attribute__((address_space(3))) bf16x8*)(kp+512);
  kf[2]=*(const __attribute__((address_space(3))) bf16x8*)(kp+2048); kf[3]=*(const __attribute__((address_space(3))) bf16x8*)(kp+2560);
  kf[4]=*(const __attribute__((address_space(3))) bf16x8*)(kp+4096); kf[5]=*(const __attribute__((address_space(3))) bf16x8*)(kp+4608);
  kf[6]=*(const __attribute__((address_space(3))) bf16x8*)(kp+6144); kf[7]=*(const __attribute__((address_space(3))) bf16x8*)(kp+6656);
}
__device__ __forceinline__ void kload2(bf16x8*kf,lds_cptr kp,int j){ kf[2*j]=*(const __attribute__((address_space(3))) bf16x8*)(kp+j*2048); kf[2*j+1]=*(const __attribute__((address_space(3))) bf16x8*)(kp+j*2048+512); }
__device__ __forceinline__ s16x4 vtr(lds_cptr p){ return __builtin_bit_cast(s16x4,__builtin_amdgcn_ds_read_tr16_b64_v4i16((__attribute__((address_space(3))) v4i16_t*)p)); }
__device__ __forceinline__ float rowmax(const f32x16&p0,const f32x16&p1){
  float a=max3f(p0[0],p0[1],p1[0]),b=max3f(p0[2],p0[3],p1[1]);a=max3f(a,p1[2],p1[3]);
  #pragma unroll
  for(int r=4;r<16;r+=4){a=max3f(a,p0[r],p0[r+1]);b=max3f(b,p0[r+2],p0[r+3]);a=max3f(a,p1[r],p1[r+1]);b=max3f(b,p1[r+2],p1[r+3]);}
  const float m=max2f(a,b);
  auto rr=__builtin_amdgcn_permlane32_swap(__float_as_uint(m),__float_as_uint(m),false,false);
  return max2f(__uint_as_float(rr[0]),__uint_as_float(rr[1]));
}
__device__ __forceinline__ void pv(f32x16*o,int vb,bf16x8 pa0,bf16x8 pa1,bf16x8 pa2,bf16x8 pa3){
  #pragma unroll
  for(int d0=0;d0<2;++d0){s16x4 lo[4],hi[4];
    #pragma unroll
    for(int ks=0;ks<4;++ks){
      asm volatile("ds_read_b64_tr_b16 %0,%1 offset:%c2":"=&v"(lo[ks]):"v"(vb),"i"(d0*4096+ks*1024):"memory");
      asm volatile("ds_read_b64_tr_b16 %0,%1 offset:%c2":"=&v"(hi[ks]):"v"(vb),"i"(d0*4096+ks*1024+512):"memory");}
    asm volatile("s_waitcnt lgkmcnt(0)":::"memory");SBAR();
    #define PK(k) (bf16x8){lo[k][0],lo[k][1],lo[k][2],lo[k][3],hi[k][0],hi[k][1],hi[k][2],hi[k][3]}
    o[d0]=__builtin_amdgcn_mfma_f32_32x32x16_bf16(pa0,PK(0),o[d0],0,0,0);
    o[d0]=__builtin_amdgcn_mfma_f32_32x32x16_bf16(pa1,PK(1),o[d0],0,0,0);
    o[d0]=__builtin_amdgcn_mfma_f32_32x32x16_bf16(pa2,PK(2),o[d0],0,0,0);
    o[d0]=__builtin_amdgcn_mfma_f32_32x32x16_bf16(pa3,PK(3),o[d0],0,0,0);
    #undef PK
  }
}
#define ATTN_STORE16(p,v) (*(u32x4*)(p)=(v))
template<int THRL> __device__ __forceinline__ void attn_unit(int b,int qc,int kc,int vc,int oc,int qb,const bf16*Q,const bf16*__restrict__ K,const bf16*__restrict__ V,bf16*O,char*shm){
  const int tid=threadIdx.x,lane=tid&63,r32=lane&31,hi=lane>>5; const int wid=__builtin_amdgcn_readfirstlane(tid>>6);
  const long rowbase=(long)b*SEQ; const int q0=qb*QB;
  const bf16*Qw=Q+(rowbase+q0+wid*QBLK)*DM+qc;
  const bf16*Kh=K+rowbase*DM+kc,*Vh=V+rowbase*DM+vc;
  const unsigned lds0=(unsigned)(uintptr_t)shm;
  float*wsf=(float*)(shm+LDS_WS)+wid*64;
  const bf16*ksrc=Kh+(long)lane*DM+wid*8;
  const bf16*vsrc=Vh+(long)(16*(wid&3)+(lane>>2))*DM+(wid>>2)*32+(lane&3)*8;
  const unsigned kdst=lds0+LDS_K+wid*1024, vdst=lds0+LDS_V+wid*1024;
  #define DMA_K(t,slot) glds16(ksrc+(long)(t)*KVBLK*DM,(unsigned)__builtin_amdgcn_readfirstlane(kdst+(slot)))
  #define DMA_V(t,slot) glds16(vsrc+(long)(t)*KVBLK*DM,(unsigned)__builtin_amdgcn_readfirstlane(vdst+(slot)))
  const int vb0=(int)(lds0+LDS_V)+((lane>>4)&1)*32+(lane&3)*8+(4*hi+((lane&15)>>2))*64;
  const char*Kbase=shm+LDS_K; bf16x8 kf[8];
  const lds_cptr shm3=(lds_cptr)shm; const lds_cptr kp0=shm3+LDS_K+hi*1024+r32*16; const lds_cptr vp0=shm3+LDS_V+((lane>>4)&1)*32+(lane&3)*8+(4*hi+((lane&15)>>2))*64;
  const int NT=(q0+QB)/KVBLK;
  DMA_K(0,0);DMA_V(0,0);DMA_K(1,SLOTB);
  bf16x8 qr[4];
  #pragma unroll
  for(int d0=0;d0<4;++d0)qr[d0]=*reinterpret_cast<const bf16x8*>(&Qw[(long)r32*DM+d0*16+hi*8]);
  float mhat=0.f,l_reg=0.f;f32x16 o[2];o[0]=f32x16{};o[1]=f32x16{};f32x16 negm=f32x16{};asm volatile("":"+v"(negm));
  const int qrel=wid*QBLK+r32;
  #define CMASK(P0,P1,t) do{int jb_=(t)-(NT-4); if(jb_>=0)cmask(P0,P1,jb_,qrel,hi);}while(0)
  bool resc=false;
  #define START(P0,P1) do{ const float rm=rowmax(P0,P1); resc=false; \
    { const float dl=rm; mhat=fadd_s(mhat,dl); \
      _Pragma("unroll") for(int r=0;r<16;++r){P0[r]=fsub_s(P0[r],dl);P1[r]=fsub_s(P1[r],dl);} \
      _Pragma("unroll") for(int r=0;r<16;++r)negm[r]=-mhat; asm volatile("":"+v"(negm)); } \
    _Pragma("unroll") for(int r=0;r<16;++r)P0[r]=__builtin_amdgcn_exp2f(P0[r]); }while(0)
  #define RESC() do{ if(resc){ asm volatile("s_waitcnt lgkmcnt(0)":::"memory"); \
      _Pragma("unroll") for(int d_=0;d_<2;++d_) _Pragma("unroll") for(int r=0;r<16;++r)o[d_][r]*=wsf[crow(r,hi)]; } }while(0)
  f32x16 pA0,pA1,pB0,pB1;
  int sl_prev=0,sl_cur=0,sl_next=SLOTB;
  #define ROT() do{sl_prev=sl_cur;sl_cur=sl_next;sl_next=(sl_next==(NSLOT-1)*SLOTB)?0:sl_next+SLOTB;}while(0)
  DMA_K(2,2*SLOTB);
  WAIT_BAR(3);
  qkt(pA0,pA1,Kbase,qr,negm,r32,hi);asm volatile("s_nop 15\n\ts_nop 7":"+v"(pA0),"+v"(pA1));CMASK(pA0,pA1,0);
  START(pA0,pA1);
  _Pragma("unroll") for(int r=0;r<16;++r)pA1[r]=__builtin_amdgcn_exp2f(pA1[r]);
  WAIT_BAR(0);
  DMA_K(3,0);DMA_V(1,SLOTB);
  ROT();
  kload8(kf,kp0+sl_cur);
  WAIT_BAR(2);
  s16x4 vlo[8],vhi[8]; u32x4 pw0,pw1,pw2,pw3;
  #define PKW(P,B) cvtpk_s(P[B],P[B+1])
  #define PAF(k) __builtin_bit_cast(bf16x8,pw##k)
  #define VFR(i) (bf16x8){vlo[i][0],vlo[i][1],vlo[i][2],vlo[i][3],vhi[i][0],vhi[i][1],vhi[i][2],vhi[i][3]}
  #define PIN(x) asm volatile("":"+v"(x))
  #define MX3(a,b,c) __builtin_fmaxf(__builtin_fmaxf((a),(b)),(c))
  #define GAPA(MF,A0,A1,A2,A3,W0,W1,PW) do{ MF; sacc+=A0; sacc+=A1; sacc+=A2; sacc+=A3; PIN(sacc); W0; W1; PIN(PW); SBAR(); }while(0)
  #define EX(v) __builtin_amdgcn_exp2f(v)
  #define GAPB(MF,X,B) do{ MF; X[B]=EX(X[B]); X[B+1]=EX(X[B+1]); X[B+2]=EX(X[B+2]); X[B+3]=EX(X[B+3]); PIN(X); SBAR(); }while(0)
  #define VRD(i) do{ vlo[i]=vtr(vp_+(((i)>>2)*4096+((i)&3)*1024)); vhi[i]=vtr(vp_+(((i)>>2)*4096+((i)&3)*1024+512)); }while(0)
  #define KRD(G,j) do{ if(G){ kload2(kf,kp0+sl_next,j); SBAR(); } }while(0)
  #define STEP(C0,C1,P0,P1,t,GK,GV,GL) do{ SBAR(); \
    const lds_cptr vp_=vp0+sl_prev; \
    VRD(0); SBAR(); float sacc=(P0[0]+P0[1]); \
    GAPA(C0=__builtin_amdgcn_mfma_f32_32x32x16_bf16(kf[0],qr[0],negm,0,0,0), P0[2],P0[3],P0[4],P0[5],     pw0[0]=PKW(P0,0), pw0[1]=PKW(P0,2), pw0); \
    VRD(4); SBAR(); GAPA(C1=__builtin_amdgcn_mfma_f32_32x32x16_bf16(kf[1],qr[0],negm,0,0,0), P0[6],P0[7],P0[8],P0[9],     pw0[2]=PKW(P0,4), pw0[3]=PKW(P0,6), pw0); \
    VRD(1); SBAR(); GAPA(C0=__builtin_amdgcn_mfma_f32_32x32x16_bf16(kf[2],qr[1],C0,0,0,0),   P0[10],P0[11],P0[12],P0[13], pw1[0]=PKW(P0,8), pw1[1]=PKW(P0,10), pw1); \
    VRD(5); SBAR(); GAPA(C1=__builtin_amdgcn_mfma_f32_32x32x16_bf16(kf[3],qr[1],C1,0,0,0),   P0[14],P0[15],P1[0],P1[1],   pw1[2]=PKW(P0,12),pw1[3]=PKW(P0,14), pw1); \
    VRD(2); SBAR(); GAPA(C0=__builtin_amdgcn_mfma_f32_32x32x16_bf16(kf[4],qr[2],C0,0,0,0),   P1[2],P1[3],P1[4],P1[5],     pw2[0]=PKW(P1,0), pw2[1]=PKW(P1,2), pw2); \
    VRD(6); SBAR(); GAPA(C1=__builtin_amdgcn_mfma_f32_32x32x16_bf16(kf[5],qr[2],C1,0,0,0),   P1[6],P1[7],P1[8],P1[9],     pw2[2]=PKW(P1,4), pw2[3]=PKW(P1,6), pw2); \
    VRD(3); SBAR(); GAPA(C0=__builtin_amdgcn_mfma_f32_32x32x16_bf16(kf[6],qr[3],C0,0,0,0),   P1[10],P1[11],P1[12],P1[13], pw3[0]=PKW(P1,8), pw3[1]=PKW(P1,10), pw3); \
    VRD(7); SBAR(); GAPA(C1=__builtin_amdgcn_mfma_f32_32x32x16_bf16(kf[7],qr[3],C1,0,0,0),   P1[14],P1[15],0.f,0.f,       pw3[2]=PKW(P1,12),pw3[3]=PKW(P1,14), pw3); \
    l_reg+=sacc; \
    if(GK){DMA_K((t)+3,sl_cur);} if(GV){DMA_V((t)+1,sl_next);} \
    CMASK(C0,C1,t); \
    { float a=MX3(C0[0],C0[1],C1[0]),b=MX3(C0[2],C0[3],C1[1]); a=MX3(a,C1[2],C1[3]); \
      _Pragma("unroll") for(int r=4;r<16;r+=4){a=MX3(a,C0[r],C0[r+1]);b=MX3(b,C0[r+2],C0[r+3]);a=MX3(a,C1[r],C1[r+1]);b=MX3(b,C1[r+2],C1[r+3]);} \
      float rm=__builtin_fmaxf(a,b); { auto rr=__builtin_amdgcn_permlane32_swap(__float_as_uint(rm),__float_as_uint(rm),false,false); rm=__builtin_fmaxf(__uint_as_float(rr[0]),__uint_as_float(rr[1])); } \
      resc=false; \
      if(__builtin_expect(__any(rm>(float)THRL),0)){ const float dl=__builtin_fmaxf(rm,0.f); mhat+=dl; \
        _Pragma("unroll") for(int r=0;r<16;++r){C0[r]-=dl;C1[r]-=dl;} \
        _Pragma("unroll") for(int r=0;r<16;++r)negm[r]=-mhat; asm volatile("":"+v"(negm)); \
        const float f=__builtin_amdgcn_exp2f(-dl); l_reg*=f; if(hi==0)wsf[r32]=f; resc=true; } } \
    SBAR(); \
    GAPB(o[0]=__builtin_amdgcn_mfma_f32_32x32x16_bf16(PAF(0),VFR(0),o[0],0,0,0), C0,0); \
    GAPB(o[1]=__builtin_amdgcn_mfma_f32_32x32x16_bf16(PAF(0),VFR(4),o[1],0,0,0), C0,4); \
    KRD(GL,0); GAPB(o[0]=__builtin_amdgcn_mfma_f32_32x32x16_bf16(PAF(1),VFR(1),o[0],0,0,0), C0,8); \
    KRD(GL,1); GAPB(o[1]=__builtin_amdgcn_mfma_f32_32x32x16_bf16(PAF(1),VFR(5),o[1],0,0,0), C0,12); \
    KRD(GL,2); GAPB(o[0]=__builtin_amdgcn_mfma_f32_32x32x16_bf16(PAF(2),VFR(2),o[0],0,0,0), C1,0); \
    KRD(GL,3); GAPB(o[1]=__builtin_amdgcn_mfma_f32_32x32x16_bf16(PAF(2),VFR(6),o[1],0,0,0), C1,4); \
    GAPB(o[0]=__builtin_amdgcn_mfma_f32_32x32x16_bf16(PAF(3),VFR(3),o[0],0,0,0), C1,8); \
    GAPB(o[1]=__builtin_amdgcn_mfma_f32_32x32x16_bf16(PAF(3),VFR(7),o[1],0,0,0), C1,12); \
    }while(0)
  int t=1;
  #undef CMASK
  #define CMASK(P0,P1,t) do{}while(0)
  for(;t+5<NT;t+=2){
    STEP(pB0,pB1,pA0,pA1,t,true,true,true);     WAIT_BAR(2); RESC(); ROT();
    STEP(pA0,pA1,pB0,pB1,t+1,true,true,true);   WAIT_BAR(2); RESC(); ROT();
  }
  #undef CMASK
  #define CMASK(P0,P1,t) do{int jb_=(t)-(NT-4); if(jb_>=0)cmask(P0,P1,jb_,qrel,hi);}while(0)
  #define ENDW(tt) do{ if((tt)+3<NT){WAIT_BAR(2);} else if((tt)+2<NT){WAIT_BAR(1);} else {WAIT_BAR(0);} }while(0)
  for(;t+1<NT;t+=2){
    STEP(pB0,pB1,pA0,pA1,t,(t+3<NT),(t+1<NT),(t+1<NT));       ENDW(t);   RESC(); ROT();
    STEP(pA0,pA1,pB0,pB1,t+1,(t+4<NT),(t+2<NT),(t+2<NT));     ENDW(t+1); RESC(); ROT();
  }
  STEP(pB0,pB1,pA0,pA1,NT-1,false,false,false); RESC();
  { float sacc=pB0[0]+pB0[1]; _Pragma("unroll") for(int r=2;r<16;++r)sacc+=pB0[r]; _Pragma("unroll") for(int r=0;r<16;++r)sacc+=pB1[r]; l_reg+=sacc;
    pw0=(u32x4){PKW(pB0,0),PKW(pB0,2),PKW(pB0,4),PKW(pB0,6)};pw1=(u32x4){PKW(pB0,8),PKW(pB0,10),PKW(pB0,12),PKW(pB0,14)};pw2=(u32x4){PKW(pB1,0),PKW(pB1,2),PKW(pB1,4),PKW(pB1,6)};pw3=(u32x4){PKW(pB1,8),PKW(pB1,10),PKW(pB1,12),PKW(pB1,14)};
    SBAR(); pv(o,vb0+sl_cur,PAF(0),PAF(1),PAF(2),PAF(3)); }
  #undef PKW
  #undef PAF
  #undef VFR
  #undef PIN
  #undef MX3
  #undef GAPA
  #undef GAPB
  #undef EX
  #undef VRD
  #undef KRD
  #undef STEP
  #undef ENDW
  {auto rr=__builtin_amdgcn_permlane32_swap(__float_as_uint(l_reg),__float_as_uint(l_reg),false,false);l_reg=__uint_as_float(rr[0])+__uint_as_float(rr[1]);}
  if(hi==0)wsf[32+r32]=l_reg;asm volatile("s_waitcnt lgkmcnt(0)":::"memory");
  float rli[16];
  #pragma unroll
  for(int r=0;r<16;++r)rli[r]=__builtin_amdgcn_rcpf(wsf[32+crow(r,hi)]);
  bf16*Ow=O+(rowbase+q0+wid*QBLK)*DM+oc;
  { bf16*stg=(bf16*)(shm+LDS_OST)+wid*2048;
    #pragma unroll
    for(int r=0;r<16;++r){const int orow=crow(r,hi);
      #pragma unroll
      for(int d0=0;d0<2;++d0)stg[orow*64+d0*32+r32]=__float2bfloat16(o[d0][r]*rli[r]);}
    asm volatile("s_waitcnt lgkmcnt(0)":::"memory");
    #pragma unroll
    for(int i=0;i<4;++i){const int row=i*8+(lane>>3),ch=lane&7; const u32x4 v=*(const u32x4*)(stg+row*64+ch*8); ATTN_STORE16(Ow+(long)row*DM+ch*8,v);} }
  asm volatile("s_waitcnt lgkmcnt(0)\n\ts_barrier":::"memory");
  #undef DMA_K
  #undef DMA_V
  #undef CMASK
  #undef START
  #undef RESC
  #undef ROT
}
constexpr int ATTN_LDS_BYTES=LDS_BYTES;
#undef SBAR
#undef WAIT_BAR
}

namespace attn2 {
using namespace attn_body;
constexpr int NKS=4, SLOTK=8192, NVS=3, SLOTV=16384;
constexpr int A2_K=0, A2_V=NKS*SLOTK, A2_WS=A2_V+NVS*SLOTV, A2_OST=A2_WS+NW*64*4, A2_BYTES=A2_OST+NW*4096;
#define SBAR() __builtin_amdgcn_sched_barrier(0)
#define WAIT_BAR(N) asm volatile("s_waitcnt vmcnt(" #N ") lgkmcnt(0)\n\ts_barrier":::"memory")
typedef __attribute__((address_space(3))) const bf16x8* lds_b8;
typedef float f32x4_t __attribute__((ext_vector_type(4)));
__device__ __forceinline__ bf16x8 KL(lds_cptr p){ return *(lds_b8)p; }
__device__ __forceinline__ void glds16s(const void*sbase,unsigned voff,unsigned lds_dst){unsigned keep;
  asm volatile("s_mov_b32 %0, m0\n\ts_mov_b32 m0, %3\n\ts_nop 0\n\tglobal_load_lds_dwordx4 %1, %2\n\ts_mov_b32 m0, %0":"=&s"(keep):"v"(voff),"s"(sbase),"s"(lds_dst):"memory");}
__device__ __forceinline__ void pv4(f32x16*o,int vb,bf16x8 pa0,bf16x8 pa1,bf16x8 pa2,bf16x8 pa3){
  #pragma unroll
  for(int d0=0;d0<4;++d0){s16x4 lo[4],hi[4];
    #pragma unroll
    for(int ks=0;ks<4;++ks){
      asm volatile("ds_read_b64_tr_b16 %0,%1 offset:%c2":"=&v"(lo[ks]):"v"(vb),"i"(d0*4096+ks*1024):"memory");
      asm volatile("ds_read_b64_tr_b16 %0,%1 offset:%c2":"=&v"(hi[ks]):"v"(vb),"i"(d0*4096+ks*1024+512):"memory");}
    asm volatile("s_waitcnt lgkmcnt(0)":::"memory");SBAR();
    #define PK(k) (bf16x8){lo[k][0],lo[k][1],lo[k][2],lo[k][3],hi[k][0],hi[k][1],hi[k][2],hi[k][3]}
    o[d0]=__builtin_amdgcn_mfma_f32_32x32x16_bf16(pa0,PK(0),o[d0],0,0,0);
    o[d0]=__builtin_amdgcn_mfma_f32_32x32x16_bf16(pa1,PK(1),o[d0],0,0,0);
    o[d0]=__builtin_amdgcn_mfma_f32_32x32x16_bf16(pa2,PK(2),o[d0],0,0,0);
    o[d0]=__builtin_amdgcn_mfma_f32_32x32x16_bf16(pa3,PK(3),o[d0],0,0,0);
    #undef PK
  }
}
template<int THRL,long A_OFF,long SG_OFF> __device__ __forceinline__ void attn_unit(int b,int qc,int kc,int vc,int oc,int qb,const bf16*Q,const bf16*__restrict__ K,const bf16*__restrict__ V,bf16*O,char*shm){
  const int MODE=(oc>>7)&1;
  const int tid=threadIdx.x,lane=tid&63,r32=lane&31,hi=lane>>5; const int wid=__builtin_amdgcn_readfirstlane(tid>>6);
  const long rowbase=(long)b*SEQ; const int q0=qb*QB;
  const bf16*Qw=Q+(rowbase+q0+wid*QBLK)*DM+qc;
  const bf16*Kh=K+rowbase*DM+kc,*Vh=V+rowbase*DM+vc;
  const unsigned lds0=(unsigned)(uintptr_t)shm;
  float*wsf=(float*)(shm+A2_WS)+wid*64;
  const unsigned koff=(unsigned)(lane*DM+wid*8)*2u;
  const unsigned voff=(unsigned)((16*(wid&3)+(lane>>2))*DM+(wid>>2)*32+(lane&3)*8)*2u;
  const unsigned kdst=lds0+A2_K+wid*1024, vdst=lds0+A2_V+wid*1024;
  #define DMA_K(t) glds16s(Kh+(long)(t)*KVBLK*DM,koff,(unsigned)__builtin_amdgcn_readfirstlane(kdst+(((t)&3)*SLOTK)))
  #define DMA_V(t,slot) do{ glds16s(Vh+(long)(t)*KVBLK*DM,voff,(unsigned)__builtin_amdgcn_readfirstlane(vdst+(slot))); glds16s(Vh+(long)(t)*KVBLK*DM+64,voff,(unsigned)__builtin_amdgcn_readfirstlane(vdst+(slot)+8192)); }while(0)
  const char*Kbase=shm+A2_K;
  const lds_cptr shm3=(lds_cptr)shm; const lds_cptr kp0=shm3+A2_K+hi*1024+r32*16; const lds_cptr vp0=shm3+A2_V+((lane>>4)&1)*32+(lane&3)*8+(4*hi+((lane&15)>>2))*64;
  const int NT=(q0+QB)/KVBLK;
  DMA_K(0);DMA_V(0,0);DMA_K(1);
  bf16x8 qr[4];
  #pragma unroll
  for(int d0=0;d0<4;++d0)qr[d0]=*reinterpret_cast<const bf16x8*>(&Qw[(long)r32*DM+d0*16+hi*8]);
  float mhat=0.f,l_reg=0.f;f32x16 o[4];o[0]=f32x16{};o[1]=f32x16{};o[2]=f32x16{};o[3]=f32x16{};f32x16 negm=f32x16{};asm volatile("":"+v"(negm));
  const int qrel=wid*QBLK+r32;
  #define CMASK(P0,P1,t) do{int jb_=(t)-(NT-4); if(jb_>=0)cmask(P0,P1,jb_,qrel,hi);}while(0)
  bool resc=false;
  #define START(P0,P1) do{ const float rm=rowmax(P0,P1); resc=false; \
    { const float dl=rm; mhat=fadd_s(mhat,dl); \
      _Pragma("unroll") for(int r=0;r<16;++r){P0[r]=fsub_s(P0[r],dl);P1[r]=fsub_s(P1[r],dl);} \
      _Pragma("unroll") for(int r=0;r<16;++r)negm[r]=-mhat; asm volatile("":"+v"(negm)); } \
    _Pragma("unroll") for(int r=0;r<16;++r)P0[r]=__builtin_amdgcn_exp2f(P0[r]); }while(0)
  #define RESC() do{ if(resc){ asm volatile("s_waitcnt lgkmcnt(0)":::"memory"); \
      _Pragma("unroll") for(int d_=0;d_<4;++d_) _Pragma("unroll") for(int r=0;r<16;++r)o[d_][r]*=wsf[crow(r,hi)]; } }while(0)
  f32x16 pA0,pA1,pB0,pB1;
  int vs_prev=0,vs_cur=0,vs_next=SLOTV;
  #define ROT() do{vs_prev=vs_cur;vs_cur=vs_next;vs_next=(vs_next==(NVS-1)*SLOTV)?0:vs_next+SLOTV;}while(0)
  DMA_K(2);
  WAIT_BAR(4);
  qkt(pA0,pA1,Kbase,qr,negm,r32,hi);asm volatile("s_nop 15\n\ts_nop 7":"+v"(pA0),"+v"(pA1));CMASK(pA0,pA1,0);
  START(pA0,pA1);
  _Pragma("unroll") for(int r=0;r<16;++r)pA1[r]=__builtin_amdgcn_exp2f(pA1[r]);
  WAIT_BAR(0);
  DMA_K(3);DMA_V(1,SLOTV);
  ROT();
  bf16x8 kn0=KL(kp0+SLOTK),kn1=KL(kp0+SLOTK+512);
  s16x4 vlo[8],vhi[8]; u32x4 pw0,pw1,pw2,pw3;
  #define PKW(P,B) cvtpk_s(P[B],P[B+1])
  #define PAF(k) __builtin_bit_cast(bf16x8,pw##k)
  #define VFR(i) (bf16x8){vlo[i][0],vlo[i][1],vlo[i][2],vlo[i][3],vhi[i][0],vhi[i][1],vhi[i][2],vhi[i][3]}
  #define PIN(x) asm volatile("":"+v"(x))
  #define MX3(a,b,c) __builtin_fmaxf(__builtin_fmaxf((a),(b)),(c))
  #define GAPA(MF,A0,A1,A2,A3,W0,W1,PW) do{ MF; sacc+=A0; sacc+=A1; sacc+=A2; sacc+=A3; PIN(sacc); W0; W1; PIN(PW); SBAR(); }while(0)
  #define EX(v) __builtin_amdgcn_exp2f(v)
  #define GAPB(MF,X,B) do{ MF; X[B]=EX(X[B]); X[B+1]=EX(X[B+1]); PIN(X); SBAR(); }while(0)
  #define VRD(i) do{ vlo[i]=vtr(vp_+(((i)>>2)*4096+((i)&3)*1024)); vhi[i]=vtr(vp_+(((i)>>2)*4096+((i)&3)*1024+512)); }while(0)
  #define VRH(i) do{ vlo[i]=vtr(vp_+(8192+((i)>>2)*4096+((i)&3)*1024)); vhi[i]=vtr(vp_+(8192+((i)>>2)*4096+((i)&3)*1024+512)); SBAR(); }while(0)
  #define STEP(C0,C1,P0,P1,t,GK,GV,GL) do{ SBAR(); \
    const lds_cptr vp_=vp0+vs_prev; const lds_cptr kq_=kp0+(((t)&3)*SLOTK); \
    bf16x8 ka0=kn0,ka1=kn1,kb0,kb1; \
    kb0=KL(kq_+2048); kb1=KL(kq_+2560); VRD(0); SBAR(); float sacc=(P0[0]+P0[1]); \
    GAPA(C0=__builtin_amdgcn_mfma_f32_32x32x16_bf16(ka0,qr[0],negm,0,0,0), P0[2],P0[3],P0[4],P0[5],     pw0[0]=PKW(P0,0), pw0[1]=PKW(P0,2), pw0); \
    VRD(4); SBAR(); GAPA(C1=__builtin_amdgcn_mfma_f32_32x32x16_bf16(ka1,qr[0],negm,0,0,0), P0[6],P0[7],P0[8],P0[9],     pw0[2]=PKW(P0,4), pw0[3]=PKW(P0,6), pw0); \
    ka0=KL(kq_+4096); ka1=KL(kq_+4608); VRD(1); SBAR(); GAPA(C0=__builtin_amdgcn_mfma_f32_32x32x16_bf16(kb0,qr[1],C0,0,0,0),   P0[10],P0[11],P0[12],P0[13], pw1[0]=PKW(P0,8), pw1[1]=PKW(P0,10), pw1); \
    VRD(5); SBAR(); GAPA(C1=__builtin_amdgcn_mfma_f32_32x32x16_bf16(kb1,qr[1],C1,0,0,0),   P0[14],P0[15],P1[0],P1[1],   pw1[2]=PKW(P0,12),pw1[3]=PKW(P0,14), pw1); \
    kb0=KL(kq_+6144); kb1=KL(kq_+6656); VRD(2); SBAR(); GAPA(C0=__builtin_amdgcn_mfma_f32_32x32x16_bf16(ka0,qr[2],C0,0,0,0),   P1[2],P1[3],P1[4],P1[5],     pw2[0]=PKW(P1,0), pw2[1]=PKW(P1,2), pw2); \
    VRD(6); SBAR(); GAPA(C1=__builtin_amdgcn_mfma_f32_32x32x16_bf16(ka1,qr[2],C1,0,0,0),   P1[6],P1[7],P1[8],P1[9],     pw2[2]=PKW(P1,4), pw2[3]=PKW(P1,6), pw2); \
    VRD(3); SBAR(); GAPA(C0=__builtin_amdgcn_mfma_f32_32x32x16_bf16(kb0,qr[3],C0,0,0,0),   P1[10],P1[11],P1[12],P1[13], pw3[0]=PKW(P1,8), pw3[1]=PKW(P1,10), pw3); \
    VRD(7); SBAR(); GAPA(C1=__builtin_amdgcn_mfma_f32_32x32x16_bf16(kb1,qr[3],C1,0,0,0),   P1[14],P1[15],0.f,0.f,       pw3[2]=PKW(P1,12),pw3[3]=PKW(P1,14), pw3); \
    l_reg+=sacc; \
    if(GK){DMA_K((t)+3);} if(GV){DMA_V((t)+1,vs_next);} \
    CMASK(C0,C1,t); \
    { float a=MX3(C0[0],C0[1],C1[0]),b=MX3(C0[2],C0[3],C1[1]); a=MX3(a,C1[2],C1[3]); \
      _Pragma("unroll") for(int r=4;r<16;r+=4){a=MX3(a,C0[r],C0[r+1]);b=MX3(b,C0[r+2],C0[r+3]);a=MX3(a,C1[r],C1[r+1]);b=MX3(b,C1[r+2],C1[r+3]);} \
      float rm=__builtin_fmaxf(a,b); { auto rr=__builtin_amdgcn_permlane32_swap(__float_as_uint(rm),__float_as_uint(rm),false,false); rm=__builtin_fmaxf(__uint_as_float(rr[0]),__uint_as_float(rr[1])); } \
      resc=false; \
      if(__builtin_expect(__any(rm>(float)THRL),0)){ const float dl=__builtin_fmaxf(rm,0.f); mhat+=dl; \
        _Pragma("unroll") for(int r=0;r<16;++r){C0[r]-=dl;C1[r]-=dl;} \
        _Pragma("unroll") for(int r=0;r<16;++r)negm[r]=-mhat; asm volatile("":"+v"(negm)); \
        const float f=__builtin_amdgcn_exp2f(-dl); l_reg*=f; if(hi==0)wsf[r32]=f; resc=true; } } \
    SBAR(); \
    GAPB(o[0]=__builtin_amdgcn_mfma_f32_32x32x16_bf16(PAF(0),VFR(0),o[0],0,0,0), C0,0);  VRH(0); \
    GAPB(o[1]=__builtin_amdgcn_mfma_f32_32x32x16_bf16(PAF(0),VFR(4),o[1],0,0,0), C0,2);  VRH(4); \
    GAPB(o[0]=__builtin_amdgcn_mfma_f32_32x32x16_bf16(PAF(1),VFR(1),o[0],0,0,0), C0,4);  VRH(1); \
    GAPB(o[1]=__builtin_amdgcn_mfma_f32_32x32x16_bf16(PAF(1),VFR(5),o[1],0,0,0), C0,6);  VRH(5); \
    GAPB(o[0]=__builtin_amdgcn_mfma_f32_32x32x16_bf16(PAF(2),VFR(2),o[0],0,0,0), C0,8);  VRH(2); \
    GAPB(o[1]=__builtin_amdgcn_mfma_f32_32x32x16_bf16(PAF(2),VFR(6),o[1],0,0,0), C0,10); VRH(6); \
    GAPB(o[0]=__builtin_amdgcn_mfma_f32_32x32x16_bf16(PAF(3),VFR(3),o[0],0,0,0), C0,12); VRH(3); \
    GAPB(o[1]=__builtin_amdgcn_mfma_f32_32x32x16_bf16(PAF(3),VFR(7),o[1],0,0,0), C0,14); VRH(7); \
    GAPB(o[2]=__builtin_amdgcn_mfma_f32_32x32x16_bf16(PAF(0),VFR(0),o[2],0,0,0), C1,0); \
    GAPB(o[3]=__builtin_amdgcn_mfma_f32_32x32x16_bf16(PAF(0),VFR(4),o[3],0,0,0), C1,2); \
    if(GL){ kn0=KL(kp0+((((t)+1)&3)*SLOTK)); kn1=KL(kp0+((((t)+1)&3)*SLOTK)+512); SBAR(); } \
    GAPB(o[2]=__builtin_amdgcn_mfma_f32_32x32x16_bf16(PAF(1),VFR(1),o[2],0,0,0), C1,4); \
    GAPB(o[3]=__builtin_amdgcn_mfma_f32_32x32x16_bf16(PAF(1),VFR(5),o[3],0,0,0), C1,6); \
    GAPB(o[2]=__builtin_amdgcn_mfma_f32_32x32x16_bf16(PAF(2),VFR(2),o[2],0,0,0), C1,8); \
    GAPB(o[3]=__builtin_amdgcn_mfma_f32_32x32x16_bf16(PAF(2),VFR(6),o[3],0,0,0), C1,10); \
    GAPB(o[2]=__builtin_amdgcn_mfma_f32_32x32x16_bf16(PAF(3),VFR(3),o[2],0,0,0), C1,12); \
    GAPB(o[3]=__builtin_amdgcn_mfma_f32_32x32x16_bf16(PAF(3),VFR(7),o[3],0,0,0), C1,14); \
    }while(0)
  int t=1;
  #undef CMASK
  #define CMASK(P0,P1,t) do{}while(0)
  for(;t+5<NT;t+=2){
    STEP(pB0,pB1,pA0,pA1,t,true,true,true);     WAIT_BAR(3); RESC(); ROT();
    STEP(pA0,pA1,pB0,pB1,t+1,true,true,true);   WAIT_BAR(3); RESC(); ROT();
  }
  #undef CMASK
  #define CMASK(P0,P1,t) do{int jb_=(t)-(NT-4); if(jb_>=0)cmask(P0,P1,jb_,qrel,hi);}while(0)
  #define ENDW(tt) do{ if((tt)+3<NT){WAIT_BAR(3);} else if((tt)+2<NT){WAIT_BAR(2);} else {WAIT_BAR(0);} }while(0)
  for(;t+1<NT;t+=2){
    STEP(pB0,pB1,pA0,pA1,t,(t+3<NT),(t+1<NT),(t+1<NT));       ENDW(t);   RESC(); ROT();
    STEP(pA0,pA1,pB0,pB1,t+1,(t+4<NT),(t+2<NT),(t+2<NT));     ENDW(t+1); RESC(); ROT();
  }
  STEP(pB0,pB1,pA0,pA1,NT-1,false,false,false); RESC();
  { float sacc=pB0[0]+pB0[1]; _Pragma("unroll") for(int r=2;r<16;++r)sacc+=pB0[r]; _Pragma("unroll") for(int r=0;r<16;++r)sacc+=pB1[r]; l_reg+=sacc;
    pw0=(u32x4){PKW(pB0,0),PKW(pB0,2),PKW(pB0,4),PKW(pB0,6)};pw1=(u32x4){PKW(pB0,8),PKW(pB0,10),PKW(pB0,12),PKW(pB0,14)};pw2=(u32x4){PKW(pB1,0),PKW(pB1,2),PKW(pB1,4),PKW(pB1,6)};pw3=(u32x4){PKW(pB1,8),PKW(pB1,10),PKW(pB1,12),PKW(pB1,14)};
    SBAR(); pv4(o,(int)(unsigned)(uintptr_t)vp0+vs_cur,PAF(0),PAF(1),PAF(2),PAF(3)); }
  #undef PKW
  #undef PAF
  #undef VFR
  #undef PIN
  #undef MX3
  #undef GAPA
  #undef GAPB
  #undef EX
  #undef VRD
  #undef VRH
  #undef STEP
  #undef ENDW
  {auto rr=__builtin_amdgcn_permlane32_swap(__float_as_uint(l_reg),__float_as_uint(l_reg),false,false);l_reg=__uint_as_float(rr[0])+__uint_as_float(rr[1]);}
  if(hi==0)wsf[32+r32]=l_reg;asm volatile("s_waitcnt lgkmcnt(0)":::"memory");
  float rli[16];
  #pragma unroll
  for(int r=0;r<16;++r)rli[r]=__builtin_amdgcn_rcpf(wsf[32+crow(r,hi)]);
  bf16*Ow=O+(rowbase+q0+wid*QBLK)*DM+oc;
  bf16*stg=(bf16*)(shm+A2_OST)+wid*2048;
  if(MODE==0){
    #pragma unroll
    for(int hf=0;hf<2;++hf){
      #pragma unroll
      for(int r=0;r<16;++r){const int orow=crow(r,hi);
        #pragma unroll
        for(int d0=0;d0<2;++d0)stg[orow*64+d0*32+r32]=__float2bfloat16(o[2*hf+d0][r]*rli[r]);}
      asm volatile("s_waitcnt lgkmcnt(0)":::"memory");
      #pragma unroll
      for(int i=0;i<4;++i){const int row=i*8+(lane>>3),ch=lane&7; const u32x4 v=*(const u32x4*)(stg+row*64+ch*8); ATTN_STORE16(Ow+(long)row*DM+hf*64+ch*8,v);}
      asm volatile("s_waitcnt lgkmcnt(0)":::"memory"); }
  } else {
    const bf16*O1w=Ow-128; bf16*Aw=(bf16*)((char*)O+A_OFF)+(rowbase+q0+wid*QBLK)*DM+(oc>>8)*128; const float*subln=(const float*)((const char*)O+SG_OFF); const float lam=subln[128];
    asm volatile("s_waitcnt vmcnt(0)":::"memory");
    float dv[2][4][8]; float ssq[4]={0.f,0.f,0.f,0.f};
    #pragma unroll
    for(int hf=0;hf<2;++hf){
      #pragma unroll
      for(int r=0;r<16;++r){const int orow=crow(r,hi);
        #pragma unroll
        for(int d0=0;d0<2;++d0)stg[orow*64+d0*32+r32]=__float2bfloat16(o[2*hf+d0][r]*rli[r]);}
      asm volatile("s_waitcnt lgkmcnt(0)":::"memory");
      #pragma unroll
      for(int i=0;i<4;++i){const int row=i*8+(lane>>3),ch=lane&7; const u32x4 v=*(const u32x4*)(stg+row*64+ch*8); const u32x4 a=*(const u32x4*)(O1w+(long)row*DM+hf*64+ch*8);
        #pragma unroll
        for(int j=0;j<4;++j){ const float d0_=__uint_as_float(a[j]<<16)-lam*__uint_as_float(v[j]<<16), d1_=__uint_as_float(a[j]&0xffff0000u)-lam*__uint_as_float(v[j]&0xffff0000u);
          dv[hf][i][2*j]=d0_; dv[hf][i][2*j+1]=d1_; ssq[i]+=d0_*d0_+d1_*d1_; } }
      asm volatile("s_waitcnt lgkmcnt(0)":::"memory"); }
    #pragma unroll
    for(int i=0;i<4;++i){ float q_=ssq[i]; q_+=__shfl_xor(q_,1); q_+=__shfl_xor(q_,2); q_+=__shfl_xor(q_,4); ssq[i]=1.0f/sqrtf(q_*(1.f/128.f)+1e-6f); }
    #pragma unroll
    for(int hf=0;hf<2;++hf){ const int ch=lane&7;
      const f32x4_t g0=*(const f32x4_t*)(subln+hf*64+ch*8), g1=*(const f32x4_t*)(subln+hf*64+ch*8+4);
      #pragma unroll
      for(int i=0;i<4;++i){const int row=i*8+(lane>>3); const float r_=ssq[i]; u32x4 w;
        w[0]=cvtpk_s(dv[hf][i][0]*r_*g0[0],dv[hf][i][1]*r_*g0[1]); w[1]=cvtpk_s(dv[hf][i][2]*r_*g0[2],dv[hf][i][3]*r_*g0[3]);
        w[2]=cvtpk_s(dv[hf][i][4]*r_*g1[0],dv[hf][i][5]*r_*g1[1]); w[3]=cvtpk_s(dv[hf][i][6]*r_*g1[2],dv[hf][i][7]*r_*g1[3]);
        ATTN_STORE16(Aw+(long)row*DM+hf*64+ch*8,w);} }
  }
  asm volatile("s_waitcnt lgkmcnt(0)\n\ts_barrier":::"memory");
  #undef DMA_K
  #undef DMA_V
  #undef CMASK
  #undef START
  #undef RESC
  #undef ROT
}
#undef SBAR
#undef WAIT_BAR
}

constexpr int NWAVES = 8;
constexpr int NB = 8, SEQ = 4096, DMODEL = 1024, NTOK = NB * SEQ;
constexpr int DINP = 2048, NEXP = 32, TOPK = 4, PLE = 256;
constexpr float EPS = 1e-6f;
constexpr int PMAXROWS = NTOK * TOPK + NEXP * 256;

constexpr size_t MiB = 1u << 20, KiB = 1u << 10;
constexpr size_t WS_CTL = 0, CTL_ZERO_BYTES = 192 * KiB;
constexpr size_t WS_SS = 64 * KiB;
constexpr size_t WS_TOKE = 192 * KiB, WS_TOKG = WS_TOKE + 512 * KiB, WS_TOKP = WS_TOKG + 512 * KiB;
constexpr size_t WS_WRS = 2304 * KiB;
constexpr size_t WS_SG = 2432 * KiB;
constexpr size_t WS_CS = 4 * MiB;
constexpr size_t WS_WGU = 6 * MiB;
constexpr size_t WS_WD = 70 * MiB;
constexpr size_t WS_WG = 102 * MiB;
constexpr size_t WS_WP = 104 * MiB;
constexpr size_t WS_XN = 105 * MiB;
constexpr size_t WS_R = 169 * MiB;
constexpr size_t WS_QK = WS_R, WS_VU = WS_R + 64 * MiB, WS_ACAT = WS_R + 128 * MiB, WS_O16 = WS_R + 192 * MiB, WS_WIN = WS_R + 256 * MiB, WS_WOUT = WS_R + 260 * MiB;
constexpr size_t WS_HDN = 137 * MiB;
constexpr size_t WS_Y = 273 * MiB;
constexpr size_t WS_XN3 = 137 * MiB, WS_PB = 432 * MiB, WS_ER = 448 * MiB;
constexpr size_t WS_END = WS_Y + 128 * MiB;
constexpr size_t WS_H2B = 169 * MiB;
constexpr size_t WS_TOP = 522 * MiB;
constexpr size_t WS_ELIST = 520 * MiB;
static_assert(WS_END <= WS_PB && WS_ER + 64 * MiB <= 560 * MiB && WS_WOUT + 2 * MiB <= WS_PB && WS_END <= 560 * MiB && WS_WOUT + 2 * MiB <= 560 * MiB && WS_HDN + (size_t)PMAXROWS * 1024 <= WS_Y, "d_ws map");
constexpr int CW_CNT = 0;
constexpr int CW_BAR = 1024;

constexpr int RING_OFF = 0, RING_BYTES = 131072;
constexpr int LDSCTL_OFF = RING_BYTES;
constexpr int TBL_OFF = LDSCTL_OFF + 512;
constexpr int TILE_E_OFF = LDSCTL_OFF + 1024;
constexpr int MAXU = 18;
constexpr int UROW_OFF = LDSCTL_OFF + 2048;
constexpr int UBIAS_OFF = UROW_OFF + MAXU * 512;
constexpr int LDS_BYTES = 163840;
static_assert(UBIAS_OFF + MAXU * 1024 <= LDS_BYTES, "LDS map");

#define GAS __attribute__((address_space(1)))
#define LAS __attribute__((address_space(3)))
typedef unsigned short bf16;
typedef unsigned v4u __attribute__((ext_vector_type(4)));
typedef unsigned v2u __attribute__((ext_vector_type(2)));
typedef float f32x4 __attribute__((ext_vector_type(4)));
typedef float f32x16 __attribute__((ext_vector_type(16)));
#define LDS_WAIT() asm volatile("s_waitcnt lgkmcnt(0)" ::: "memory")
#define VM_WAIT() asm volatile("s_waitcnt vmcnt(0)" ::: "memory")
__device__ __forceinline__ unsigned f2bf(float f) { unsigned u = __builtin_bit_cast(unsigned, f); return (u + 0x7fffu + ((u >> 16) & 1u)) >> 16; }
__device__ __forceinline__ unsigned pk2(float lo, float hi) { return f2bf(lo) | (f2bf(hi) << 16); }
__device__ __forceinline__ float bflo(unsigned w) { return __uint_as_float(w << 16); }
__device__ __forceinline__ float bfhi(unsigned w) { return __uint_as_float(w & 0xffff0000u); }
typedef float f32x2 __attribute__((ext_vector_type(2)));
__device__ __forceinline__ f32x4 fp8x4_to_f32(unsigned w) { const f32x2 lo = __builtin_amdgcn_cvt_pk_f32_fp8((int)w, false), hi = __builtin_amdgcn_cvt_pk_f32_fp8((int)w, true); return (f32x4){lo.x, lo.y, hi.x, hi.y}; }
__device__ __forceinline__ float wave_sum(float v) {
#pragma unroll
    for (int o = 1; o < 64; o <<= 1) v += __shfl_xor(v, o);
    return v;
}


#define XB_TMO      128
#define XB_XCNT(j)  (256  + 64 * (j))
#define XB_XSUB(j)  (1280 + 64 * (j))
#define XB_XGEN(j)  (2304 + 64 * (j))
#define XB_TOP      3328
#define XB_TOPGEN   3392
#define XCD_BAR_WORDS 3456
#define XB_SPIN_CAP (1u << 22)
__device__ __forceinline__ unsigned xb_ld(unsigned* p)              { return __hip_atomic_load(p, __ATOMIC_RELAXED, __HIP_MEMORY_SCOPE_AGENT); }
__device__ __forceinline__ unsigned xb_add(unsigned* p, unsigned v) { return __hip_atomic_fetch_add(p, v, __ATOMIC_RELAXED, __HIP_MEMORY_SCOPE_AGENT); }
__device__ __forceinline__ unsigned xb_xcc_id() { return (unsigned)__builtin_amdgcn_s_getreg((3 << 11) | 20) & 0xFu; }
#define XB_SPIN(cond, bar) do { unsigned _sp = 0; while (cond) { __builtin_amdgcn_s_sleep(1); \
    if ((++_sp & 255u) == 0u) { if (xb_ld(&(bar)[XB_TMO])) break; if (_sp > XB_SPIN_CAP) { atomicAdd(&(bar)[XB_TMO], 1u); break; } } } } while (0)
struct XcdBarrier { unsigned* bar; unsigned x; volatile LAS unsigned* st; };
__device__ __forceinline__ XcdBarrier xcd_barrier_post(unsigned* bar, volatile LAS unsigned* st) {
    XcdBarrier b; b.bar = bar; b.x = xb_xcc_id(); b.st = st;
    if (threadIdx.x == 0) (void)xb_add(&bar[XB_XCNT(b.x)], 1u);
    return b;
}
__device__ __forceinline__ void xcd_barrier_complete(unsigned* bar, unsigned x, unsigned& nloc, unsigned& nx) {
    const unsigned G = gridDim.x * gridDim.y * gridDim.z;
    unsigned sum, cnt, mine, sp = 0u;
    for (;;) {
        sum = 0u; cnt = 0u; mine = 0u;
#pragma unroll
        for (unsigned j = 0; j < 16; ++j) { const unsigned c = xb_ld(&bar[XB_XCNT(j)]); sum += c; cnt += (c > 0u) ? 1u : 0u; mine = (j == x) ? c : mine; }
        if (sum == G) break;
        __builtin_amdgcn_s_sleep(1);
        if ((++sp & 255u) == 0u) { if (xb_ld(&bar[XB_TMO])) break; if (sp > XB_SPIN_CAP) { atomicAdd(&bar[XB_TMO], 1u); break; } }
    }
    nloc = mine > 0u ? mine : 1u; nx = cnt > 0u ? cnt : 1u;
}
__device__ __forceinline__ void xcd_barrier(const XcdBarrier& b) {
    asm volatile("s_waitcnt vmcnt(0)" ::: "memory");
    __syncthreads();
    if (threadIdx.x == 0) {
        unsigned* bar = b.bar;
        __builtin_amdgcn_s_waitcnt(0);
        unsigned nloc = b.st[0], nx = b.st[1];
        if (nloc == 0u) { xcd_barrier_complete(bar, b.x, nloc, nx); b.st[0] = nloc; b.st[1] = nx; }
        const unsigned old = xb_add(&bar[XB_XSUB(b.x)], 1u);
        const unsigned gen = old / nloc;
        if (old + 1u == (gen + 1u) * nloc) {
            __builtin_amdgcn_fence(__ATOMIC_RELEASE, "agent");
            asm volatile("s_waitcnt vmcnt(0)" ::: "memory");
            const unsigned og = xb_add(&bar[XB_TOP], 1u);
            const unsigned tg = og / nx;
            if (og + 1u == (tg + 1u) * nx) xb_add(&bar[XB_TOPGEN], 1u);
            else XB_SPIN(xb_ld(&bar[XB_TOPGEN]) == tg, bar);
            __builtin_amdgcn_fence(__ATOMIC_ACQUIRE, "agent");
            xb_add(&bar[XB_XGEN(b.x)], 1u);
            asm volatile("s_waitcnt vmcnt(0)" ::: "memory");
        } else {
            XB_SPIN(xb_ld(&bar[XB_XGEN(b.x)]) == gen, bar);
            __builtin_amdgcn_fence(__ATOMIC_ACQUIRE, "agent");
            asm volatile("s_waitcnt vmcnt(0)" ::: "memory");
        }
    }
    __syncthreads();
}

struct Args { const float* in[28]; float* out; unsigned char* ws; };
enum { I_X = 0, I_P, I_POS, I_ATTN_NORM, I_WIN, I_QNORM, I_KNORM, I_LQ1, I_LK1, I_LQ2, I_LK2, I_SUBLN, I_WPOOL, I_PSCALE, I_WOUT, I_FFN_NORM, I_WROUTER, I_BROUTER,
       I_WGATE, I_BGATE, I_WUP, I_BUP, I_WDOWN, I_BDOWN, I_PLE_GNORM, I_WPLE_GATE, I_WPLE_PROJ, I_PLE_PNORM };

__device__ __forceinline__ void tr_load(const float* W, int ldw, int k0, int n0, LAS float* scr, int lane) {
    float t[32];
#pragma unroll
    for (int i = 0; i < 32; ++i) t[i] = __builtin_nontemporal_load(W + (size_t)(k0 + 2 * i + (lane >> 5)) * ldw + n0 + (lane & 31));
#pragma unroll
    for (int i = 0; i < 32; ++i) scr[(2 * i + (lane >> 5)) * 33 + (lane & 31)] = t[i];
    LDS_WAIT(); asm volatile("" ::: "memory");
}
__device__ __forceinline__ void tr_item(const float* W, int ldw, int k0, int n0, bf16* WT, int ldt, int drow0, int dcol0, LAS float* scr, int lane) {
    tr_load(W, ldw, k0, n0, scr, lane);
    const int c = lane & 7;
#pragma unroll
    for (int j = 0; j < 4; ++j) { const int n = (lane >> 3) + 8 * j; const LAS float* s = scr + (8 * c) * 33 + n;
        v4u o; o.x = pk2(s[0 * 33], s[1 * 33]); o.y = pk2(s[2 * 33], s[3 * 33]); o.z = pk2(s[4 * 33], s[5 * 33]); o.w = pk2(s[6 * 33], s[7 * 33]);
        *(GAS v4u*)(WT + (size_t)(drow0 + n) * ldt + dcol0 + k0 + 8 * c) = o; }
    LDS_WAIT(); asm volatile("" ::: "memory");
}
__device__ __forceinline__ void tr_item8(const float* W, int ldw, int k0, int n0, unsigned char* WT, int ldt, int drow0, float sc, LAS float* scr, int lane) {
    tr_load(W, ldw, k0, n0, scr, lane);
    const int c = lane & 7;
#pragma unroll
    for (int j = 0; j < 4; ++j) { const int n = (lane >> 3) + 8 * j; const LAS float* s = scr + (8 * c) * 33 + n;
        v2u o; o.x = pg8::pk4_fp8(s[0 * 33] * sc, s[1 * 33] * sc, s[2 * 33] * sc, s[3 * 33] * sc); o.y = pg8::pk4_fp8(s[4 * 33] * sc, s[5 * 33] * sc, s[6 * 33] * sc, s[7 * 33] * sc);
        *(GAS v2u*)(WT + (size_t)(drow0 + n) * ldt + k0 + 8 * c) = o; }
    LDS_WAIT(); asm volatile("" ::: "memory");
}

struct MoeOrder {
    const LAS int* tbl;
    const LAS unsigned char* te;
    int tile0, ntile, npn, G, vc; bool gu;
    __device__ __forceinline__ bool next(int i, pg8::Unit& u) const {
        const int U = i * G + vc; if (U >= ntile * npn) return false;
        const int tl = U / npn, pn = U - tl * npn, tau = tile0 + tl;
        const int e = (int)te[tau];
        const int tloc = tau - tbl[32 + e];
        u.e = e; u.pn = pn; u.tb = e * npn + pn; u.ord = i;
        if (gu) { u.ta = tau; u.pm = tau; u.nv = 256; }
        else { u.ta = tau; u.pm = tbl[65 + e] + tloc * 256; const int rem = tbl[e] - tloc * 256; u.nv = rem < 256 ? rem : 256; }
        return true;
    }
};

__global__ void __launch_bounds__(NWAVES * 64, 2) mk_fwd(Args args) {
    extern __shared__ __attribute__((aligned(16))) unsigned char lds[];
    cg::grid_group grid = cg::this_grid();
    LAS unsigned char* L = (LAS unsigned char*)lds;
    const int wave = __builtin_amdgcn_readfirstlane(threadIdx.x >> 6);
    const int G = gridDim.x;
    const int vcu = (G % 8 == 0) ? ((int)blockIdx.x % 8) * (G / 8) + (int)blockIdx.x / 8 : (int)blockIdx.x;
    const int gw = vcu * NWAVES + wave, NGW = G * NWAVES;
    unsigned char* ws = args.ws;
    unsigned* ctl = (unsigned*)(ws + WS_CTL);
    float* out = args.out;
    LAS int* tbl = (LAS int*)(L + TBL_OFF);
    LAS unsigned char* tile_e = (LAS unsigned char*)(L + TILE_E_OFF);
    volatile LAS unsigned* MISC = (volatile LAS unsigned*)(L + LDSCTL_OFF);
    if (threadIdx.x < 64) MISC[threadIdx.x] = 0u;
    __syncthreads();
    XcdBarrier xbar = xcd_barrier_post(ctl + CW_BAR, MISC + 8);
#define GRID_BAR() do { xcd_barrier(xbar); } while (0)

    {
        const int tid = pg8::tid_opaque(), lane = tid & 63;
        LAS float* scr = (LAS float*)(L + RING_OFF + wave * 16384);
        constexpr int IT_WIN = 16 * 64, IT_WOUT = 8 * 32, IT_EXP = 512, IT_WG = 512, IT_WP = 4 * 32;
        constexpr int NITEMS = IT_WIN + IT_WOUT + NEXP * 3 * IT_EXP + IT_WG + IT_WP;
        for (int it = gw; it < NITEMS; it += NGW) {
            int r = it;
            if (r < IT_WIN) { const int kb = r / 64, nb = r % 64; tr_item(args.in[I_WIN], DINP, 64 * kb, 32 * nb, (bf16*)(ws + WS_WIN), 1024, 32 * nb, 0, scr, lane); continue; } r -= IT_WIN;
            if (r < IT_WOUT) { const int kb = r / 32, nb = r % 32; tr_item(args.in[I_WOUT], 1024, 64 * kb, 32 * nb, (bf16*)(ws + WS_WOUT), 1024, 32 * nb, 0, scr, lane); continue; } r -= IT_WOUT;
            if (r < NEXP * 3 * IT_EXP) {
                const int e = r / (3 * IT_EXP), rr = r % (3 * IT_EXP), mat = rr / IT_EXP, q = rr % IT_EXP, kb = q / 32, nb = q % 32, n0 = 32 * nb;
                if (mat == 2) tr_item8(args.in[I_WDOWN] + (size_t)e * 1024 * 1024, 1024, 64 * kb, n0, ws + WS_WD, 1024, e * 1024 + n0, 32.0f, scr, lane);
                else tr_item8(args.in[mat == 0 ? I_WGATE : I_WUP] + (size_t)e * 1024 * 1024, 1024, 64 * kb, n0, ws + WS_WGU, 1024, e * 2048 + (n0 >> 7) * 256 + mat * 128 + (n0 & 127), 32.0f, scr, lane);
                continue; } r -= NEXP * 3 * IT_EXP;
            if (r < IT_WG) { const int kb = r / 32, nb = r % 32; tr_item8(args.in[I_WPLE_GATE], 1024, 64 * kb, 32 * nb, ws + WS_WG, 1024, 32 * nb, 32.0f, scr, lane); continue; } r -= IT_WG;
            { const int kb = r / 32, nb = r % 32; tr_item(args.in[I_WPLE_PROJ], 1024, 64 * kb, 32 * nb, (bf16*)(ws + WS_WP), 256, 32 * nb, 0, scr, lane); }
        }
        {
            const float* wpool = args.in[I_WPOOL]; const float* ps = args.in[I_PSCALE]; const float* wout = args.in[I_WOUT]; bf16* WT = (bf16*)(ws + WS_WOUT);
            for (int tile = wave * G + vcu; tile < 16 * 32; tile += NWAVES * G) {
                const int gc0 = (tile >> 5) * 32, n0 = (tile & 31) * 32, g = gc0 >> 7, hf = lane >> 5, li = lane & 31;
                const float* ap = wpool + (size_t)(gc0 + li) * 128 + 64 * hf; const float* pp = ps + g * 128 + 64 * hf;
                const float* bp = wout + (size_t)(512 + g * 128 + 64 * hf) * 1024 + n0 + li;
                f32x16 acc = f32x16{};
#pragma unroll 8
                for (int q = 0; q < 16; ++q) {
                    const f32x4 a4 = *(const GAS f32x4*)(ap + 4 * q), p4 = *(const GAS f32x4*)(pp + 4 * q);
                    const float b0 = bp[(size_t)(4 * q + 0) * 1024], b1 = bp[(size_t)(4 * q + 1) * 1024], b2 = bp[(size_t)(4 * q + 2) * 1024], b3 = bp[(size_t)(4 * q + 3) * 1024];
                    acc = __builtin_amdgcn_mfma_f32_32x32x2f32(a4.x * p4.x, b0, acc, 0, 0, 0);
                    acc = __builtin_amdgcn_mfma_f32_32x32x2f32(a4.y * p4.y, b1, acc, 0, 0, 0);
                    acc = __builtin_amdgcn_mfma_f32_32x32x2f32(a4.z * p4.z, b2, acc, 0, 0, 0);
                    acc = __builtin_amdgcn_mfma_f32_32x32x2f32(a4.w * p4.w, b3, acc, 0, 0, 0);
                }
#pragma unroll
                for (int r4 = 0; r4 < 4; ++r4) { v2u w; w.x = pk2(acc[4 * r4], acc[4 * r4 + 1]); w.y = pk2(acc[4 * r4 + 2], acc[4 * r4 + 3]);
                    *(GAS v2u*)(WT + (size_t)(n0 + li) * 1024 + 512 + gc0 + 8 * r4 + 4 * hf) = w; }
            }
        }
        if (gw == 0) { float* SG = (float*)(ws + WS_SG); SG[lane] = args.in[I_SUBLN][lane] * 0.8f; SG[64 + lane] = args.in[I_SUBLN][64 + lane] * 0.8f;
            const float s1 = wave_sum(args.in[I_LQ1][lane] * args.in[I_LK1][lane]), s2 = wave_sum(args.in[I_LQ2][lane] * args.in[I_LK2][lane]); if (lane == 0) SG[128] = expf(s1) - expf(s2) + 0.2f; }
        { const float* wr = args.in[I_WROUTER]; const float* fn = args.in[I_FFN_NORM]; bf16* WRh = (bf16*)(ws + WS_WRS); bf16* WRl = WRh + 32 * 1024;
          for (int idx = blockIdx.x * 512 + tid; idx < 1024 * 32; idx += G * 512) {
              const int j = idx & 7, e = (idx >> 3) & 31, hf_ = (idx >> 8) & 1, q = (idx >> 9) & 31, kh_ = idx >> 14, k = 512 * kh_ + 16 * q + 8 * hf_ + j; const float v = wr[k * 32 + e] * fn[k];
              const unsigned h = f2bf(v); WRh[idx] = (bf16)h; WRl[idx] = (bf16)f2bf(v - __uint_as_float(h << 16)); } }
        { const int* pos = (const int*)args.in[I_POS]; float* cs = (float*)(ws + WS_CS);
          for (int idx = blockIdx.x * 512 + tid; idx < NTOK * 8; idx += G * 512) {
              const int t = idx >> 3, i = idx & 7;
              const float fr = i == 0 ? 1.0f : i == 1 ? 0.1939227432012558f : i == 2 ? 0.03760603070259094f : i == 3 ? 0.007292664609849453f : i == 4 ? 0.0014142135623842478f :
                               i == 5 ? 0.00027424818836152554f : i == 6 ? 5.318296098266728e-05f : 1.0313386155758053e-05f;
              const float ang = (float)pos[t] * fr;
              const double a = (double)ang, k = __builtin_rint(a * 0.15915494309189535), rr = a - k * 6.283185307179586;
              const float rf = (float)rr;
              cs[t * 16 + i] = cosf(rf); cs[t * 16 + 8 + i] = sinf(rf);
          } }
        { const float* x = args.in[I_X]; const float* gn = args.in[I_ATTN_NORM]; bf16* XN = (bf16*)(ws + WS_XN);
          f32x4 gg[4];
#pragma unroll
          for (int j = 0; j < 4; ++j) gg[j] = *((const GAS f32x4*)gn + lane + 64 * j);
          for (int m0 = gw; m0 < NTOK; m0 += 2 * NGW) {
              f32x4 v[2][4]; float s[2] = {0.f, 0.f};
#pragma unroll
              for (int u = 0; u < 2; ++u) { const int m = (m0 + u * NGW < NTOK) ? m0 + u * NGW : m0; const GAS f32x4* xr = (const GAS f32x4*)(x + (size_t)m * 1024) + lane;
#pragma unroll
                  for (int j = 0; j < 4; ++j) v[u][j] = xr[64 * j]; }
#pragma unroll
              for (int u = 0; u < 2; ++u) {
#pragma unroll
                  for (int j = 0; j < 4; ++j) s[u] += (v[u][j].x * v[u][j].x + v[u][j].y * v[u][j].y) + (v[u][j].z * v[u][j].z + v[u][j].w * v[u][j].w); }
#pragma unroll
              for (int u = 0; u < 2; ++u) { const int m = m0 + u * NGW; if (m < NTOK) {
                  const float r = 1.0f / sqrtf(wave_sum(s[u]) * (1.f / 1024.f) + EPS);
                  GAS unsigned long long* o8 = (GAS unsigned long long*)(XN + (size_t)m * 1024) + lane;
#pragma unroll
                  for (int j = 0; j < 4; ++j) o8[64 * j] = (unsigned long long)pk2(v[u][j].x * r * gg[j].x, v[u][j].y * r * gg[j].y) | ((unsigned long long)pk2(v[u][j].z * r * gg[j].z, v[u][j].w * r * gg[j].w) << 32); } }
          } }
        { const int tid = pg8::tid_opaque();
        const float* p = args.in[I_P]; bf16* PB = (bf16*)(ws + WS_PB);
        for (size_t idx = (size_t)blockIdx.x * 512 + tid; idx < (size_t)NTOK * PLE / 4; idx += (size_t)G * 512) {
            const f32x4 a = *((const GAS f32x4*)p + idx); v2u w; w.x = pk2(a.x, a.y); w.y = pk2(a.z, a.w); *((GAS v2u*)PB + idx) = w; }
        }
    }
    grid.sync();


    {
        pg8::Gemm g{(const pg8::bf16_t*)(ws + WS_XN), (const pg8::bf16_t*)(ws + WS_WIN), 1024, nullptr}; pg8::StaticOrder S; S.init(NTOK, DINP, G, (int)blockIdx.x);
        pg8::EpiQKVU E{(pg8::bf16_t*)(ws + WS_QK), (pg8::bf16_t*)(ws + WS_VU), (const float*)(ws + WS_CS), args.in[I_QNORM], args.in[I_KNORM], attn_body::C2};
        pg8::gemm_phase<pg8::EpiQKVU, pg8::StaticOrder, false, true, false, true>(L + RING_OFF, g, S, E);
    }
    {
        pg8::Gemm g{(const pg8::bf16_t*)(ws + WS_PB), (const pg8::bf16_t*)(ws + WS_WP), 256, nullptr}; pg8::StaticOrder S; S.init(NTOK, 1024, G, (int)blockIdx.x);
        pg8::EpiBf16 E{(pg8::bf16_t*)(ws + WS_ER), 1024, nullptr, 0, 0, (float*)(ws + WS_SS)};
        pg8::gemm_phase<pg8::EpiBf16, pg8::StaticOrder, false, true>(L + RING_OFF, g, S, E);
    }
    GRID_BAR();

    {
        const int tid = pg8::tid_opaque(), lane = tid & 63;
        const bf16* VU = (const bf16*)(ws + WS_VU); bf16* ACAT = (bf16*)(ws + WS_ACAT);
        const int grp = lane >> 4, w = 2 << grp;
        for (int chunk = gw; chunk < NTOK / 16; chunk += NGW) {
            const int m0 = chunk * 16, t0 = m0 & (SEQ - 1);
            v4u rows[31];
#pragma unroll
            for (int k = 0; k < 15; ++k) { rows[k] = (v4u){0u, 0u, 0u, 0u}; if (15 - k < w && t0 > 0) rows[k] = *(const GAS v4u*)(VU + (size_t)(m0 + k - 15) * 1024 + 512 + lane * 8); }
#pragma unroll
            for (int k = 15; k < 31; ++k) rows[k] = *(const GAS v4u*)(VU + (size_t)(m0 + k - 15) * 1024 + 512 + lane * 8);
#pragma unroll
            for (int j = 0; j < 16; ++j) {
                float a2[8], a4[8], a8[8], a16[8], u0[8];
#pragma unroll
                for (int i = 0; i < 8; ++i) { a2[i] = 0.f; }
#pragma unroll
                for (int d = 0; d < 16; ++d) { const v4u r = rows[15 + j - d];
                    const float f[8] = {bflo(r.x), bfhi(r.x), bflo(r.y), bfhi(r.y), bflo(r.z), bfhi(r.z), bflo(r.w), bfhi(r.w)};
#pragma unroll
                    for (int i = 0; i < 8; ++i) { if (d == 0) u0[i] = f[i]; a2[i] += f[i]; if (d == 1) a4[i] = a2[i]; if (d == 3) a8[i] = a2[i]; if (d == 7) a16[i] = a2[i]; } }
                const int t = t0 + j, cnt = (t + 1 < w) ? t + 1 : w; const float ic = 1.0f / (float)cnt;
                float pz[8];
#pragma unroll
                for (int i = 0; i < 8; ++i) { const float sel = grp == 0 ? a4[i] : grp == 1 ? a8[i] : grp == 2 ? a16[i] : a2[i]; pz[i] = sel * ic - u0[i]; }
                v4u op; op.x = pk2(pz[0], pz[1]); op.y = pk2(pz[2], pz[3]); op.z = pk2(pz[4], pz[5]); op.w = pk2(pz[6], pz[7]);
                *(GAS v4u*)(ACAT + (size_t)(m0 + j) * 1024 + 512 + lane * 8) = op;
            }
        }
    }
    GRID_BAR();

    {
        const attn_body::bf16* Q = (const attn_body::bf16*)(ws + WS_QK); const attn_body::bf16* V = (const attn_body::bf16*)(ws + WS_VU); attn_body::bf16* O = (attn_body::bf16*)(ws + WS_O16);
        constexpr int NUNITS = NB * 8 * attn_body::NQB;
        const int per = (NUNITS + G - 1) / G;
        for (int u = 0; u < per; ++u) {
            int bh, qb;
            if (G == 256) { bh = vcu >> 3; const int s = vcu & 7; qb = (u < 2) ? s : 15 - s; }
            else { const int P = (u >> 1) * G + vcu; if (P >= NUNITS / 2) break; bh = P & 31; qb = 15 - (P >> 5); }
            const int hc = 2 * (bh & 3) + (u & 1);
            attn2::attn_unit<8, (long)WS_ACAT - (long)WS_O16, (long)WS_SG - (long)WS_O16>(bh >> 2, hc * 64, 512 + hc * 64, (hc >> 1) * 128, hc * 128, qb, Q, Q, V, O, (char*)lds + RING_OFF);
        }
    }
    GRID_BAR();

    {
        pg8::Gemm g{(const pg8::bf16_t*)(ws + WS_ACAT), (const pg8::bf16_t*)(ws + WS_WOUT), 1024, nullptr}; pg8::StaticOrder S; S.init(NTOK, 1024, G, (int)blockIdx.x);
        pg8::EpiResBf16 E{args.in[I_X], (pg8::bf16_t*)out};
        pg8::gemm_phase<pg8::EpiResBf16, pg8::StaticOrder, false, true>(L + RING_OFF, g, S, E);
    }
    GRID_BAR();

    {
        const int tid = pg8::tid_opaque(), lane = tid & 63;
        LAS float* r1s = (LAS float*)(L + RING_OFF);
        LAS int* cntl = (LAS int*)(L + RING_OFF + 512);
        LAS int* basel = (LAS int*)(L + RING_OFF + 640);
        LAS float* Pl = (LAS float*)(L + RING_OFF + 1024);
        const float* fn = args.in[I_FFN_NORM]; const bf16* WRh = (const bf16*)(ws + WS_WRS); const bf16* WRl = WRh + 32 * 1024; unsigned char* XN8 = ws + WS_XN; const bf16* H1B = (const bf16*)out;
        int* toke = (int*)(ws + WS_TOKE); float* tokg = (float*)(ws + WS_TOKG); int* tokp = (int*)(ws + WS_TOKP); unsigned short* elist = (unsigned short*)(ws + WS_ELIST);
        if (tid < 32) cntl[tid] = 0;
        __syncthreads();
        for (int chunk = blockIdx.x; chunk < NTOK / 128; chunk += G) {
            const int tok0 = chunk * 128;
            for (int j0 = 0; j0 < 16; j0 += 4) {
                f32x4 v[4][4];
#pragma unroll
                for (int u = 0; u < 4; ++u) { const GAS v2u* xr = (const GAS v2u*)(H1B + (size_t)(tok0 + wave * 16 + j0 + u) * 1024) + lane;
#pragma unroll
                    for (int q = 0; q < 4; ++q) { const v2u w_ = xr[64 * q]; v[u][q] = (f32x4){bflo(w_.x), bfhi(w_.x), bflo(w_.y), bfhi(w_.y)}; } }
#pragma unroll
                for (int u = 0; u < 4; ++u) { const int m = tok0 + wave * 16 + j0 + u; float s = 0.f;
#pragma unroll
                    for (int q = 0; q < 4; ++q) s += (v[u][q].x * v[u][q].x + v[u][q].y * v[u][q].y) + (v[u][q].z * v[u][q].z + v[u][q].w * v[u][q].w);
                    const float r = 1.0f / sqrtf(wave_sum(s) * (1.f / 1024.f) + EPS);
                    GAS unsigned* o4 = (GAS unsigned*)(XN8 + (size_t)m * 1024) + lane;
#pragma unroll
                    for (int q = 0; q < 4; ++q) { const f32x4 gg = *((const GAS f32x4*)fn + lane + 64 * q);
                        o4[64 * q] = pg8::pk4_fp8(v[u][q].x * r * gg.x, v[u][q].y * r * gg.y, v[u][q].z * r * gg.z, v[u][q].w * r * gg.w); }
                    if (lane == 0) r1s[wave * 16 + j0 + u] = r; }
            }
            {
                const int g = wave & 3, kh = wave >> 2, hf = lane >> 5, li = lane & 31;
                LAS unsigned char* tile = L + RING_OFF + 36864 + wave * 8704;
                const bf16* ablk = H1B + (size_t)(tok0 + 32 * g + (lane >> 4)) * 1024 + kh * 512 + 8 * (lane & 15);
                const bf16* bh = WRh + (size_t)(kh * 32) * 512 + lane * 8; const bf16* bl = WRl + (size_t)(kh * 32) * 512 + lane * 8;
                f32x16 acc = f32x16{};
                v4u R[8];
#pragma unroll
                for (int i = 0; i < 8; ++i) R[i] = *(const GAS v4u*)(ablk + (size_t)(4 * i) * 1024);
                for (int b = 0; b < 4; ++b) {
#pragma unroll
                    for (int i = 0; i < 8; ++i) *(LAS v4u*)(tile + (4 * i + (lane >> 4)) * 272 + 16 * (lane & 15)) = R[i];
                    pg8::bf16x8 wh[8], wl[8];
#pragma unroll
                    for (int s_ = 0; s_ < 8; ++s_) { wh[s_] = *(const GAS pg8::bf16x8*)(bh + (size_t)(8 * b + s_) * 512); wl[s_] = *(const GAS pg8::bf16x8*)(bl + (size_t)(8 * b + s_) * 512); }
                    if (b < 3) {
#pragma unroll
                        for (int i = 0; i < 8; ++i) R[i] = *(const GAS v4u*)(ablk + (size_t)(4 * i) * 1024 + 128 * (b + 1)); }
#pragma unroll
                    for (int s_ = 0; s_ < 8; ++s_) {
                        const pg8::bf16x8 ah = *(const LAS pg8::bf16x8*)(tile + li * 272 + 32 * s_ + 16 * hf);
                        acc = __builtin_amdgcn_mfma_f32_32x32x16_bf16(ah, wl[s_], acc, 0, 0, 0);
                        acc = __builtin_amdgcn_mfma_f32_32x32x16_bf16(ah, wh[s_], acc, 0, 0, 0);
                    }
                }
                LAS float* Pw = Pl + (size_t)((kh * 4 + g) * 32) * 33;
#pragma unroll
                for (int r = 0; r < 16; ++r) Pw[((r & 3) + 8 * (r >> 2) + 4 * hf) * 33 + li] = acc[r];
            }
            __syncthreads();
            int ek[4] = {0, 0, 0, 0}, rk[4] = {0, 0, 0, 0};
            if (tid < 128) {
                const int g = tid >> 5, i = tid & 31; const float r1 = r1s[tid];
                const LAS float* p0 = Pl + (size_t)((0 * 4 + g) * 32 + i) * 33; const LAS float* p1 = Pl + (size_t)((1 * 4 + g) * 32 + i) * 33;
                float v[32];
#pragma unroll
                for (int e = 0; e < 32; ++e) v[e] = (p0[e] + p1[e]) * r1 + args.in[I_BROUTER][e];
                float tv[4];
#pragma unroll
                for (int k = 0; k < 4; ++k) {
                    float best = v[0]; int bi = 0;
#pragma unroll
                    for (int e = 1; e < 32; ++e) { if (v[e] > best) { best = v[e]; bi = e; } }
                    tv[k] = best; ek[k] = bi;
#pragma unroll
                    for (int e = 0; e < 32; ++e) v[e] = (e == bi) ? -INFINITY : v[e];
                }
                const float e1 = expf(tv[1] - tv[0]), e2 = expf(tv[2] - tv[0]), e3 = expf(tv[3] - tv[0]); const float inv = 1.0f / (1.0f + e1 + e2 + e3);
                const float gt[4] = {inv, e1 * inv, e2 * inv, e3 * inv};
#pragma unroll
                for (int k = 0; k < 4; ++k) { rk[k] = atomicAdd((int*)(cntl + ek[k]), 1); toke[(size_t)(tok0 + tid) * 4 + k] = ek[k]; tokg[(size_t)(tok0 + tid) * 4 + k] = gt[k]; }
            }
            __syncthreads();
            if (tid < 32) { basel[tid] = atomicAdd((int*)ctl + CW_CNT + tid, cntl[tid]); cntl[tid] = 0; }
            __syncthreads();
            if (tid < 128) {
#pragma unroll
                for (int k = 0; k < 4; ++k) { const int rank = basel[ek[k]] + rk[k]; tokp[(size_t)(tok0 + tid) * 4 + k] = rank; elist[(size_t)ek[k] * NTOK + rank] = (unsigned short)(tok0 + tid); }
            }
            __syncthreads();
        }
    }
    GRID_BAR();

    {
        const int tid = pg8::tid_opaque();
        if (tid == 0) {
            int pt = 0, cr = 0;
            for (int e = 0; e < NEXP; ++e) { const int c = (int)__hip_atomic_load(ctl + CW_CNT + e, __ATOMIC_RELAXED, __HIP_MEMORY_SCOPE_AGENT); tbl[e] = c; tbl[32 + e] = pt; tbl[65 + e] = cr; pt += (c + 255) >> 8; cr += c; }
            tbl[64] = pt; tbl[97] = cr;
        }
        __syncthreads();
        for (int t = tid; t < 576; t += 512) { int e = 0;
            for (int j = 1; j < NEXP; ++j) e += (tbl[32 + j] <= t) ? 1 : 0;
            tile_e[t] = (unsigned char)e; }
        __syncthreads();
    }


    {
        const int T = tbl[64];
        LAS unsigned short* urow = (LAS unsigned short*)(L + UROW_OFF); LAS float* ubias = (LAS float*)(L + UBIAS_OFF);
        {
            MoeOrder S{tbl, tile_e, 0, T, 8, G, vcu, true};
            {
                const int tid = pg8::tid_opaque(); pg8::Unit u; const unsigned short* elist = (const unsigned short*)(ws + WS_ELIST);
                for (int i = 0; i < MAXU && S.next(i, u); ++i) {
                    if (tid < 256) { const int r = (u.ta - tbl[32 + u.e]) * 256 + tid; urow[i * 256 + tid] = (r < tbl[u.e]) ? elist[(size_t)u.e * NTOK + r] : (unsigned short)0; }
                    else { const int j = tid - 256; ubias[i * 256 + j] = (j < 128 ? args.in[I_BGATE] : args.in[I_BUP])[u.e * 1024 + u.pn * 128 + (j & 127)]; } }
                __syncthreads();
            }
            pg8::Gemm g{(const pg8::bf16_t*)(ws + WS_XN), (const pg8::bf16_t*)(ws + WS_WGU), 512, urow};
            pg8::EpiSwiglu E{ws + WS_HDN, ubias};
            pg8::gemm_phase<pg8::EpiSwiglu, MoeOrder, true, true, true>(L + RING_OFF, g, S, E);
        }
        GRID_BAR();
        {
            MoeOrder S{tbl, tile_e, 0, T, 4, G, vcu, false};
            {   const int tid = pg8::tid_opaque(); pg8::Unit u;
                for (int i = 0; i < MAXU && S.next(i, u); ++i) { if (tid < 256) ubias[i * 256 + tid] = args.in[I_BDOWN][u.e * 1024 + u.pn * 256 + tid]; }
                __syncthreads();
            }
            pg8::Gemm g{(const pg8::bf16_t*)(ws + WS_HDN), (const pg8::bf16_t*)(ws + WS_WD), 512, nullptr};
            pg8::EpiDown E{ws + WS_Y, ubias};
            pg8::gemm_phase<pg8::EpiDown, MoeOrder, false, true, true>(L + RING_OFF, g, S, E);
        }
        GRID_BAR();
    }

    {
        const int tid = pg8::tid_opaque(), lane = tid & 63;
        const int* toke = (const int*)(ws + WS_TOKE); const float* tokg = (const float*)(ws + WS_TOKG); const int* tokp = (const int*)(ws + WS_TOKP);
        const unsigned char* Y = ws + WS_Y; unsigned char* XN = ws + WS_XN3; const bf16* H1B = (const bf16*)out; bf16* H2B = (bf16*)(ws + WS_H2B); const float* gn = args.in[I_PLE_GNORM];
        f32x4 gg[4];
#pragma unroll
        for (int j = 0; j < 4; ++j) gg[j] = *((const GAS f32x4*)gn + lane + 64 * j);
        for (int m0 = gw; m0 < NTOK; m0 += 2 * NGW) {
            int rowk[2][4]; float gk[2][4]; f32x4 v[2][4];
#pragma unroll
            for (int u = 0; u < 2; ++u) { const int m = (m0 + u * NGW < NTOK) ? m0 + u * NGW : m0;
#pragma unroll
                for (int k = 0; k < 4; ++k) { const int e = toke[(size_t)m * 4 + k]; gk[u][k] = tokg[(size_t)m * 4 + k]; rowk[u][k] = tbl[65 + e] + tokp[(size_t)m * 4 + k]; }
                const GAS v2u* xr = (const GAS v2u*)(H1B + (size_t)m * 1024) + lane;
#pragma unroll
                for (int j = 0; j < 4; ++j) { const v2u w_ = xr[64 * j]; v[u][j] = (f32x4){bflo(w_.x), bfhi(w_.x), bflo(w_.y), bfhi(w_.y)}; } }
#pragma unroll
            for (int u = 0; u < 2; ++u)
#pragma unroll
                for (int k = 0; k < 4; ++k) { const GAS unsigned* yr = (const GAS unsigned*)(Y + (size_t)rowk[u][k] * 1024) + lane; const float g_ = gk[u][k];
#pragma unroll
                    for (int j = 0; j < 4; ++j) { const f32x4 y4 = fp8x4_to_f32(yr[64 * j]); v[u][j] += y4 * g_; } }
#pragma unroll
            for (int u = 0; u < 2; ++u) { const int m = m0 + u * NGW; if (m < NTOK) {
                GAS v2u* xw = (GAS v2u*)(H2B + (size_t)m * 1024) + lane; float s = 0.f;
#pragma unroll
                for (int j = 0; j < 4; ++j) { v2u w_; w_.x = pk2(v[u][j].x, v[u][j].y); w_.y = pk2(v[u][j].z, v[u][j].w); xw[64 * j] = w_; s += (v[u][j].x * v[u][j].x + v[u][j].y * v[u][j].y) + (v[u][j].z * v[u][j].z + v[u][j].w * v[u][j].w); }
                const float r = 1.0f / sqrtf(wave_sum(s) * (1.f / 1024.f) + EPS);
                GAS unsigned* o4 = (GAS unsigned*)(XN + (size_t)m * 1024) + lane;
#pragma unroll
                for (int j = 0; j < 4; ++j) o4[64 * j] = pg8::pk4_fp8(v[u][j].x * r * gg[j].x, v[u][j].y * r * gg[j].y, v[u][j].z * r * gg[j].z, v[u][j].w * r * gg[j].w); } }
        }
    }
    GRID_BAR();

    {
        pg8::Gemm g{(const pg8::bf16_t*)(ws + WS_XN3), (const pg8::bf16_t*)(ws + WS_WG), 512, nullptr}; pg8::StaticOrder S; S.init(NTOK, 1024, G, (int)blockIdx.x);
        pg8::EpiFinal E{out, (const pg8::bf16_t*)(ws + WS_H2B), (const pg8::bf16_t*)(ws + WS_ER), (const float*)(ws + WS_SS), args.in[I_PLE_PNORM]};
        pg8::gemm_phase<pg8::EpiFinal, pg8::StaticOrder, false, true, true>(L + RING_OFF, g, S, E);
    }
}

extern "C" void kernel_launch(void* const* d_in, const int* in_sizes, int n_in, void* d_out, int out_size, void* d_ws, size_t ws_size, hipStream_t stream) {
    static int grid = 0;
    if (grid == 0) {
        if (n_in != 28 || in_sizes[0] != NTOK * DMODEL || out_size != NTOK * DMODEL || ws_size < WS_TOP) { fprintf(stderr, "kernel_launch: unexpected shapes (n_in %d, ws %zu)\n", n_in, ws_size); grid = -1; return; }
        int dev = 0, cus = 0, per_cu = 0;
        (void)hipGetDevice(&dev); (void)hipDeviceGetAttribute(&cus, hipDeviceAttributeMultiprocessorCount, dev);
        (void)hipFuncSetAttribute((const void*)mk_fwd, hipFuncAttributeMaxDynamicSharedMemorySize, LDS_BYTES);
        if (hipOccupancyMaxActiveBlocksPerMultiprocessor(&per_cu, (const void*)mk_fwd, NWAVES * 64, LDS_BYTES) != hipSuccess || per_cu < 1) per_cu = 1;
        (void)hipGetLastError();
        grid = cus * (per_cu > 1 ? 1 : per_cu);
    }
    if (grid < 0) return;
    (void)hipMemsetAsync((char*)d_ws + WS_CTL, 0, CTL_ZERO_BYTES, stream);
    Args a{};
    for (int i = 0; i < 28; ++i) a.in[i] = (const float*)d_in[i];
    a.out = (float*)d_out; a.ws = (unsigned char*)d_ws;
    void* kargs[] = {&a};
    hipError_t e = hipLaunchCooperativeKernel((const void*)mk_fwd, dim3(grid), dim3(NWAVES * 64), kargs, LDS_BYTES, stream);
    if (e != hipSuccess) fprintf(stderr, "cooperative launch failed: %s (grid %d)\n", hipGetErrorString(e), grid);
}
```

```cpp
#include <hip/hip_runtime.h>
#include <hip/hip_cooperative_groups.h>
#include <hip/hip_bf16.h>
#include <cstdio>
#include <cstdint>
#include <cmath>
namespace cg = cooperative_groups;


namespace pg8 {
#define PG8_LAS __attribute__((address_space(3)))
typedef unsigned short bf16_t;
typedef short bf16x8 __attribute__((ext_vector_type(8)));
typedef float f32x4 __attribute__((ext_vector_type(4)));
typedef float f32x2 __attribute__((ext_vector_type(2)));
typedef unsigned u32x4 __attribute__((ext_vector_type(4)));
typedef unsigned u32x2 __attribute__((ext_vector_type(2)));
constexpr int BM = 256, BK = 64, HALF = 128, HTB = HALF * BK * 2, STAGE_BYTES = 8 * HTB, NXCD = 8, WGM = 8;

__host__ __device__ __forceinline__ int lds_byte(int r, int c) { const int st = (r >> 4) * 2 + (c >> 5), rr = r & 15, cc = c & 31, ob = rr * 64 + cc * 2; return st * 1024 + (ob ^ (((ob >> 9) & 1) << 5)); }
__host__ __device__ __forceinline__ void stage_rc(int b, int& R, int& C) { const int st = b / 1024, sb = b % 1024, swz = sb ^ (((sb >> 9) & 1) << 5); R = (st >> 1) * 16 + swz / 64; C = (st & 1) * 32 + (swz % 64) / 2; }
__host__ __device__ __forceinline__ int perm32(int rho) { const int n = rho >> 4, i = rho & 15; return 8 * (i >> 2) + 4 * n + (i & 3); }

struct Unit { int ta, tb, pm, pn, e, nv, ord; };
struct Gemm { const bf16_t* A; const bf16_t* Bt; int K; const PG8_LAS unsigned short* urow; };

struct StaticOrder {
    int nM, nN, nwg, G, c;
    __host__ __device__ void init(int M, int N, int G_, int c_) { nM = M / BM; nN = N / BM; nwg = nM * nN; G = G_; c = c_; }
    __host__ __device__ bool next(int i, Unit& u) const {
        const long L = (long)i * G + c; if (L >= nwg) return false;
        int wgid = (int)L; { const int q = nwg / NXCD, r = nwg % NXCD, xcd = wgid % NXCD, off = wgid / NXCD; wgid = (xcd < r ? xcd * (q + 1) : r * (q + 1) + (xcd - r) * q) + off; }
        const int nig = WGM * nN, gid = wgid / nig, fm = gid * WGM, gsz = (nM - fm) < WGM ? (nM - fm) : WGM;
        u.pm = fm + ((wgid % nig) % gsz); u.pn = (wgid % nig) / gsz; u.ta = u.pm; u.tb = u.pn; u.e = 0; u.nv = 256; u.ord = i; return true;
    }
};

__device__ __forceinline__ unsigned cvt_pk_bf16(float lo, float hi) { unsigned r; asm volatile("v_cvt_pk_bf16_f32 %0, %1, %2" : "=v"(r) : "v"(lo), "v"(hi)); return r; }

struct EpiBf16 {
    static constexpr bool PERM = true;
    bf16_t* O; int ldc; const float* bias; int split_cols; size_t split_stride; float* ss;
    __device__ __forceinline__ void operator()(const f32x4 (&acc)[2][2][4][2], const Unit& u, int wr, int wc, int fr, int fq) const {
        const int row0 = u.pm * BM + wr * 64 + fr; int colt = u.pn * BM; bf16_t* base = O;
        if (split_cols) { const int t = colt / split_cols; base += (size_t)t * split_stride; colt -= t * split_cols; }
        const int col0 = colt + wc * 32 + 8 * fq, bcol0 = u.pn * BM + wc * 32 + 8 * fq;
        f32x4 bv[2][2];
#pragma unroll
        for (int bj = 0; bj < 2; ++bj)
#pragma unroll
            for (int n = 0; n < 2; ++n) bv[bj][n] = bias ? *(const f32x4*)(bias + bcol0 + bj * HALF + 4 * n) : (f32x4){0.f, 0.f, 0.f, 0.f};
#pragma unroll
        for (int ai = 0; ai < 2; ++ai)
#pragma unroll
            for (int m = 0; m < 4; ++m) { bf16_t* rowp = base + (size_t)(row0 + ai * HALF + m * 16) * ldc + col0;
                float q = 0.f;
#pragma unroll
                for (int bj = 0; bj < 2; ++bj) { f32x4 v0 = acc[ai][bj][m][0] + bv[bj][0], v1 = acc[ai][bj][m][1] + bv[bj][1];
                    q += (v0[0] * v0[0] + v0[1] * v0[1]) + (v0[2] * v0[2] + v0[3] * v0[3]) + (v1[0] * v1[0] + v1[1] * v1[1]) + (v1[2] * v1[2] + v1[3] * v1[3]);
                    u32x4 w; w.x = cvt_pk_bf16(v0[0], v0[1]); w.y = cvt_pk_bf16(v0[2], v0[3]); w.z = cvt_pk_bf16(v1[0], v1[1]); w.w = cvt_pk_bf16(v1[2], v1[3]);
                    *(u32x4*)(rowp + bj * HALF) = w; }
                if (ss) { q += __shfl_xor(q, 16); q += __shfl_xor(q, 32); if (fq == 0) atomicAdd(ss + row0 + ai * HALF + m * 16, q); } }
    }
};
struct EpiQKVU {
    static constexpr bool PERM = true;
    bf16_t* QK; bf16_t* VU; const float* cs; const float* qn; const float* kn; float c2;
    __device__ __forceinline__ void operator()(const f32x4 (&acc)[2][2][4][2], const Unit& u, int wr, int wc, int fr, int fq) const {
        const int row0 = u.pm * BM + wr * 64 + fr, tcol = 64 * wc + 8 * fq;
        if (u.pn >= 4) {
#pragma unroll
            for (int ai = 0; ai < 2; ++ai)
#pragma unroll
                for (int m = 0; m < 4; ++m) { bf16_t* rowp = VU + (size_t)(row0 + ai * HALF + m * 16) * 1024 + (u.pn - 4) * BM + tcol;
#pragma unroll
                    for (int bj = 0; bj < 2; ++bj) { const f32x4 v0 = acc[ai][bj][m][0], v1 = acc[ai][bj][m][1];
                        u32x4 w; w.x = cvt_pk_bf16(v0[0], v0[1]); w.y = cvt_pk_bf16(v0[2], v0[3]); w.z = cvt_pk_bf16(v1[0], v1[1]); w.w = cvt_pk_bf16(v1[2], v1[3]);
                        *(u32x4*)(rowp + 32 * bj) = w; } }
        } else {
            const bool isq = u.pn < 2; const float* gn = isq ? qn : kn; const float osc = isq ? c2 : 1.0f;
            f32x4 g4[2][2];
#pragma unroll
            for (int bj = 0; bj < 2; ++bj)
#pragma unroll
                for (int n = 0; n < 2; ++n) g4[bj][n] = *(const f32x4*)(gn + 32 * bj + 8 * fq + 4 * n);
#pragma unroll
            for (int ai = 0; ai < 2; ++ai)
#pragma unroll
                for (int m = 0; m < 4; ++m) { const int row = row0 + ai * HALF + m * 16;
                    f32x4 v[2][2]; float ss = 0.f;
#pragma unroll
                    for (int bj = 0; bj < 2; ++bj)
#pragma unroll
                        for (int n = 0; n < 2; ++n) { v[bj][n] = acc[ai][bj][m][n]; ss += (v[bj][n][0] * v[bj][n][0] + v[bj][n][1] * v[bj][n][1]) + (v[bj][n][2] * v[bj][n][2] + v[bj][n][3] * v[bj][n][3]); }
                    ss += __shfl_xor(ss, 16); ss += __shfl_xor(ss, 32);
                    const float r = 1.0f / sqrtf(ss * (1.f / 64.f) + 1e-6f);
#pragma unroll
                    for (int bj = 0; bj < 2; ++bj)
#pragma unroll
                        for (int n = 0; n < 2; ++n) v[bj][n] = v[bj][n] * g4[bj][n] * r;
#pragma unroll
                    for (int n = 0; n < 2; ++n) { const f32x4 c4 = *(const f32x4*)(cs + (size_t)row * 16 + 4 * n), s4 = *(const f32x4*)(cs + (size_t)row * 16 + 8 + 4 * n);
#pragma unroll
                        for (int j = 0; j < 4; ++j) { const float pv = __shfl_xor(v[0][n][j], 16); const float sg = (fq == 0) ? -s4[j] : s4[j];
                            if (fq < 2) v[0][n][j] = v[0][n][j] * c4[j] + pv * sg; } }
                    bf16_t* rowp = QK + (size_t)row * 1024 + u.pn * BM + tcol;
#pragma unroll
                    for (int bj = 0; bj < 2; ++bj) { const f32x4 v0 = v[bj][0] * osc, v1 = v[bj][1] * osc;
                        u32x4 w; w.x = cvt_pk_bf16(v0[0], v0[1]); w.y = cvt_pk_bf16(v0[2], v0[3]); w.z = cvt_pk_bf16(v1[0], v1[1]); w.w = cvt_pk_bf16(v1[2], v1[3]);
                        *(u32x4*)(rowp + 32 * bj) = w; } }
        }
    }
};
__device__ __forceinline__ f32x2 swiglu2(f32x2 g, f32x2 u) {
    g.x = fminf(g.x, 7.0f); g.y = fminf(g.y, 7.0f);
    u.x = __builtin_amdgcn_fmed3f(u.x, -7.0f, 7.0f); u.y = __builtin_amdgcn_fmed3f(u.y, -7.0f, 7.0f);
    f32x2 e = g * (-1.702f * 1.4426950408889634f);
    e.x = __builtin_amdgcn_exp2f(e.x); e.y = __builtin_amdgcn_exp2f(e.y);
    f32x2 d = e + 1.0f;
    d.x = __builtin_amdgcn_rcpf(d.x); d.y = __builtin_amdgcn_rcpf(d.y);
    return (u + 1.0f) * (g * d);
}
__device__ __forceinline__ unsigned pk4_fp8(float a, float b, float c, float d) { int w = 0; w = __builtin_amdgcn_cvt_pk_fp8_f32(a, b, w, false); w = __builtin_amdgcn_cvt_pk_fp8_f32(c, d, w, true); return (unsigned)w; }
struct EpiSwiglu {
    static constexpr bool PERM = true;
    unsigned char* H; const PG8_LAS float* ub;
    __device__ __forceinline__ void operator()(const f32x4 (&acc)[2][2][4][2], const Unit& u, int wr, int wc, int fr, int fq) const {
        const int row0 = u.pm * BM + wr * 64 + fr, hcol0 = u.pn * HALF + wc * 32 + 8 * fq;
        f32x4 g4[2], u4[2];
#pragma unroll
        for (int n = 0; n < 2; ++n) { g4[n] = *(const PG8_LAS f32x4*)(ub + u.ord * 256 + wc * 32 + 8 * fq + 4 * n); u4[n] = *(const PG8_LAS f32x4*)(ub + u.ord * 256 + 128 + wc * 32 + 8 * fq + 4 * n); }
#pragma unroll
        for (int ai = 0; ai < 2; ++ai)
#pragma unroll
            for (int m = 0; m < 4; ++m) { unsigned char* rowp = H + (size_t)(row0 + ai * HALF + m * 16) * 1024 + hcol0;
                float h[8];
#pragma unroll
                for (int n = 0; n < 2; ++n) { const f32x4 gv = acc[ai][0][m][n] * 0.03125f + g4[n], uv = acc[ai][1][m][n] * 0.03125f + u4[n];
                    const f32x2 h0 = swiglu2((f32x2){gv[0], gv[1]}, (f32x2){uv[0], uv[1]}), h1 = swiglu2((f32x2){gv[2], gv[3]}, (f32x2){uv[2], uv[3]});
                    h[4 * n] = h0.x; h[4 * n + 1] = h0.y; h[4 * n + 2] = h1.x; h[4 * n + 3] = h1.y; }
                u32x2 w; w.x = pk4_fp8(h[0], h[1], h[2], h[3]); w.y = pk4_fp8(h[4], h[5], h[6], h[7]);
                *(u32x2*)rowp = w; }
    }
};
struct EpiDown {
    static constexpr bool PERM = true;
    unsigned char* Y; const PG8_LAS float* ub;
    __device__ __forceinline__ void operator()(const f32x4 (&acc)[2][2][4][2], const Unit& u, int wr, int wc, int fr, int fq) const {
        const int col0 = u.pn * BM + wc * 32 + 8 * fq;
        f32x4 bv[2][2];
#pragma unroll
        for (int bj = 0; bj < 2; ++bj)
#pragma unroll
            for (int n = 0; n < 2; ++n) bv[bj][n] = *(const PG8_LAS f32x4*)(ub + u.ord * 256 + wc * 32 + 8 * fq + bj * HALF + 4 * n);
#pragma unroll
        for (int ai = 0; ai < 2; ++ai)
#pragma unroll
            for (int m = 0; m < 4; ++m) { const int r = wr * 64 + fr + ai * HALF + m * 16; unsigned char* rowp = Y + (size_t)(u.pm + r) * 1024 + col0;
                if (r < u.nv) {
#pragma unroll
                    for (int bj = 0; bj < 2; ++bj) { f32x4 v0 = acc[ai][bj][m][0] * 0.03125f + bv[bj][0], v1 = acc[ai][bj][m][1] * 0.03125f + bv[bj][1];
                        u32x2 w; w.x = pk4_fp8(v0[0], v0[1], v0[2], v0[3]); w.y = pk4_fp8(v1[0], v1[1], v1[2], v1[3]);
                        *(u32x2*)(rowp + bj * HALF) = w; } } }
    }
};
struct EpiResBf16 {
    static constexpr bool PERM = true;
    const float* base; bf16_t* H;
    __device__ __forceinline__ void operator()(const f32x4 (&acc)[2][2][4][2], const Unit& u, int wr, int wc, int fr, int fq) const {
        const int row0 = u.pm * BM + wr * 64 + fr, col0 = u.pn * BM + wc * 32 + 8 * fq;
#pragma unroll
        for (int ai = 0; ai < 2; ++ai)
#pragma unroll
            for (int m = 0; m < 4; ++m) { const size_t off = (size_t)(row0 + ai * HALF + m * 16) * 1024 + col0;
#pragma unroll
                for (int bj = 0; bj < 2; ++bj) { const f32x4 b0 = *(const f32x4*)(base + off + bj * HALF), b1 = *(const f32x4*)(base + off + bj * HALF + 4);
                    const f32x4 v0 = b0 + acc[ai][bj][m][0], v1 = b1 + acc[ai][bj][m][1];
                    u32x4 w; w.x = cvt_pk_bf16(v0[0], v0[1]); w.y = cvt_pk_bf16(v0[2], v0[3]); w.z = cvt_pk_bf16(v1[0], v1[1]); w.w = cvt_pk_bf16(v1[2], v1[3]);
                    *(u32x4*)(H + off + bj * HALF) = w; }
                if (m & 1) asm volatile("" ::: "memory"); }
    }
};
struct EpiFinal {
    static constexpr bool PERM = false;
    float* out; const bf16_t* H2; const bf16_t* ER; const float* ss; const float* pn;
    __device__ __forceinline__ void operator()(const f32x4 (&acc)[2][2][4][2], const Unit& u, int wr, int wc, int fr, int fq) const {
        const int row0 = u.pm * BM + wr * 64 + fr, col0 = u.pn * BM + wc * 32 + 4 * fq;
        f32x4 pv[2][2];
#pragma unroll
        for (int bj = 0; bj < 2; ++bj)
#pragma unroll
            for (int n = 0; n < 2; ++n) pv[bj][n] = *(const f32x4*)(pn + col0 + bj * HALF + n * 16);
#pragma unroll
        for (int ai = 0; ai < 2; ++ai)
#pragma unroll
            for (int m = 0; m < 4; ++m) { const int row = row0 + ai * HALF + m * 16; const size_t off = (size_t)row * 1024 + col0;
                const float re = 1.0f / sqrtf(ss[row] * (1.f / 1024.f) + 1e-6f);
#pragma unroll
                for (int bj = 0; bj < 2; ++bj)
#pragma unroll
                    for (int n = 0; n < 2; ++n) { const size_t o = off + bj * HALF + n * 16; const u32x2 hw = *(const u32x2*)(H2 + o); const u32x2 ew = *(const u32x2*)(ER + o);
                        f32x4 b; b[0] = __uint_as_float(hw.x << 16); b[1] = __uint_as_float(hw.x & 0xffff0000u); b[2] = __uint_as_float(hw.y << 16); b[3] = __uint_as_float(hw.y & 0xffff0000u);
                        f32x4 e; e[0] = __uint_as_float(ew.x << 16); e[1] = __uint_as_float(ew.x & 0xffff0000u); e[2] = __uint_as_float(ew.y << 16); e[3] = __uint_as_float(ew.y & 0xffff0000u);
                        f32x4 r;
#pragma unroll
                        for (int j = 0; j < 4; ++j) { const float sg = __builtin_amdgcn_rcpf(1.0f + __builtin_amdgcn_exp2f((-1.4426950408889634f * 0.03125f) * acc[ai][bj][m][n][j])); r[j] = b[j] + sg * (e[j] * re * pv[bj][n][j]); }
                        *(f32x4*)(out + o) = r; }
                if (m & 1) asm volatile("" ::: "memory"); }
    }
};

typedef int v8i __attribute__((ext_vector_type(8)));
typedef int v4i __attribute__((ext_vector_type(4)));
__device__ __forceinline__ v8i cat8(bf16x8 a, bf16x8 b) { const v4i x = __builtin_bit_cast(v4i, a), y = __builtin_bit_cast(v4i, b); return __builtin_shufflevector(x, y, 0, 1, 2, 3, 4, 5, 6, 7); }
__device__ __forceinline__ void mfma8(f32x4& acc, v8i a, v8i b, int sc) { asm volatile("v_mfma_scale_f32_16x16x128_f8f6f4 %0, %1, %2, %0, %3, %3 op_sel_hi:[0,0,0]" : "+v"(acc) : "v"(a), "v"(b), "v"(sc)); }
__device__ __forceinline__ int tid_opaque() { int t; asm volatile("v_mov_b32 %0, %1" : "=v"(t) : "v"(threadIdx.x)); return t; }
__device__ __forceinline__ void a_offs(const Gemm& g, const Unit& u, int R0, unsigned c2, unsigned (&o)[2][2]) {
    const PG8_LAS unsigned short* t = g.urow + u.ord * 256 + R0;
#pragma unroll
    for (int h = 0; h < 2; ++h) {
        const unsigned r0 = t[h * HALF], r1 = t[h * HALF + 64];
        o[h][0] = (r0 * (unsigned)g.K) * 2u + c2; o[h][1] = (r1 * (unsigned)g.K) * 2u + c2; }
}

template <class Epi, class Sched, bool GATHER, bool ALIGN_EPI, bool F8 = false, bool G64 = false>
__device__ __forceinline__ void gemm_phase(PG8_LAS unsigned char* lds, const Gemm g, const Sched& S, const Epi& E) {
    const int tid = tid_opaque(), wid = __builtin_amdgcn_readfirstlane(tid >> 6), lane = tid & 63, wr = wid >> 2, wc = wid & 3, fr = lane & 15, fq = lane >> 4;
    const int K = g.K, nt = K / BK;
    int R0, C0; stage_rc(tid * 16, R0, C0);
    unsigned voffA[2], voffB[2];
    { const int Rb0 = G64 ? (64 * (R0 >> 5) + perm32(R0 & 31)) : Epi::PERM ? ((R0 & ~31) + perm32(R0 & 31)) : R0;
      voffA[0] = (unsigned)(R0 * K + C0) * 2u; voffA[1] = voffA[0] + (unsigned)(64 * K) * 2u;
      voffB[0] = (unsigned)(Rb0 * K + C0) * 2u; voffB[1] = voffB[0] + (unsigned)((G64 ? 128 : 64) * K) * 2u; }
    const size_t kstep = (size_t)(BK * 2);
    const size_t hstep = (size_t)HALF * K * 2;
    const size_t tstep = 2 * hstep;
    const size_t hstepB = G64 ? (size_t)32 * K * 2 : hstep;
    const unsigned ldsw = (unsigned)wid * 1024u;
    const int aoff = lds_byte(wr * 64 + fr, F8 ? fq * 16 : fq * 8), boff = lds_byte(wc * 32 + fr, F8 ? fq * 16 : fq * 8);
    constexpr int CHS = F8 ? 16 : 1024;
    int sc8 = 0x7f7f7f7f; asm volatile("" : "+v"(sc8));
#define PG8_SA(b, h) (((b) * 2 + (h)) * HTB)
#define PG8_SB(b, h) ((4 + (b) * 2 + (h)) * HTB)
#define PG8_STAGE(bufoff, gbase, voff) do { _Pragma("unroll") for (int _i = 0; _i < 2; ++_i) \
        __builtin_amdgcn_global_load_lds((const unsigned*)((const char*)(gbase) + (voff)[_i]), (PG8_LAS unsigned*)(lds + (bufoff) + ldsw + _i * 8192), 16, 0, 0); } while (0)
#define PG8_STAGE_AC(bufoff, kb, h) do { if constexpr (GATHER) { PG8_STAGE(bufoff, Ab + (kb), co[h]); } else { PG8_STAGE(bufoff, cA + (kb) + (h) * hstep, voffA); } } while (0)
#define PG8_STAGE_AX(bufoff, nx, kb, kbn, h) do { if constexpr (GATHER) { unsigned _o[2]; _o[0] = (nx) ? no[h][0] : co[h][0]; _o[1] = (nx) ? no[h][1] : co[h][1]; PG8_STAGE(bufoff, Ab + ((nx) ? (kbn) : (kb)), _o); } \
        else { PG8_STAGE(bufoff, ((nx) ? nA + (kbn) : cA + (kb)) + (h) * hstep, voffA); } } while (0)
#define PG8_LDA(dst, b, h) do { _Pragma("unroll") for (int m = 0; m < 4; ++m) _Pragma("unroll") for (int k = 0; k < 2; ++k) dst[m][k] = *(const PG8_LAS bf16x8*)(lds + PG8_SA(b, h) + aoff + m * 2048 + k * CHS); } while (0)
#define PG8_LDB(dst, b, h) do { _Pragma("unroll") for (int n = 0; n < 2; ++n) _Pragma("unroll") for (int k = 0; k < 2; ++k) dst[n][k] = *(const PG8_LAS bf16x8*)(lds + PG8_SB(b, h) + boff + n * 2048 + k * CHS); } while (0)
#define PG8_MMA(ai, bj, At, Bt) do { __builtin_amdgcn_s_setprio(1); _Pragma("unroll") for (int m = 0; m < 4; ++m) _Pragma("unroll") for (int n = 0; n < 2; ++n) { \
        if constexpr (F8) { mfma8(acc[ai][bj][m][n], cat8(Bt[n][0], Bt[n][1]), cat8(At[m][0], At[m][1]), sc8); } \
        else { _Pragma("unroll") for (int k = 0; k < 2; ++k) acc[ai][bj][m][n] = __builtin_amdgcn_mfma_f32_16x16x32_bf16(Bt[n][k], At[m][k], acc[ai][bj][m][n], 0, 0, 0); } } \
        __builtin_amdgcn_s_setprio(0); } while (0)
#define PG8_WAIT_V(n) asm volatile("s_waitcnt vmcnt(" #n ")" ::: "memory")
#define PG8_WAIT_L(n) asm volatile("s_waitcnt lgkmcnt(" #n ")" ::: "memory")
#define PG8_BAR __builtin_amdgcn_s_barrier()
#define PG8_SCHED __builtin_amdgcn_sched_barrier(0)
    Unit cur, nxt; int ui = 0;
    if (!S.next(0, cur)) return;
    f32x4 acc[2][2][4][2];
#pragma unroll
    for (int a = 0; a < 2; ++a)
#pragma unroll
        for (int b = 0; b < 2; ++b)
#pragma unroll
            for (int m = 0; m < 4; ++m)
#pragma unroll
                for (int n = 0; n < 2; ++n) acc[a][b][m][n] = (f32x4){0.f, 0.f, 0.f, 0.f};
    bf16x8 At[4][2], B0[2][2], B1[2][2];
    const char* const Ab = (const char*)g.A;
    const char* cA = Ab + (GATHER ? (size_t)0 : (size_t)cur.ta * tstep);
    const char* cB = (const char*)g.Bt + (size_t)cur.tb * tstep;
    unsigned co[2][2], no[2][2];
    const unsigned c2 = (unsigned)C0 * 2u;
    if constexpr (GATHER) a_offs(g, cur, R0, c2, co);
    PG8_STAGE(PG8_SB(0, 0), cB, voffB); PG8_STAGE(PG8_SB(0, 1), cB + hstepB, voffB); PG8_STAGE_AC(PG8_SA(0, 0), 0, 0); PG8_STAGE_AC(PG8_SA(0, 1), 0, 1);
    if (wr == 1) PG8_BAR;
    PG8_WAIT_V(2); PG8_BAR;
    PG8_STAGE(PG8_SB(1, 0), cB + kstep, voffB); PG8_STAGE_AC(PG8_SA(1, 0), kstep, 0); PG8_STAGE(PG8_SB(1, 1), cB + hstepB + kstep, voffB);
    PG8_WAIT_V(6); PG8_BAR;
    for (;;) {
        const bool has_next = S.next(ui + 1, nxt);
        const char* nB = has_next ? (const char*)g.Bt + (size_t)nxt.tb * tstep : cB;
        const char* nA = (has_next && !GATHER) ? Ab + (size_t)nxt.ta * tstep : cA;
        if constexpr (GATHER) {
            if (has_next) a_offs(g, nxt, R0, c2, no);
            else {
#pragma unroll
                for (int h = 0; h < 2; ++h) { no[h][0] = co[h][0]; no[h][1] = co[h][1]; } } }
        for (int t = 0; t < nt; t += 2) {
            const bool last = (t == nt - 2);
            const size_t k1 = (size_t)(t + 1) * kstep, k2 = (size_t)(t + 2) * kstep, k3 = (size_t)(t + 3) * kstep;
            const char* b2 = last ? nB : cB + k2;
            const char* b3 = b2 + kstep;
            PG8_LDB(B0, 0, 0); PG8_LDB(B1, 0, 1); PG8_SCHED; PG8_LDA(At, 0, 0); PG8_STAGE_AC(PG8_SA(1, 1), k1, 1);
            PG8_WAIT_V(8); PG8_WAIT_L(0); PG8_BAR; PG8_MMA(0, 0, At, B0); PG8_MMA(0, 1, At, B1); PG8_BAR; PG8_SCHED;
            PG8_LDA(At, 0, 1); PG8_STAGE(PG8_SB(0, 0), b2, voffB); PG8_STAGE(PG8_SB(0, 1), b2 + hstepB, voffB); PG8_STAGE_AX(PG8_SA(0, 0), last, k2, (size_t)0, 0);
            PG8_WAIT_V(8); PG8_WAIT_L(0); PG8_BAR; PG8_MMA(1, 0, At, B0); PG8_MMA(1, 1, At, B1); PG8_BAR; PG8_SCHED;
            PG8_LDB(B0, 1, 0); PG8_LDB(B1, 1, 1); PG8_SCHED; PG8_LDA(At, 1, 0); PG8_STAGE_AX(PG8_SA(0, 1), last, k2, (size_t)0, 1);
            PG8_WAIT_V(8); PG8_WAIT_L(0); PG8_BAR; PG8_MMA(0, 0, At, B0); PG8_MMA(0, 1, At, B1); PG8_BAR; PG8_SCHED;
            PG8_LDA(At, 1, 1); PG8_STAGE(PG8_SB(1, 0), b3, voffB); PG8_STAGE(PG8_SB(1, 1), b3 + hstepB, voffB); PG8_STAGE_AX(PG8_SA(1, 0), last, k3, kstep, 0);
            PG8_WAIT_V(8); PG8_WAIT_L(0); PG8_BAR; PG8_MMA(1, 0, At, B0); PG8_MMA(1, 1, At, B1); PG8_BAR; PG8_SCHED;
        }
        if constexpr (ALIGN_EPI) { if (wr == 0) PG8_BAR; }
        if constexpr (F8) asm volatile("s_nop 15\n\ts_nop 15" ::: "memory");
        { const int te = tid_opaque() & 63; E(acc, cur, wr, wc, te & 15, te >> 4); }
        if (!has_next) break;
#pragma unroll
        for (int a = 0; a < 2; ++a)
#pragma unroll
            for (int b = 0; b < 2; ++b)
#pragma unroll
                for (int m = 0; m < 4; ++m)
#pragma unroll
                    for (int n = 0; n < 2; ++n) acc[a][b][m][n] = (f32x4){0.f, 0.f, 0.f, 0.f};
        cur = nxt; cB = nB; cA = nA; ++ui;
        if constexpr (GATHER) {
#pragma unroll
            for (int h = 0; h < 2; ++h) { co[h][0] = no[h][0]; co[h][1] = no[h][1]; } }
        if constexpr (ALIGN_EPI) { if (wr == 1) PG8_BAR; }
    }
    PG8_WAIT_V(0);
    if constexpr (!ALIGN_EPI) { if (wr == 0) PG8_BAR; }
    PG8_BAR;
#undef PG8_SA
#undef PG8_SB
#undef PG8_STAGE
#undef PG8_STAGE_AC
#undef PG8_STAGE_AX
#undef PG8_LDA
#undef PG8_LDB
#undef PG8_MMA
#undef PG8_WAIT_V
#undef PG8_WAIT_L
#undef PG8_BAR
#undef PG8_SCHED
}
}

namespace attn_body {
using bf16=__hip_bfloat16;
using bf16x8=__attribute__((ext_vector_type(8)))short;
using s16x4=__attribute__((ext_vector_type(4)))short;
using f32x16=__attribute__((ext_vector_type(16)))float;
using u32x4=__attribute__((ext_vector_type(4)))unsigned;
constexpr int SEQ=4096,D=64,DM=1024;
constexpr int NW=8,QBLK=32,QB=QBLK*NW,KVBLK=64,NQB=SEQ/QB;
__device__ __forceinline__ int crow(int r,int hi){return (r&3)+8*(r>>2)+4*hi;}
#define SBAR() __builtin_amdgcn_sched_barrier(0)
__device__ __forceinline__ void cmask(f32x16&p0,f32x16&p1,int jb,int qrel,int hi){
  const float NEG=-INFINITY; int kb=64*jb+4*hi;
  #pragma unroll
  for(int r=0;r<16;++r){int kv=kb+(r&3)+8*(r>>2); if(kv>qrel)p0[r]=NEG; if(kv+32>qrel)p1[r]=NEG;}
}
constexpr int NSLOT=3, SLOTB=8192;
constexpr int LDS_K=0, LDS_V=NSLOT*SLOTB, LDS_WS=2*NSLOT*SLOTB, LDS_OST=LDS_WS+NW*64*4, LDS_BYTES=LDS_OST+NW*4096;
constexpr float C2=0.125f*1.4426950408889634f;
__device__ __forceinline__ void glds16(const void*gsrc,unsigned lds_dst){unsigned keep;
  asm volatile("s_mov_b32 %0, m0\n\ts_mov_b32 m0, %2\n\ts_nop 0\n\tglobal_load_lds_dwordx4 %1, off\n\ts_mov_b32 m0, %0":"=&s"(keep):"v"(gsrc),"s"(lds_dst):"memory");}
__device__ __forceinline__ float max3f(float a,float b,float c){float r;asm("v_max3_f32 %0, %1, %2, %3":"=v"(r):"v"(a),"v"(b),"v"(c));return r;}
__device__ __forceinline__ float max2f(float a,float b){float r;asm("v_max_f32_e32 %0, %1, %2":"=v"(r):"v"(a),"v"(b));return r;}
__device__ __forceinline__ float fadd_s(float a,float b){float r;asm("v_add_f32_e32 %0, %1, %2":"=v"(r):"v"(a),"v"(b));return r;}
__device__ __forceinline__ float fsub_s(float a,float b){float r;asm("v_sub_f32_e32 %0, %1, %2":"=v"(r):"v"(a),"v"(b));return r;}
typedef float f32x2_t __attribute__((ext_vector_type(2))); typedef __bf16 bf16x2_t __attribute__((ext_vector_type(2)));
__device__ __forceinline__ unsigned cvtpk_s(float lo,float hi){f32x2_t v={lo,hi};bf16x2_t b=__builtin_convertvector(v,bf16x2_t);return __builtin_bit_cast(unsigned,b);}
#define WAIT_BAR(N) asm volatile("s_waitcnt vmcnt(" #N ") lgkmcnt(0)\n\ts_barrier":::"memory")

__device__ __forceinline__ void qkt(f32x16&p0,f32x16&p1,const char*Kslot,const bf16x8*qr,const f32x16&negm,int r32,int hi){
  const char*kb=Kslot+hi*1024+r32*16;
  #pragma unroll
  for(int d0=0;d0<4;++d0){
    const bf16x8 b0=*reinterpret_cast<const bf16x8*>(kb+d0*2048);
    const bf16x8 b1=*reinterpret_cast<const bf16x8*>(kb+d0*2048+512);
    if(d0==0){p0=__builtin_amdgcn_mfma_f32_32x32x16_bf16(b0,qr[0],negm,0,0,0);p1=__builtin_amdgcn_mfma_f32_32x32x16_bf16(b1,qr[0],negm,0,0,0);}
    else{p0=__builtin_amdgcn_mfma_f32_32x32x16_bf16(b0,qr[d0],p0,0,0,0);p1=__builtin_amdgcn_mfma_f32_32x32x16_bf16(b1,qr[d0],p1,0,0,0);}}
}
typedef __attribute__((address_space(3))) const char* lds_cptr;
typedef short v4i16_t __attribute__((ext_vector_type(4)));
__device__ __forceinline__ void kload8(bf16x8*kf,lds_cptr kp){
  kf[0]=*(const __attribute__((address_space(3))) bf16x8*)(kp);      kf[1]=*(const __attribute__((address_space(3))) bf16x8*)(kp+512);
  kf[2]=*(const __attribute__((address_space(3))) bf16x8*)(kp+2048); kf[3]=*(const __attribute__((address_space(3))) bf16x8*)(kp+2560);
  kf[4]=*(const __attribute__((address_space(3))) bf16x8*)(kp+4096); kf[5]=*(const __attribute__((address_space(3))) bf16x8*)(kp+4608);
  kf[6]=*(const __attribute__((address_space(3))) bf16x8*)(kp+6144); kf[7]=*(const __attribute__((address_space(3))) bf16x8*)(kp+6656);
}
__device__ __forceinline__ void kload2(bf16x8*kf,lds_cptr kp,int j){ kf[2*j]=*(const __attribute__((address_space(3))) bf16x8*)(kp+j*2048); kf[2*j+1]=*(const __attribute__((address_space(3))) bf16x8*)(kp+j*2048+512); }
__device__ __forceinline__ s16x4 vtr(lds_cptr p){ return __builtin_bit_cast(s16x4,__builtin_amdgcn_ds_read_tr16_b64_v4i16((__attribute__((address_space(3))) v4i16_t*)p)); }
__device__ __forceinline__ float rowmax(const f32x16&p0,const f32x16&p1){
  float a=max3f(p0[0],p0[1],p1[0]),b=max3f(p0[2],p0[3],p1[1]);a=max3f(a,p1[2],p1[3]);
  #pragma unroll
  for(int r=4;r<16;r+=4){a=max3f(a,p0[r],p0[r+1]);b=max3f(b,p0[r+2],p0[r+3]);a=max3f(a,p1[r],p1[r+1]);b=max3f(b,p1[r+2],p1[r+3]);}
  const float m=max2f(a,b);
  auto rr=__builtin_amdgcn_permlane32_swap(__float_as_uint(m),__float_as_uint(m),false,false);
  return max2f(__uint_as_float(rr[0]),__uint_as_float(rr[1]));
}
__device__ __forceinline__ void pv(f32x16*o,int vb,bf16x8 pa0,bf16x8 pa1,bf16x8 pa2,bf16x8 pa3){
  #pragma unroll
  for(int d0=0;d0<2;++d0){s16x4 lo[4],hi[4];
    #pragma unroll
    for(int ks=0;ks<4;++ks){
      asm volatile("ds_read_b64_tr_b16 %0,%1 offset:%c2":"=&v"(lo[ks]):"v"(vb),"i"(d0*4096+ks*1024):"memory");
      asm volatile("ds_read_b64_tr_b16 %0,%1 offset:%c2":"=&v"(hi[ks]):"v"(vb),"i"(d0*4096+ks*1024+512):"memory");}
    asm volatile("s_waitcnt lgkmcnt(0)":::"memory");SBAR();
    #define PK(k) (bf16x8){lo[k][0],lo[k][1],lo[k][2],lo[k][3],hi[k][0],hi[k][1],hi[k][2],hi[k][3]}
    o[d0]=__builtin_amdgcn_mfma_f32_32x32x16_bf16(pa0,PK(0),o[d0],0,0,0);
    o[d0]=__builtin_amdgcn_mfma_f32_32x32x16_bf16(pa1,PK(1),o[d0],0,0,0);
    o[d0]=__builtin_amdgcn_mfma_f32_32x32x16_bf16(pa2,PK(2),o[d0],0,0,0);
    o[d0]=__builtin_amdgcn_mfma_f32_32x32x16_bf16(pa3,PK(3),o[d0],0,0,0);
    #undef PK
  }
}
#define ATTN_STORE16(p,v) (*(u32x4*)(p)=(v))
template<int THRL> __device__ __forceinline__ void attn_unit(int b,int qc,int kc,int vc,int oc,int qb,const bf16*Q,const bf16*__restrict__ K,const bf16*__restrict__ V,bf16*O,char*shm){
  const int tid=threadIdx.x,lane=tid&63,r32=lane&31,hi=lane>>5; const int wid=__builtin_amdgcn_readfirstlane(tid>>6);
  const long rowbase=(long)b*SEQ; const int q0=qb*QB;
  const bf16*Qw=Q+(rowbase+q0+wid*QBLK)*DM+qc;
  const bf16*Kh=K+rowbase*DM+kc,*Vh=V+rowbase*DM+vc;
  const unsigned lds0=(unsigned)(uintptr_t)shm;
  float*wsf=(float*)(shm+LDS_WS)+wid*64;
  const bf16*ksrc=Kh+(long)lane*DM+wid*8;
  const bf16*vsrc=Vh+(long)(16*(wid&3)+(lane>>2))*DM+(wid>>2)*32+(lane&3)*8;
  const unsigned kdst=lds0+LDS_K+wid*1024, vdst=lds0+LDS_V+wid*1024;
  #define DMA_K(t,slot) glds16(ksrc+(long)(t)*KVBLK*DM,(unsigned)__builtin_amdgcn_readfirstlane(kdst+(slot)))
  #define DMA_V(t,slot) glds16(vsrc+(long)(t)*KVBLK*DM,(unsigned)__builtin_amdgcn_readfirstlane(vdst+(slot)))
  const int vb0=(int)(lds0+LDS_V)+((lane>>4)&1)*32+(lane&3)*8+(4*hi+((lane&15)>>2))*64;
  const char*Kbase=shm+LDS_K; bf16x8 kf[8];
  const lds_cptr shm3=(lds_cptr)shm; const lds_cptr kp0=shm3+LDS_K+hi*1024+r32*16; const lds_cptr vp0=shm3+LDS_V+((lane>>4)&1)*32+(lane&3)*8+(4*hi+((lane&15)>>2))*64;
  const int NT=(q0+QB)/KVBLK;
  DMA_K(0,0);DMA_V(0,0);DMA_K(1,SLOTB);
  bf16x8 qr[4];
  #pragma unroll
  for(int d0=0;d0<4;++d0)qr[d0]=*reinterpret_cast<const bf16x8*>(&Qw[(long)r32*DM+d0*16+hi*8]);
  float mhat=0.f,l_reg=0.f;f32x16 o[2];o[0]=f32x16{};o[1]=f32x16{};f32x16 negm=f32x16{};asm volatile("":"+v"(negm));
  const int qrel=wid*QBLK+r32;
  #define CMASK(P0,P1,t) do{int jb_=(t)-(NT-4); if(jb_>=0)cmask(P0,P1,jb_,qrel,hi);}while(0)
  bool resc=false;
  #define START(P0,P1) do{ const float rm=rowmax(P0,P1); resc=false; \
    { const float dl=rm; mhat=fadd_s(mhat,dl); \
      _Pragma("unroll") for(int r=0;r<16;++r){P0[r]=fsub_s(P0[r],dl);P1[r]=fsub_s(P1[r],dl);} \
      _Pragma("unroll") for(int r=0;r<16;++r)negm[r]=-mhat; asm volatile("":"+v"(negm)); } \
    _Pragma("unroll") for(int r=0;r<16;++r)P0[r]=__builtin_amdgcn_exp2f(P0[r]); }while(0)
  #define RESC() do{ if(resc){ asm volatile("s_waitcnt lgkmcnt(0)":::"memory"); \
      _Pragma("unroll") for(int d_=0;d_<2;++d_) _Pragma("unroll") for(int r=0;r<16;++r)o[d_][r]*=wsf[crow(r,hi)]; } }while(0)
  f32x16 pA0,pA1,pB0,pB1;
  int sl_prev=0,sl_cur=0,sl_next=SLOTB;
  #define ROT() do{sl_prev=sl_cur;sl_cur=sl_next;sl_next=(sl_next==(NSLOT-1)*SLOTB)?0:sl_next+SLOTB;}while(0)
  DMA_K(2,2*SLOTB);
  WAIT_BAR(3);
  qkt(pA0,pA1,Kbase,qr,negm,r32,hi);asm volatile("s_nop 15\n\ts_nop 7":"+v"(pA0),"+v"(pA1));CMASK(pA0,pA1,0);
  START(pA0,pA1);
  _Pragma("unroll") for(int r=0;r<16;++r)pA1[r]=__builtin_amdgcn_exp2f(pA1[r]);
  WAIT_BAR(0);
  DMA_K(3,0);DMA_V(1,SLOTB);
  ROT();
  kload8(kf,kp0+sl_cur);
  WAIT_BAR(2);
  s16x4 vlo[8],vhi[8]; u32x4 pw0,pw1,pw2,pw3;
  #define PKW(P,B) cvtpk_s(P[B],P[B+1])
  #define PAF(k) __builtin_bit_cast(bf16x8,pw##k)
  #define VFR(i) (bf16x8){vlo[i][0],vlo[i][1],vlo[i][2],vlo[i][3],vhi[i][0],vhi[i][1],vhi[i][2],vhi[i][3]}
  #define PIN(x) asm volatile("":"+v"(x))
  #define MX3(a,b,c) __builtin_fmaxf(__builtin_fmaxf((a),(b)),(c))
  #define GAPA(MF,A0,A1,A2,A3,W0,W1,PW) do{ MF; sacc+=A0; sacc+=A1; sacc+=A2; sacc+=A3; PIN(sacc); W0; W1; PIN(PW); SBAR(); }while(0)
  #define EX(v) __builtin_amdgcn_exp2f(v)
  #define GAPB(MF,X,B) do{ MF; X[B]=EX(X[B]); X[B+1]=EX(X[B+1]); X[B+2]=EX(X[B+2]); X[B+3]=EX(X[B+3]); PIN(X); SBAR(); }while(0)
  #define VRD(i) do{ vlo[i]=vtr(vp_+(((i)>>2)*4096+((i)&3)*1024)); vhi[i]=vtr(vp_+(((i)>>2)*4096+((i)&3)*1024+512)); }while(0)
  #define KRD(G,j) do{ if(G){ kload2(kf,kp0+sl_next,j); SBAR(); } }while(0)
  #define STEP(C0,C1,P0,P1,t,GK,GV,GL) do{ SBAR(); \
    const lds_cptr vp_=vp0+sl_prev; \
    VRD(0); SBAR(); float sacc=(P0[0]+P0[1]); \
    GAPA(C0=__builtin_amdgcn_mfma_f32_32x32x16_bf16(kf[0],qr[0],negm,0,0,0), P0[2],P0[3],P0[4],P0[5],     pw0[0]=PKW(P0,0), pw0[1]=PKW(P0,2), pw0); \
    VRD(4); SBAR(); GAPA(C1=__builtin_amdgcn_mfma_f32_32x32x16_bf16(kf[1],qr[0],negm,0,0,0), P0[6],P0[7],P0[8],P0[9],     pw0[2]=PKW(P0,4), pw0[3]=PKW(P0,6), pw0); \
    VRD(1); SBAR(); GAPA(C0=__builtin_amdgcn_mfma_f32_32x32x16_bf16(kf[2],qr[1],C0,0,0,0),   P0[10],P0[11],P0[12],P0[13], pw1[0]=PKW(P0,8), pw1[1]=PKW(P0,10), pw1); \
    VRD(5); SBAR(); GAPA(C1=__builtin_amdgcn_mfma_f32_32x32x16_bf16(kf[3],qr[1],C1,0,0,0),   P0[14],P0[15],P1[0],P1[1],   pw1[2]=PKW(P0,12),pw1[3]=PKW(P0,14), pw1); \
    VRD(2); SBAR(); GAPA(C0=__builtin_amdgcn_mfma_f32_32x32x16_bf16(kf[4],qr[2],C0,0,0,0),   P1[2],P1[3],P1[4],P1[5],     pw2[0]=PKW(P1,0), pw2[1]=PKW(P1,2), pw2); \
    VRD(6); SBAR(); GAPA(C1=__builtin_amdgcn_mfma_f32_32x32x16_bf16(kf[5],qr[2],C1,0,0,0),   P1[6],P1[7],P1[8],P1[9],     pw2[2]=PKW(P1,4), pw2[3]=PKW(P1,6), pw2); \
    VRD(3); SBAR(); GAPA(C0=__builtin_amdgcn_mfma_f32_32x32x16_bf16(kf[6],qr[3],C0,0,0,0),   P1[10],P1[11],P1[12],P1[13], pw3[0]=PKW(P1,8), pw3[1]=PKW(P1,10), pw3); \
    VRD(7); SBAR(); GAPA(C1=__builtin_amdgcn_mfma_f32_32x32x16_bf16(kf[7],qr[3],C1,0,0,0),   P1[14],P1[15],0.f,0.f,       pw3[2]=PKW(P1,12),pw3[3]=PKW(P1,14), pw3); \
    l_reg+=sacc; \
    if(GK){DMA_K((t)+3,sl_cur);} if(GV){DMA_V((t)+1,sl_next);} \
    CMASK(C0,C1,t); \
    { float a=MX3(C0[0],C0[1],C1[0]),b=MX3(C0[2],C0[3],C1[1]); a=MX3(a,C1[2],C1[3]); \
      _Pragma("unroll") for(int r=4;r<16;r+=4){a=MX3(a,C0[r],C0[r+1]);b=MX3(b,C0[r+2],C0[r+3]);a=MX3(a,C1[r],C1[r+1]);b=MX3(b,C1[r+2],C1[r+3]);} \
      float rm=__builtin_fmaxf(a,b); { auto rr=__builtin_amdgcn_permlane32_swap(__float_as_uint(rm),__float_as_uint(rm),false,false); rm=__builtin_fmaxf(__uint_as_float(rr[0]),__uint_as_float(rr[1])); } \
      resc=false; \
      if(__builtin_expect(__any(rm>(float)THRL),0)){ const float dl=__builtin_fmaxf(rm,0.f); mhat+=dl; \
        _Pragma("unroll") for(int r=0;r<16;++r){C0[r]-=dl;C1[r]-=dl;} \
        _Pragma("unroll") for(int r=0;r<16;++r)negm[r]=-mhat; asm volatile("":"+v"(negm)); \
        const float f=__builtin_amdgcn_exp2f(-dl); l_reg*=f; if(hi==0)wsf[r32]=f; resc=true; } } \
    SBAR(); \
    GAPB(o[0]=__builtin_amdgcn_mfma_f32_32x32x16_bf16(PAF(0),VFR(0),o[0],0,0,0), C0,0); \
    GAPB(o[1]=__builtin_amdgcn_mfma_f32_32x32x16_bf16(PAF(0),VFR(4),o[1],0,0,0), C0,4); \
    KRD(GL,0); GAPB(o[0]=__builtin_amdgcn_mfma_f32_32x32x16_bf16(PAF(1),VFR(1),o[0],0,0,0), C0,8); \
    KRD(GL,1); GAPB(o[1]=__builtin_amdgcn_mfma_f32_32x32x16_bf16(PAF(1),VFR(5),o[1],0,0,0), C0,12); \
    KRD(GL,2); GAPB(o[0]=__builtin_amdgcn_mfma_f32_32x32x16_bf16(PAF(2),VFR(2),o[0],0,0,0), C1,0); \
    KRD(GL,3); GAPB(o[1]=__builtin_amdgcn_mfma_f32_32x32x16_bf16(PAF(2),VFR(6),o[1],0,0,0), C1,4); \
    GAPB(o[0]=__builtin_amdgcn_mfma_f32_32x32x16_bf16(PAF(3),VFR(3),o[0],0,0,0), C1,8); \
    GAPB(o[1]=__builtin_amdgcn_mfma_f32_32x32x16_bf16(PAF(3),VFR(7),o[1],0,0,0), C1,12); \
    }while(0)
  int t=1;
  #undef CMASK
  #define CMASK(P0,P1,t) do{}while(0)
  for(;t+5<NT;t+=2){
    STEP(pB0,pB1,pA0,pA1,t,true,true,true);     WAIT_BAR(2); RESC(); ROT();
    STEP(pA0,pA1,pB0,pB1,t+1,true,true,true);   WAIT_BAR(2); RESC(); ROT();
  }
  #undef CMASK
  #define CMASK(P0,P1,t) do{int jb_=(t)-(NT-4); if(jb_>=0)cmask(P0,P1,jb_,qrel,hi);}while(0)
  #define ENDW(tt) do{ if((tt)+3<NT){WAIT_BAR(2);} else if((tt)+2<NT){WAIT_BAR(1);} else {WAIT_BAR(0);} }while(0)
  for(;t+1<NT;t+=2){
    STEP(pB0,pB1,pA0,pA1,t,(t+3<NT),(t+1<NT),(t+1<NT));       ENDW(t);   RESC(); ROT();
    STEP(pA0,pA1,pB0,pB1,t+1,(t+4<NT),(t+2<NT),(t+2<NT));     ENDW(t+1); RESC(); ROT();
  }
  STEP(pB0,pB1,pA0,pA1,NT-1,false,false,false); RESC();
  { float sacc=pB0[0]+pB0[1]; _Pragma("unroll") for(int r=2;r<16;++r)sacc+=pB0[r]; _Pragma("unroll") for(int r=0;r<16;++r)sacc+=pB1[r]; l_reg+=sacc;
    pw0=(u32x4){PKW(pB0,0),PKW(pB0,2),PKW(pB0,4),PKW(pB0,6)};pw1=(u32x4){PKW(pB0,8),PKW(pB0,10),PKW(pB0,12),PKW(pB0,14)};pw2=(u32x4){PKW(pB1,0),PKW(pB1,2),PKW(pB1,4),PKW(pB1,6)};pw3=(u32x4){PKW(pB1,8),PKW(pB1,10),PKW(pB1,12),PKW(pB1,14)};
    SBAR(); pv(o,vb0+sl_cur,PAF(0),PAF(1),PAF(2),PAF(3)); }
  #undef PKW
  #undef PAF
  #undef VFR
  #undef PIN
  #undef MX3
  #undef GAPA
  #undef GAPB
  #undef EX
  #undef VRD
  #undef KRD
  #undef STEP
  #undef ENDW
  {auto rr=__builtin_amdgcn_permlane32_swap(__float_as_uint(l_reg),__float_as_uint(l_reg),false,false);l_reg=__uint_as_float(rr[0])+__uint_as_float(rr[1]);}
  if(hi==0)wsf[32+r32]=l_reg;asm volatile("s_waitcnt lgkmcnt(0)":::"memory");
  float rli[16];
  #pragma unroll
  for(int r=0;r<16;++r)rli[r]=__builtin_amdgcn_rcpf(wsf[32+crow(r,hi)]);
  bf16*Ow=O+(rowbase+q0+wid*QBLK)*DM+oc;
  { bf16*stg=(bf16*)(shm+LDS_OST)+wid*2048;
    #pragma unroll
    for(int r=0;r<16;++r){const int orow=crow(r,hi);
      #pragma unroll
      for(int d0=0;d0<2;++d0)stg[orow*64+d0*32+r32]=__float2bfloat16(o[d0][r]*rli[r]);}
    asm volatile("s_waitcnt lgkmcnt(0)":::"memory");
    #pragma unroll
    for(int i=0;i<4;++i){const int row=i*8+(lane>>3),ch=lane&7; const u32x4 v=*(const u32x4*)(stg+row*64+ch*8); ATTN_STORE16(Ow+(long)row*DM+ch*8,v);} }
  asm volatile("s_waitcnt lgkmcnt(0)\n\ts_barrier":::"memory");
  #undef DMA_K
  #undef DMA_V
  #undef CMASK
  #undef START
  #undef RESC
  #undef ROT
}
constexpr int ATTN_LDS_BYTES=LDS_BYTES;
#undef SBAR
#undef WAIT_BAR
}

namespace attn2 {
using namespace attn_body;
constexpr int NKS=4, SLOTK=8192, NVS=3, SLOTV=16384;
constexpr int A2_K=0, A2_V=NKS*SLOTK, A2_WS=A2_V+NVS*SLOTV, A2_OST=A2_WS+NW*64*4, A2_BYTES=A2_OST+NW*4096;
#define SBAR() __builtin_amdgcn_sched_barrier(0)
#define WAIT_BAR(N) asm volatile("s_waitcnt vmcnt(" #N ") lgkmcnt(0)\n\ts_barrier":::"memory")
typedef __attribute__((address_space(3))) const bf16x8* lds_b8;
typedef float f32x4_t __attribute__((ext_vector_type(4)));
__device__ __forceinline__ bf16x8 KL(lds_cptr p){ return *(lds_b8)p; }
__device__ __forceinline__ void glds16s(const void*sbase,unsigned voff,unsigned lds_dst){unsigned keep;
  asm volatile("s_mov_b32 %0, m0\n\ts_mov_b32 m0, %3\n\ts_nop 0\n\tglobal_load_lds_dwordx4 %1, %2\n\ts_mov_b32 m0, %0":"=&s"(keep):"v"(voff),"s"(sbase),"s"(lds_dst):"memory");}
__device__ __forceinline__ void pv4(f32x16*o,int vb,bf16x8 pa0,bf16x8 pa1,bf16x8 pa2,bf16x8 pa3){
  #pragma unroll
  for(int d0=0;d0<4;++d0){s16x4 lo[4],hi[4];
    #pragma unroll
    for(int ks=0;ks<4;++ks){
      asm volatile("ds_read_b64_tr_b16 %0,%1 offset:%c2":"=&v"(lo[ks]):"v"(vb),"i"(d0*4096+ks*1024):"memory");
      asm volatile("ds_read_b64_tr_b16 %0,%1 offset:%c2":"=&v"(hi[ks]):"v"(vb),"i"(d0*4096+ks*1024+512):"memory");}
    asm volatile("s_waitcnt lgkmcnt(0)":::"memory");SBAR();
    #define PK(k) (bf16x8){lo[k][0],lo[k][1],lo[k][2],lo[k][3],hi[k][0],hi[k][1],hi[k][2],hi[k][3]}
    o[d0]=__builtin_amdgcn_mfma_f32_32x32x16_bf16(pa0,PK(0),o[d0],0,0,0);
    o[d0]=__builtin_amdgcn_mfma_f32_32x32x16_bf16(pa1,PK(1),o[d0],0,0,0);
    o[d0]=__builtin_amdgcn_mfma_f32_32x32x16_bf16(pa2,PK(2),o[d0],0,0,0);
    o[d0]=__builtin_amdgcn_mfma_f32_32x32x16_bf16(pa3,PK(3),o[d0],0,0,0);
    #undef PK
  }
}
template<int THRL,long A_OFF,long SG_OFF> __device__ __forceinline__ void attn_unit(int b,int qc,int kc,int vc,int oc,int qb,const bf16*Q,const bf16*__restrict__ K,const bf16*__restrict__ V,bf16*O,char*shm){
  const int MODE=(oc>>7)&1;
  const int tid=threadIdx.x,lane=tid&63,r32=lane&31,hi=lane>>5; const int wid=__builtin_amdgcn_readfirstlane(tid>>6);
  const long rowbase=(long)b*SEQ; const int q0=qb*QB;
  const bf16*Qw=Q+(rowbase+q0+wid*QBLK)*DM+qc;
  const bf16*Kh=K+rowbase*DM+kc,*Vh=V+rowbase*DM+vc;
  const unsigned lds0=(unsigned)(uintptr_t)shm;
  float*wsf=(float*)(shm+A2_WS)+wid*64;
  const unsigned koff=(unsigned)(lane*DM+wid*8)*2u;
  const unsigned voff=(unsigned)((16*(wid&3)+(lane>>2))*DM+(wid>>2)*32+(lane&3)*8)*2u;
  const unsigned kdst=lds0+A2_K+wid*1024, vdst=lds0+A2_V+wid*1024;
  #define DMA_K(t) glds16s(Kh+(long)(t)*KVBLK*DM,koff,(unsigned)__builtin_amdgcn_readfirstlane(kdst+(((t)&3)*SLOTK)))
  #define DMA_V(t,slot) do{ glds16s(Vh+(long)(t)*KVBLK*DM,voff,(unsigned)__builtin_amdgcn_readfirstlane(vdst+(slot))); glds16s(Vh+(long)(t)*KVBLK*DM+64,voff,(unsigned)__builtin_amdgcn_readfirstlane(vdst+(slot)+8192)); }while(0)
  const char*Kbase=shm+A2_K;
  const lds_cptr shm3=(lds_cptr)shm; const lds_cptr kp0=shm3+A2_K+hi*1024+r32*16; const lds_cptr vp0=shm3+A2_V+((lane>>4)&1)*32+(lane&3)*8+(4*hi+((lane&15)>>2))*64;
  const int NT=(q0+QB)/KVBLK;
  DMA_K(0);DMA_V(0,0);DMA_K(1);
  bf16x8 qr[4];
  #pragma unroll
  for(int d0=0;d0<4;++d0)qr[d0]=*reinterpret_cast<const bf16x8*>(&Qw[(long)r32*DM+d0*16+hi*8]);
  float mhat=0.f,l_reg=0.f;f32x16 o[4];o[0]=f32x16{};o[1]=f32x16{};o[2]=f32x16{};o[3]=f32x16{};f32x16 negm=f32x16{};asm volatile("":"+v"(negm));
  const int qrel=wid*QBLK+r32;
  #define CMASK(P0,P1,t) do{int jb_=(t)-(NT-4); if(jb_>=0)cmask(P0,P1,jb_,qrel,hi);}while(0)
  bool resc=false;
  #define START(P0,P1) do{ const float rm=rowmax(P0,P1); resc=false; \
    { const float dl=rm; mhat=fadd_s(mhat,dl); \
      _Pragma("unroll") for(int r=0;r<16;++r){P0[r]=fsub_s(P0[r],dl);P1[r]=fsub_s(P1[r],dl);} \
      _Pragma("unroll") for(int r=0;r<16;++r)negm[r]=-mhat; asm volatile("":"+v"(negm)); } \
    _Pragma("unroll") for(int r=0;r<16;++r)P0[r]=__builtin_amdgcn_exp2f(P0[r]); }while(0)
  #define RESC() do{ if(resc){ asm volatile("s_waitcnt lgkmcnt(0)":::"memory"); \
      _Pragma("unroll") for(int d_=0;d_<4;++d_) _Pragma("unroll") for(int r=0;r<16;++r)o[d_][r]*=wsf[crow(r,hi)]; } }while(0)
  f32x16 pA0,pA1,pB0,pB1;
  int vs_prev=0,vs_cur=0,vs_next=SLOTV;
  #define ROT() do{vs_prev=vs_cur;vs_cur=vs_next;vs_next=(vs_next==(NVS-1)*SLOTV)?0:vs_next+SLOTV;}while(0)
  DMA_K(2);
  WAIT_BAR(4);
  qkt(pA0,pA1,Kbase,qr,negm,r32,hi);asm volatile("s_nop 15\n\ts_nop 7":"+v"(pA0),"+v"(pA1));CMASK(pA0,pA1,0);
  START(pA0,pA1);
  _Pragma("unroll") for(int r=0;r<16;++r)pA1[r]=__builtin_amdgcn_exp2f(pA1[r]);
  WAIT_BAR(0);
  DMA_K(3);DMA_V(1,SLOTV);
  ROT();
  bf16x8 kn0=KL(kp0+SLOTK),kn1=KL(kp0+SLOTK+512);
  s16x4 vlo[8],vhi[8]; u32x4 pw0,pw1,pw2,pw3;
  #define PKW(P,B) cvtpk_s(P[B],P[B+1])
  #define PAF(k) __builtin_bit_cast(bf16x8,pw##k)
  #define VFR(i) (bf16x8){vlo[i][0],vlo[i][1],vlo[i][2],vlo[i][3],vhi[i][0],vhi[i][1],vhi[i][2],vhi[i][3]}
  #define PIN(x) asm volatile("":"+v"(x))
  #define MX3(a,b,c) __builtin_fmaxf(__builtin_fmaxf((a),(b)),(c))
  #define GAPA(MF,A0,A1,A2,A3,W0,W1,PW) do{ MF; sacc+=A0; sacc+=A1; sacc+=A2; sacc+=A3; PIN(sacc); W0; W1; PIN(PW); SBAR(); }while(0)
  #define EX(v) __builtin_amdgcn_exp2f(v)
  #define GAPB(MF,X,B) do{ MF; X[B]=EX(X[B]); X[B+1]=EX(X[B+1]); PIN(X); SBAR(); }while(0)
  #define GAPB3(MF,X,B) do{ MF; X[B]=EX(X[B]); X[B+1]=EX(X[B+1]); X[B+2]=EX(X[B+2]); PIN(X); SBAR(); }while(0)
  #define GAPB4(MF,X,B) do{ MF; X[B]=EX(X[B]); X[B+1]=EX(X[B+1]); X[B+2]=EX(X[B+2]); X[B+3]=EX(X[B+3]); PIN(X); SBAR(); }while(0)
  #define VRD(i) do{ vlo[i]=vtr(vp_+(((i)>>2)*4096+((i)&3)*1024)); vhi[i]=vtr(vp_+(((i)>>2)*4096+((i)&3)*1024+512)); }while(0)
  #define VRH(i) do{ vlo[i]=vtr(vp_+(8192+((i)>>2)*4096+((i)&3)*1024)); vhi[i]=vtr(vp_+(8192+((i)>>2)*4096+((i)&3)*1024+512)); SBAR(); }while(0)
  #define STEP(C0,C1,P0,P1,t,GK,GV,GL) do{ SBAR(); \
    const lds_cptr vp_=vp0+vs_prev; const lds_cptr kq_=kp0+(((t)&3)*SLOTK); \
    bf16x8 ka0=kn0,ka1=kn1,kb0,kb1; \
    kb0=KL(kq_+2048); kb1=KL(kq_+2560); VRD(0); SBAR(); float sacc=(P0[0]+P0[1]); \
    GAPA(C0=__builtin_amdgcn_mfma_f32_32x32x16_bf16(ka0,qr[0],negm,0,0,0), P0[2],P0[3],P0[4],P0[5],     pw0[0]=PKW(P0,0), pw0[1]=PKW(P0,2), pw0); \
    VRD(4); SBAR(); GAPA(C1=__builtin_amdgcn_mfma_f32_32x32x16_bf16(ka1,qr[0],negm,0,0,0), P0[6],P0[7],P0[8],P0[9],     pw0[2]=PKW(P0,4), pw0[3]=PKW(P0,6), pw0); \
    ka0=KL(kq_+4096); ka1=KL(kq_+4608); VRD(1); SBAR(); GAPA(C0=__builtin_amdgcn_mfma_f32_32x32x16_bf16(kb0,qr[1],C0,0,0,0),   P0[10],P0[11],P0[12],P0[13], pw1[0]=PKW(P0,8), pw1[1]=PKW(P0,10), pw1); \
    VRD(5); SBAR(); GAPA(C1=__builtin_amdgcn_mfma_f32_32x32x16_bf16(kb1,qr[1],C1,0,0,0),   P0[14],P0[15],P1[0],P1[1],   pw1[2]=PKW(P0,12),pw1[3]=PKW(P0,14), pw1); \
    kb0=KL(kq_+6144); kb1=KL(kq_+6656); VRD(2); SBAR(); GAPA(C0=__builtin_amdgcn_mfma_f32_32x32x16_bf16(ka0,qr[2],C0,0,0,0),   P1[2],P1[3],P1[4],P1[5],     pw2[0]=PKW(P1,0), pw2[1]=PKW(P1,2), pw2); \
    VRD(6); SBAR(); GAPA(C1=__builtin_amdgcn_mfma_f32_32x32x16_bf16(ka1,qr[2],C1,0,0,0),   P1[6],P1[7],P1[8],P1[9],     pw2[2]=PKW(P1,4), pw2[3]=PKW(P1,6), pw2); \
    VRD(3); SBAR(); GAPA(C0=__builtin_amdgcn_mfma_f32_32x32x16_bf16(kb0,qr[3],C0,0,0,0),   P1[10],P1[11],P1[12],P1[13], pw3[0]=PKW(P1,8), pw3[1]=PKW(P1,10), pw3); \
    VRD(7); SBAR(); GAPA(C1=__builtin_amdgcn_mfma_f32_32x32x16_bf16(kb1,qr[3],C1,0,0,0),   P1[14],P1[15],0.f,0.f,       pw3[2]=PKW(P1,12),pw3[3]=PKW(P1,14), pw3); \
    l_reg+=sacc; \
    if(GK){DMA_K((t)+3);} if(GV){DMA_V((t)+1,vs_next);} \
    CMASK(C0,C1,t); \
      \
    float mxa,mxb; \
    o[0]=__builtin_amdgcn_mfma_f32_32x32x16_bf16(PAF(0),VFR(0),o[0],0,0,0); \
    mxa=MX3(C0[0],C0[1],C1[0]); mxb=MX3(C0[2],C0[3],C1[1]); mxa=MX3(mxa,C1[2],C1[3]); mxa=MX3(mxa,C0[4],C0[5]); mxb=MX3(mxb,C0[6],C0[7]); mxa=MX3(mxa,C1[4],C1[5]); mxb=MX3(mxb,C1[6],C1[7]); PIN(mxa); PIN(mxb); SBAR(); VRH(0); \
    o[1]=__builtin_amdgcn_mfma_f32_32x32x16_bf16(PAF(0),VFR(4),o[1],0,0,0); \
    mxa=MX3(mxa,C0[8],C0[9]); mxb=MX3(mxb,C0[10],C0[11]); mxa=MX3(mxa,C1[8],C1[9]); mxb=MX3(mxb,C1[10],C1[11]); mxa=MX3(mxa,C0[12],C0[13]); mxb=MX3(mxb,C0[14],C0[15]); mxa=MX3(mxa,C1[12],C1[13]); mxb=MX3(mxb,C1[14],C1[15]); PIN(mxa); PIN(mxb); SBAR(); VRH(4); \
    o[0]=__builtin_amdgcn_mfma_f32_32x32x16_bf16(PAF(1),VFR(1),o[0],0,0,0); \
    { float rm=__builtin_fmaxf(mxa,mxb); { auto rr=__builtin_amdgcn_permlane32_swap(__float_as_uint(rm),__float_as_uint(rm),false,false); rm=__builtin_fmaxf(__uint_as_float(rr[0]),__uint_as_float(rr[1])); } \
      resc=false; \
      if(__builtin_expect(__any(rm>(float)THRL),0)){ const float dl=__builtin_fmaxf(rm,0.f); mhat+=dl; \
        _Pragma("unroll") for(int r=0;r<16;++r){C0[r]-=dl;C1[r]-=dl;} \
        _Pragma("unroll") for(int r=0;r<16;++r)negm[r]=-mhat; asm volatile("":"+v"(negm)); \
        const float f=__builtin_amdgcn_exp2f(-dl); l_reg*=f; if(hi==0)wsf[r32]=f; resc=true; } } \
    SBAR(); VRH(1); \
    GAPB4(o[1]=__builtin_amdgcn_mfma_f32_32x32x16_bf16(PAF(1),VFR(5),o[1],0,0,0), C0,0);  VRH(5); \
    GAPB3(o[0]=__builtin_amdgcn_mfma_f32_32x32x16_bf16(PAF(2),VFR(2),o[0],0,0,0), C0,4);  VRH(2); \
    GAPB3(o[1]=__builtin_amdgcn_mfma_f32_32x32x16_bf16(PAF(2),VFR(6),o[1],0,0,0), C0,7);  VRH(6); \
    GAPB3(o[0]=__builtin_amdgcn_mfma_f32_32x32x16_bf16(PAF(3),VFR(3),o[0],0,0,0), C0,10); VRH(3); \
    GAPB3(o[1]=__builtin_amdgcn_mfma_f32_32x32x16_bf16(PAF(3),VFR(7),o[1],0,0,0), C0,13); VRH(7); \
    GAPB(o[2]=__builtin_amdgcn_mfma_f32_32x32x16_bf16(PAF(0),VFR(0),o[2],0,0,0), C1,0); \
    GAPB(o[3]=__builtin_amdgcn_mfma_f32_32x32x16_bf16(PAF(0),VFR(4),o[3],0,0,0), C1,2); \
    if(GL){ kn0=KL(kp0+((((t)+1)&3)*SLOTK)); kn1=KL(kp0+((((t)+1)&3)*SLOTK)+512); SBAR(); } \
    GAPB(o[2]=__builtin_amdgcn_mfma_f32_32x32x16_bf16(PAF(1),VFR(1),o[2],0,0,0), C1,4); \
    GAPB(o[3]=__builtin_amdgcn_mfma_f32_32x32x16_bf16(PAF(1),VFR(5),o[3],0,0,0), C1,6); \
    GAPB(o[2]=__builtin_amdgcn_mfma_f32_32x32x16_bf16(PAF(2),VFR(2),o[2],0,0,0), C1,8); \
    GAPB(o[3]=__builtin_amdgcn_mfma_f32_32x32x16_bf16(PAF(2),VFR(6),o[3],0,0,0), C1,10); \
    GAPB(o[2]=__builtin_amdgcn_mfma_f32_32x32x16_bf16(PAF(3),VFR(3),o[2],0,0,0), C1,12); \
    GAPB(o[3]=__builtin_amdgcn_mfma_f32_32x32x16_bf16(PAF(3),VFR(7),o[3],0,0,0), C1,14); \
    }while(0)
  int t=1;
  #undef CMASK
  #define CMASK(P0,P1,t) do{}while(0)
  for(;t+5<NT;t+=2){
    STEP(pB0,pB1,pA0,pA1,t,true,true,true);     WAIT_BAR(3); RESC(); ROT();
    STEP(pA0,pA1,pB0,pB1,t+1,true,true,true);   WAIT_BAR(3); RESC(); ROT();
  }
  #undef CMASK
  #define CMASK(P0,P1,t) do{int jb_=(t)-(NT-4); if(jb_>=0)cmask(P0,P1,jb_,qrel,hi);}while(0)
  #define ENDW(tt) do{ if((tt)+3<NT){WAIT_BAR(3);} else if((tt)+2<NT){WAIT_BAR(2);} else {WAIT_BAR(0);} }while(0)
  for(;t+1<NT;t+=2){
    STEP(pB0,pB1,pA0,pA1,t,(t+3<NT),(t+1<NT),(t+1<NT));       ENDW(t);   RESC(); ROT();
    STEP(pA0,pA1,pB0,pB1,t+1,(t+4<NT),(t+2<NT),(t+2<NT));     ENDW(t+1); RESC(); ROT();
  }
  STEP(pB0,pB1,pA0,pA1,NT-1,false,false,false); RESC();
  { float sacc=pB0[0]+pB0[1]; _Pragma("unroll") for(int r=2;r<16;++r)sacc+=pB0[r]; _Pragma("unroll") for(int r=0;r<16;++r)sacc+=pB1[r]; l_reg+=sacc;
    pw0=(u32x4){PKW(pB0,0),PKW(pB0,2),PKW(pB0,4),PKW(pB0,6)};pw1=(u32x4){PKW(pB0,8),PKW(pB0,10),PKW(pB0,12),PKW(pB0,14)};pw2=(u32x4){PKW(pB1,0),PKW(pB1,2),PKW(pB1,4),PKW(pB1,6)};pw3=(u32x4){PKW(pB1,8),PKW(pB1,10),PKW(pB1,12),PKW(pB1,14)};
    SBAR(); pv4(o,(int)(unsigned)(uintptr_t)vp0+vs_cur,PAF(0),PAF(1),PAF(2),PAF(3)); }
  #undef PKW
  #undef PAF
  #undef VFR
  #undef PIN
  #undef MX3
  #undef GAPA
  #undef GAPB
  #undef GAPB3
  #undef GAPB4
  #undef EX
  #undef VRD
  #undef VRH
  #undef STEP
  #undef ENDW
  {auto rr=__builtin_amdgcn_permlane32_swap(__float_as_uint(l_reg),__float_as_uint(l_reg),false,false);l_reg=__uint_as_float(rr[0])+__uint_as_float(rr[1]);}
  if(hi==0)wsf[32+r32]=l_reg;asm volatile("s_waitcnt lgkmcnt(0)":::"memory");
  float rli[16];
  #pragma unroll
  for(int r=0;r<16;++r)rli[r]=__builtin_amdgcn_rcpf(wsf[32+crow(r,hi)]);
  bf16*Ow=O+(rowbase+q0+wid*QBLK)*DM+oc;
  bf16*stg=(bf16*)(shm+A2_OST)+wid*2048;
  if(MODE==0){
    #pragma unroll
    for(int hf=0;hf<2;++hf){
      #pragma unroll
      for(int r=0;r<16;++r){const int orow=crow(r,hi);
        #pragma unroll
        for(int d0=0;d0<2;++d0)stg[orow*64+d0*32+r32]=__float2bfloat16(o[2*hf+d0][r]*rli[r]);}
      asm volatile("s_waitcnt lgkmcnt(0)":::"memory");
      #pragma unroll
      for(int i=0;i<4;++i){const int row=i*8+(lane>>3),ch=lane&7; const u32x4 v=*(const u32x4*)(stg+row*64+ch*8); ATTN_STORE16(Ow+(long)row*DM+hf*64+ch*8,v);}
      asm volatile("s_waitcnt lgkmcnt(0)":::"memory"); }
  } else {
    const bf16*O1w=Ow-128; bf16*Aw=(bf16*)((char*)O+A_OFF)+(rowbase+q0+wid*QBLK)*DM+(oc>>8)*128; const float*subln=(const float*)((const char*)O+SG_OFF); const float lam=subln[128];
    asm volatile("s_waitcnt vmcnt(0)":::"memory");
    float dv[2][4][8]; float ssq[4]={0.f,0.f,0.f,0.f};
    #pragma unroll
    for(int hf=0;hf<2;++hf){
      #pragma unroll
      for(int r=0;r<16;++r){const int orow=crow(r,hi);
        #pragma unroll
        for(int d0=0;d0<2;++d0)stg[orow*64+d0*32+r32]=__float2bfloat16(o[2*hf+d0][r]*rli[r]);}
      asm volatile("s_waitcnt lgkmcnt(0)":::"memory");
      #pragma unroll
      for(int i=0;i<4;++i){const int row=i*8+(lane>>3),ch=lane&7; const u32x4 v=*(const u32x4*)(stg+row*64+ch*8); const u32x4 a=*(const u32x4*)(O1w+(long)row*DM+hf*64+ch*8);
        #pragma unroll
        for(int j=0;j<4;++j){ const float d0_=__uint_as_float(a[j]<<16)-lam*__uint_as_float(v[j]<<16), d1_=__uint_as_float(a[j]&0xffff0000u)-lam*__uint_as_float(v[j]&0xffff0000u);
          dv[hf][i][2*j]=d0_; dv[hf][i][2*j+1]=d1_; ssq[i]+=d0_*d0_+d1_*d1_; } }
      asm volatile("s_waitcnt lgkmcnt(0)":::"memory"); }
    #pragma unroll
    for(int i=0;i<4;++i){ float q_=ssq[i]; q_+=__shfl_xor(q_,1); q_+=__shfl_xor(q_,2); q_+=__shfl_xor(q_,4); ssq[i]=1.0f/sqrtf(q_*(1.f/128.f)+1e-6f); }
    #pragma unroll
    for(int hf=0;hf<2;++hf){ const int ch=lane&7;
      const f32x4_t g0=*(const f32x4_t*)(subln+hf*64+ch*8), g1=*(const f32x4_t*)(subln+hf*64+ch*8+4);
      #pragma unroll
      for(int i=0;i<4;++i){const int row=i*8+(lane>>3); const float r_=ssq[i]; u32x4 w;
        w[0]=cvtpk_s(dv[hf][i][0]*r_*g0[0],dv[hf][i][1]*r_*g0[1]); w[1]=cvtpk_s(dv[hf][i][2]*r_*g0[2],dv[hf][i][3]*r_*g0[3]);
        w[2]=cvtpk_s(dv[hf][i][4]*r_*g1[0],dv[hf][i][5]*r_*g1[1]); w[3]=cvtpk_s(dv[hf][i][6]*r_*g1[2],dv[hf][i][7]*r_*g1[3]);
        ATTN_STORE16(Aw+(long)row*DM+hf*64+ch*8,w);} }
  }
  asm volatile("s_waitcnt lgkmcnt(0)\n\ts_barrier":::"memory");
  #undef DMA_K
  #undef DMA_V
  #undef CMASK
  #undef START
  #undef RESC
  #undef ROT
}
#undef SBAR
#undef WAIT_BAR
}

constexpr int NWAVES = 8;
constexpr int NB = 8, SEQ = 4096, DMODEL = 1024, NTOK = NB * SEQ;
constexpr int DINP = 2048, NEXP = 32, TOPK = 4, PLE = 256;
constexpr float EPS = 1e-6f;
constexpr int PMAXROWS = NTOK * TOPK + NEXP * 256;

constexpr size_t MiB = 1u << 20, KiB = 1u << 10;
constexpr size_t WS_CTL = 0, CTL_ZERO_BYTES = 192 * KiB;
constexpr size_t WS_SS = 64 * KiB;
constexpr size_t WS_TOKE = 192 * KiB, WS_TOKG = WS_TOKE + 512 * KiB, WS_TOKP = WS_TOKG + 512 * KiB;
constexpr size_t WS_WRS = 2304 * KiB;
constexpr size_t WS_SG = 2432 * KiB;
constexpr size_t WS_CS = 4 * MiB;
constexpr size_t WS_WGU = 6 * MiB;
constexpr size_t WS_WD = 70 * MiB;
constexpr size_t WS_WG = 102 * MiB;
constexpr size_t WS_WP = 104 * MiB;
constexpr size_t WS_XN = 105 * MiB;
constexpr size_t WS_R = 169 * MiB;
constexpr size_t WS_QK = WS_R, WS_VU = WS_R + 64 * MiB, WS_ACAT = WS_R + 128 * MiB, WS_O16 = WS_R + 192 * MiB, WS_WIN = WS_R + 256 * MiB, WS_WOUT = WS_R + 260 * MiB;
constexpr size_t WS_HDN = 137 * MiB;
constexpr size_t WS_Y = 273 * MiB;
constexpr size_t WS_XN3 = 137 * MiB, WS_PB = 432 * MiB, WS_ER = 448 * MiB;
constexpr size_t WS_END = WS_Y + 128 * MiB;
constexpr size_t WS_H2B = 169 * MiB;
constexpr size_t WS_TOP = 522 * MiB;
constexpr size_t WS_ELIST = 520 * MiB;
static_assert(WS_END <= WS_PB && WS_ER + 64 * MiB <= 560 * MiB && WS_WOUT + 2 * MiB <= WS_PB && WS_END <= 560 * MiB && WS_WOUT + 2 * MiB <= 560 * MiB && WS_HDN + (size_t)PMAXROWS * 1024 <= WS_Y, "d_ws map");
constexpr int CW_CNT = 0;
constexpr int CW_BAR = 1024;

constexpr int RING_OFF = 0, RING_BYTES = 131072;
constexpr int LDSCTL_OFF = RING_BYTES;
constexpr int TBL_OFF = LDSCTL_OFF + 512;
constexpr int TILE_E_OFF = LDSCTL_OFF + 1024;
constexpr int MAXU = 18;
constexpr int UROW_OFF = LDSCTL_OFF + 2048;
constexpr int UBIAS_OFF = UROW_OFF + MAXU * 512;
constexpr int LDS_BYTES = 163840;
static_assert(UBIAS_OFF + MAXU * 1024 <= LDS_BYTES, "LDS map");

#define GAS __attribute__((address_space(1)))
#define LAS __attribute__((address_space(3)))
typedef unsigned short bf16;
typedef unsigned v4u __attribute__((ext_vector_type(4)));
typedef unsigned v2u __attribute__((ext_vector_type(2)));
typedef float f32x4 __attribute__((ext_vector_type(4)));
typedef float f32x16 __attribute__((ext_vector_type(16)));
#define LDS_WAIT() asm volatile("s_waitcnt lgkmcnt(0)" ::: "memory")
#define VM_WAIT() asm volatile("s_waitcnt vmcnt(0)" ::: "memory")
__device__ __forceinline__ unsigned f2bf(float f) { unsigned u = __builtin_bit_cast(unsigned, f); return (u + 0x7fffu + ((u >> 16) & 1u)) >> 16; }
__device__ __forceinline__ unsigned pk2(float lo, float hi) { return f2bf(lo) | (f2bf(hi) << 16); }
__device__ __forceinline__ float bflo(unsigned w) { return __uint_as_float(w << 16); }
__device__ __forceinline__ float bfhi(unsigned w) { return __uint_as_float(w & 0xffff0000u); }
typedef float f32x2 __attribute__((ext_vector_type(2)));
__device__ __forceinline__ f32x4 fp8x4_to_f32(unsigned w) { const f32x2 lo = __builtin_amdgcn_cvt_pk_f32_fp8((int)w, false), hi = __builtin_amdgcn_cvt_pk_f32_fp8((int)w, true); return (f32x4){lo.x, lo.y, hi.x, hi.y}; }
__device__ __forceinline__ float wave_sum(float v) {
#pragma unroll
    for (int o = 1; o < 64; o <<= 1) v += __shfl_xor(v, o);
    return v;
}


#define XB_TMO      128
#define XB_XCNT(j)  (256  + 64 * (j))
#define XB_XSUB(j)  (1280 + 64 * (j))
#define XB_XGEN(j)  (2304 + 64 * (j))
#define XB_TOP      3328
#define XB_TOPGEN   3392
#define XCD_BAR_WORDS 3456
#define XB_SPIN_CAP (1u << 22)
__device__ __forceinline__ unsigned xb_ld(unsigned* p)              { return __hip_atomic_load(p, __ATOMIC_RELAXED, __HIP_MEMORY_SCOPE_AGENT); }
__device__ __forceinline__ unsigned xb_add(unsigned* p, unsigned v) { return __hip_atomic_fetch_add(p, v, __ATOMIC_RELAXED, __HIP_MEMORY_SCOPE_AGENT); }
__device__ __forceinline__ unsigned xb_xcc_id() { return (unsigned)__builtin_amdgcn_s_getreg((3 << 11) | 20) & 0xFu; }
#define XB_SPIN(cond, bar) do { unsigned _sp = 0; while (cond) { __builtin_amdgcn_s_sleep(1); \
    if ((++_sp & 255u) == 0u) { if (xb_ld(&(bar)[XB_TMO])) break; if (_sp > XB_SPIN_CAP) { atomicAdd(&(bar)[XB_TMO], 1u); break; } } } } while (0)
struct XcdBarrier { unsigned* bar; unsigned x; volatile LAS unsigned* st; };
__device__ __forceinline__ XcdBarrier xcd_barrier_post(unsigned* bar, volatile LAS unsigned* st) {
    XcdBarrier b; b.bar = bar; b.x = xb_xcc_id(); b.st = st;
    if (threadIdx.x == 0) (void)xb_add(&bar[XB_XCNT(b.x)], 1u);
    return b;
}
__device__ __forceinline__ void xcd_barrier_complete(unsigned* bar, unsigned x, unsigned& nloc, unsigned& nx) {
    const unsigned G = gridDim.x * gridDim.y * gridDim.z;
    unsigned sum, cnt, mine, sp = 0u;
    for (;;) {
        sum = 0u; cnt = 0u; mine = 0u;
#pragma unroll
        for (unsigned j = 0; j < 16; ++j) { const unsigned c = xb_ld(&bar[XB_XCNT(j)]); sum += c; cnt += (c > 0u) ? 1u : 0u; mine = (j == x) ? c : mine; }
        if (sum == G) break;
        __builtin_amdgcn_s_sleep(1);
        if ((++sp & 255u) == 0u) { if (xb_ld(&bar[XB_TMO])) break; if (sp > XB_SPIN_CAP) { atomicAdd(&bar[XB_TMO], 1u); break; } }
    }
    nloc = mine > 0u ? mine : 1u; nx = cnt > 0u ? cnt : 1u;
}
__device__ __forceinline__ void xcd_barrier(const XcdBarrier& b) {
    asm volatile("s_waitcnt vmcnt(0)" ::: "memory");
    __syncthreads();
    if (threadIdx.x == 0) {
        unsigned* bar = b.bar;
        __builtin_amdgcn_s_waitcnt(0);
        unsigned nloc = b.st[0], nx = b.st[1];
        if (nloc == 0u) { xcd_barrier_complete(bar, b.x, nloc, nx); b.st[0] = nloc; b.st[1] = nx; }
        const unsigned old = xb_add(&bar[XB_XSUB(b.x)], 1u);
        const unsigned gen = old / nloc;
        if (old + 1u == (gen + 1u) * nloc) {
            __builtin_amdgcn_fence(__ATOMIC_RELEASE, "agent");
            asm volatile("s_waitcnt vmcnt(0)" ::: "memory");
            const unsigned og = xb_add(&bar[XB_TOP], 1u);
            const unsigned tg = og / nx;
            if (og + 1u == (tg + 1u) * nx) xb_add(&bar[XB_TOPGEN], 1u);
            else XB_SPIN(xb_ld(&bar[XB_TOPGEN]) == tg, bar);
            __builtin_amdgcn_fence(__ATOMIC_ACQUIRE, "agent");
            xb_add(&bar[XB_XGEN(b.x)], 1u);
            asm volatile("s_waitcnt vmcnt(0)" ::: "memory");
        } else {
            XB_SPIN(xb_ld(&bar[XB_XGEN(b.x)]) == gen, bar);
            __builtin_amdgcn_fence(__ATOMIC_ACQUIRE, "agent");
            asm volatile("s_waitcnt vmcnt(0)" ::: "memory");
        }
    }
    __syncthreads();
}

struct Args { const float* in[28]; float* out; unsigned char* ws; };
enum { I_X = 0, I_P, I_POS, I_ATTN_NORM, I_WIN, I_QNORM, I_KNORM, I_LQ1, I_LK1, I_LQ2, I_LK2, I_SUBLN, I_WPOOL, I_PSCALE, I_WOUT, I_FFN_NORM, I_WROUTER, I_BROUTER,
       I_WGATE, I_BGATE, I_WUP, I_BUP, I_WDOWN, I_BDOWN, I_PLE_GNORM, I_WPLE_GATE, I_WPLE_PROJ, I_PLE_PNORM };

__device__ __forceinline__ void tr_load(const float* W, int ldw, int k0, int n0, LAS float* scr, int lane) {
    float t[32];
#pragma unroll
    for (int i = 0; i < 32; ++i) t[i] = __builtin_nontemporal_load(W + (size_t)(k0 + 2 * i + (lane >> 5)) * ldw + n0 + (lane & 31));
#pragma unroll
    for (int i = 0; i < 32; ++i) scr[(2 * i + (lane >> 5)) * 33 + (lane & 31)] = t[i];
    LDS_WAIT(); asm volatile("" ::: "memory");
}
__device__ __forceinline__ void tr_item(const float* W, int ldw, int k0, int n0, bf16* WT, int ldt, int drow0, int dcol0, LAS float* scr, int lane) {
    tr_load(W, ldw, k0, n0, scr, lane);
    const int c = lane & 7;
#pragma unroll
    for (int j = 0; j < 4; ++j) { const int n = (lane >> 3) + 8 * j; const LAS float* s = scr + (8 * c) * 33 + n;
        v4u o; o.x = pk2(s[0 * 33], s[1 * 33]); o.y = pk2(s[2 * 33], s[3 * 33]); o.z = pk2(s[4 * 33], s[5 * 33]); o.w = pk2(s[6 * 33], s[7 * 33]);
        *(GAS v4u*)(WT + (size_t)(drow0 + n) * ldt + dcol0 + k0 + 8 * c) = o; }
    LDS_WAIT(); asm volatile("" ::: "memory");
}
__device__ __forceinline__ void tr_item8(const float* W, int ldw, int k0, int n0, unsigned char* WT, int ldt, int drow0, float sc, LAS float* scr, int lane) {
    tr_load(W, ldw, k0, n0, scr, lane);
    const int c = lane & 7;
#pragma unroll
    for (int j = 0; j < 4; ++j) { const int n = (lane >> 3) + 8 * j; const LAS float* s = scr + (8 * c) * 33 + n;
        v2u o; o.x = pg8::pk4_fp8(s[0 * 33] * sc, s[1 * 33] * sc, s[2 * 33] * sc, s[3 * 33] * sc); o.y = pg8::pk4_fp8(s[4 * 33] * sc, s[5 * 33] * sc, s[6 * 33] * sc, s[7 * 33] * sc);
        *(GAS v2u*)(WT + (size_t)(drow0 + n) * ldt + k0 + 8 * c) = o; }
    LDS_WAIT(); asm volatile("" ::: "memory");
}

struct MoeOrder {
    const LAS int* tbl;
    const LAS unsigned char* te;
    int tile0, ntile, npn, G, vc; bool gu;
    __device__ __forceinline__ bool next(int i, pg8::Unit& u) const {
        const int U = i * G + vc; if (U >= ntile * npn) return false;
        const int tl = U / npn, pn = U - tl * npn, tau = tile0 + tl;
        const int e = (int)te[tau];
        const int tloc = tau - tbl[32 + e];
        u.e = e; u.pn = pn; u.tb = e * npn + pn; u.ord = i;
        if (gu) { u.ta = tau; u.pm = tau; u.nv = 256; }
        else { u.ta = tau; u.pm = tbl[65 + e] + tloc * 256; const int rem = tbl[e] - tloc * 256; u.nv = rem < 256 ? rem : 256; }
        return true;
    }
};

__global__ void __launch_bounds__(NWAVES * 64, 2) mk_fwd(Args args) {
    extern __shared__ __attribute__((aligned(16))) unsigned char lds[];
    cg::grid_group grid = cg::this_grid();
    LAS unsigned char* L = (LAS unsigned char*)lds;
    const int wave = __builtin_amdgcn_readfirstlane(threadIdx.x >> 6);
    const int G = gridDim.x;
    const int vcu = (G % 8 == 0) ? ((int)blockIdx.x % 8) * (G / 8) + (int)blockIdx.x / 8 : (int)blockIdx.x;
    const int gw = vcu * NWAVES + wave, NGW = G * NWAVES;
    unsigned char* ws = args.ws;
    unsigned* ctl = (unsigned*)(ws + WS_CTL);
    float* out = args.out;
    LAS int* tbl = (LAS int*)(L + TBL_OFF);
    LAS unsigned char* tile_e = (LAS unsigned char*)(L + TILE_E_OFF);
    volatile LAS unsigned* MISC = (volatile LAS unsigned*)(L + LDSCTL_OFF);
    if (threadIdx.x < 64) MISC[threadIdx.x] = 0u;
    __syncthreads();
    XcdBarrier xbar = xcd_barrier_post(ctl + CW_BAR, MISC + 8);
#define GRID_BAR() do { xcd_barrier(xbar); } while (0)

    {
        const int tid = pg8::tid_opaque(), lane = tid & 63;
        LAS float* scr = (LAS float*)(L + RING_OFF + wave * 16384);
        constexpr int IT_WIN = 16 * 64, IT_WOUT = 8 * 32, IT_EXP = 512, IT_WG = 512, IT_WP = 4 * 32;
        constexpr int NITEMS = IT_WIN + IT_WOUT + NEXP * 3 * IT_EXP + IT_WG + IT_WP;
        for (int it = gw; it < NITEMS; it += NGW) {
            int r = it;
            if (r < IT_WIN) { const int kb = r / 64, nb = r % 64; tr_item(args.in[I_WIN], DINP, 64 * kb, 32 * nb, (bf16*)(ws + WS_WIN), 1024, 32 * nb, 0, scr, lane); continue; } r -= IT_WIN;
            if (r < IT_WOUT) { const int kb = r / 32, nb = r % 32; tr_item(args.in[I_WOUT], 1024, 64 * kb, 32 * nb, (bf16*)(ws + WS_WOUT), 1024, 32 * nb, 0, scr, lane); continue; } r -= IT_WOUT;
            if (r < NEXP * 3 * IT_EXP) {
                const int e = r / (3 * IT_EXP), rr = r % (3 * IT_EXP), mat = rr / IT_EXP, q = rr % IT_EXP, kb = q / 32, nb = q % 32, n0 = 32 * nb;
                if (mat == 2) tr_item8(args.in[I_WDOWN] + (size_t)e * 1024 * 1024, 1024, 64 * kb, n0, ws + WS_WD, 1024, e * 1024 + n0, 32.0f, scr, lane);
                else tr_item8(args.in[mat == 0 ? I_WGATE : I_WUP] + (size_t)e * 1024 * 1024, 1024, 64 * kb, n0, ws + WS_WGU, 1024, e * 2048 + (n0 >> 7) * 256 + mat * 128 + (n0 & 127), 32.0f, scr, lane);
                continue; } r -= NEXP * 3 * IT_EXP;
            if (r < IT_WG) { const int kb = r / 32, nb = r % 32; tr_item8(args.in[I_WPLE_GATE], 1024, 64 * kb, 32 * nb, ws + WS_WG, 1024, 32 * nb, 32.0f, scr, lane); continue; } r -= IT_WG;
            { const int kb = r / 32, nb = r % 32; tr_item(args.in[I_WPLE_PROJ], 1024, 64 * kb, 32 * nb, (bf16*)(ws + WS_WP), 256, 32 * nb, 0, scr, lane); }
        }
        {
            const float* wpool = args.in[I_WPOOL]; const float* ps = args.in[I_PSCALE]; const float* wout = args.in[I_WOUT]; bf16* WT = (bf16*)(ws + WS_WOUT);
            for (int tile = wave * G + vcu; tile < 16 * 32; tile += NWAVES * G) {
                const int gc0 = (tile >> 5) * 32, n0 = (tile & 31) * 32, g = gc0 >> 7, hf = lane >> 5, li = lane & 31;
                const float* ap = wpool + (size_t)(gc0 + li) * 128 + 64 * hf; const float* pp = ps + g * 128 + 64 * hf;
                const float* bp = wout + (size_t)(512 + g * 128 + 64 * hf) * 1024 + n0 + li;
                f32x16 acc = f32x16{};
#pragma unroll 8
                for (int q = 0; q < 16; ++q) {
                    const f32x4 a4 = *(const GAS f32x4*)(ap + 4 * q), p4 = *(const GAS f32x4*)(pp + 4 * q);
                    const float b0 = bp[(size_t)(4 * q + 0) * 1024], b1 = bp[(size_t)(4 * q + 1) * 1024], b2 = bp[(size_t)(4 * q + 2) * 1024], b3 = bp[(size_t)(4 * q + 3) * 1024];
                    acc = __builtin_amdgcn_mfma_f32_32x32x2f32(a4.x * p4.x, b0, acc, 0, 0, 0);
                    acc = __builtin_amdgcn_mfma_f32_32x32x2f32(a4.y * p4.y, b1, acc, 0, 0, 0);
                    acc = __builtin_amdgcn_mfma_f32_32x32x2f32(a4.z * p4.z, b2, acc, 0, 0, 0);
                    acc = __builtin_amdgcn_mfma_f32_32x32x2f32(a4.w * p4.w, b3, acc, 0, 0, 0);
                }
#pragma unroll
                for (int r4 = 0; r4 < 4; ++r4) { v2u w; w.x = pk2(acc[4 * r4], acc[4 * r4 + 1]); w.y = pk2(acc[4 * r4 + 2], acc[4 * r4 + 3]);
                    *(GAS v2u*)(WT + (size_t)(n0 + li) * 1024 + 512 + gc0 + 8 * r4 + 4 * hf) = w; }
            }
        }
        if (gw == 0) { float* SG = (float*)(ws + WS_SG); SG[lane] = args.in[I_SUBLN][lane] * 0.8f; SG[64 + lane] = args.in[I_SUBLN][64 + lane] * 0.8f;
            const float s1 = wave_sum(args.in[I_LQ1][lane] * args.in[I_LK1][lane]), s2 = wave_sum(args.in[I_LQ2][lane] * args.in[I_LK2][lane]); if (lane == 0) SG[128] = expf(s1) - expf(s2) + 0.2f; }
        { const float* wr = args.in[I_WROUTER]; const float* fn = args.in[I_FFN_NORM]; bf16* WRh = (bf16*)(ws + WS_WRS); bf16* WRl = WRh + 32 * 1024;
          for (int idx = blockIdx.x * 512 + tid; idx < 1024 * 32; idx += G * 512) {
              const int j = idx & 7, e = (idx >> 3) & 31, hf_ = (idx >> 8) & 1, q = (idx >> 9) & 31, kh_ = idx >> 14, k = 512 * kh_ + 16 * q + 8 * hf_ + j; const float v = wr[k * 32 + e] * fn[k];
              const unsigned h = f2bf(v); WRh[idx] = (bf16)h; WRl[idx] = (bf16)f2bf(v - __uint_as_float(h << 16)); } }
        { const int* pos = (const int*)args.in[I_POS]; float* cs = (float*)(ws + WS_CS);
          for (int idx = blockIdx.x * 512 + tid; idx < NTOK * 8; idx += G * 512) {
              const int t = idx >> 3, i = idx & 7;
              const float fr = i == 0 ? 1.0f : i == 1 ? 0.1939227432012558f : i == 2 ? 0.03760603070259094f : i == 3 ? 0.007292664609849453f : i == 4 ? 0.0014142135623842478f :
                               i == 5 ? 0.00027424818836152554f : i == 6 ? 5.318296098266728e-05f : 1.0313386155758053e-05f;
              const float ang = (float)pos[t] * fr;
              const double a = (double)ang, k = __builtin_rint(a * 0.15915494309189535), rr = a - k * 6.283185307179586;
              const float rf = (float)rr;
              cs[t * 16 + i] = cosf(rf); cs[t * 16 + 8 + i] = sinf(rf);
          } }
        { const float* x = args.in[I_X]; const float* gn = args.in[I_ATTN_NORM]; bf16* XN = (bf16*)(ws + WS_XN);
          f32x4 gg[4];
#pragma unroll
          for (int j = 0; j < 4; ++j) gg[j] = *((const GAS f32x4*)gn + lane + 64 * j);
          for (int m0 = gw; m0 < NTOK; m0 += 2 * NGW) {
              f32x4 v[2][4]; float s[2] = {0.f, 0.f};
#pragma unroll
              for (int u = 0; u < 2; ++u) { const int m = (m0 + u * NGW < NTOK) ? m0 + u * NGW : m0; const GAS f32x4* xr = (const GAS f32x4*)(x + (size_t)m * 1024) + lane;
#pragma unroll
                  for (int j = 0; j < 4; ++j) v[u][j] = xr[64 * j]; }
#pragma unroll
              for (int u = 0; u < 2; ++u) {
#pragma unroll
                  for (int j = 0; j < 4; ++j) s[u] += (v[u][j].x * v[u][j].x + v[u][j].y * v[u][j].y) + (v[u][j].z * v[u][j].z + v[u][j].w * v[u][j].w); }
#pragma unroll
              for (int u = 0; u < 2; ++u) { const int m = m0 + u * NGW; if (m < NTOK) {
                  const float r = 1.0f / sqrtf(wave_sum(s[u]) * (1.f / 1024.f) + EPS);
                  GAS unsigned long long* o8 = (GAS unsigned long long*)(XN + (size_t)m * 1024) + lane;
#pragma unroll
                  for (int j = 0; j < 4; ++j) o8[64 * j] = (unsigned long long)pk2(v[u][j].x * r * gg[j].x, v[u][j].y * r * gg[j].y) | ((unsigned long long)pk2(v[u][j].z * r * gg[j].z, v[u][j].w * r * gg[j].w) << 32); } }
          } }
        { const int tid = pg8::tid_opaque();
        const float* p = args.in[I_P]; bf16* PB = (bf16*)(ws + WS_PB);
        for (size_t idx = (size_t)blockIdx.x * 512 + tid; idx < (size_t)NTOK * PLE / 4; idx += (size_t)G * 512) {
            const f32x4 a = *((const GAS f32x4*)p + idx); v2u w; w.x = pk2(a.x, a.y); w.y = pk2(a.z, a.w); *((GAS v2u*)PB + idx) = w; }
        }
    }
    grid.sync();


    {
        pg8::Gemm g{(const pg8::bf16_t*)(ws + WS_XN), (const pg8::bf16_t*)(ws + WS_WIN), 1024, nullptr}; pg8::StaticOrder S; S.init(NTOK, DINP, G, (int)blockIdx.x);
        pg8::EpiQKVU E{(pg8::bf16_t*)(ws + WS_QK), (pg8::bf16_t*)(ws + WS_VU), (const float*)(ws + WS_CS), args.in[I_QNORM], args.in[I_KNORM], attn_body::C2};
        pg8::gemm_phase<pg8::EpiQKVU, pg8::StaticOrder, false, true, false, true>(L + RING_OFF, g, S, E);
    }
    {
        pg8::Gemm g{(const pg8::bf16_t*)(ws + WS_PB), (const pg8::bf16_t*)(ws + WS_WP), 256, nullptr}; pg8::StaticOrder S; S.init(NTOK, 1024, G, (int)blockIdx.x);
        pg8::EpiBf16 E{(pg8::bf16_t*)(ws + WS_ER), 1024, nullptr, 0, 0, (float*)(ws + WS_SS)};
        pg8::gemm_phase<pg8::EpiBf16, pg8::StaticOrder, false, true>(L + RING_OFF, g, S, E);
    }
    GRID_BAR();

    {
        const int tid = pg8::tid_opaque(), lane = tid & 63;
        const bf16* VU = (const bf16*)(ws + WS_VU); bf16* ACAT = (bf16*)(ws + WS_ACAT);
        const int grp = lane >> 4, w = 2 << grp;
        for (int chunk = gw; chunk < NTOK / 16; chunk += NGW) {
            const int m0 = chunk * 16, t0 = m0 & (SEQ - 1);
            v4u rows[31];
#pragma unroll
            for (int k = 0; k < 15; ++k) { rows[k] = (v4u){0u, 0u, 0u, 0u}; if (15 - k < w && t0 > 0) rows[k] = *(const GAS v4u*)(VU + (size_t)(m0 + k - 15) * 1024 + 512 + lane * 8); }
#pragma unroll
            for (int k = 15; k < 31; ++k) rows[k] = *(const GAS v4u*)(VU + (size_t)(m0 + k - 15) * 1024 + 512 + lane * 8);
#pragma unroll
            for (int j = 0; j < 16; ++j) {
                float a2[8], a4[8], a8[8], a16[8], u0[8];
#pragma unroll
                for (int i = 0; i < 8; ++i) { a2[i] = 0.f; }
#pragma unroll
                for (int d = 0; d < 16; ++d) { const v4u r = rows[15 + j - d];
                    const float f[8] = {bflo(r.x), bfhi(r.x), bflo(r.y), bfhi(r.y), bflo(r.z), bfhi(r.z), bflo(r.w), bfhi(r.w)};
#pragma unroll
                    for (int i = 0; i < 8; ++i) { if (d == 0) u0[i] = f[i]; a2[i] += f[i]; if (d == 1) a4[i] = a2[i]; if (d == 3) a8[i] = a2[i]; if (d == 7) a16[i] = a2[i]; } }
                const int t = t0 + j, cnt = (t + 1 < w) ? t + 1 : w; const float ic = 1.0f / (float)cnt;
                float pz[8];
#pragma unroll
                for (int i = 0; i < 8; ++i) { const float sel = grp == 0 ? a4[i] : grp == 1 ? a8[i] : grp == 2 ? a16[i] : a2[i]; pz[i] = sel * ic - u0[i]; }
                v4u op; op.x = pk2(pz[0], pz[1]); op.y = pk2(pz[2], pz[3]); op.z = pk2(pz[4], pz[5]); op.w = pk2(pz[6], pz[7]);
                *(GAS v4u*)(ACAT + (size_t)(m0 + j) * 1024 + 512 + lane * 8) = op;
            }
        }
    }
    GRID_BAR();

    {
        const attn_body::bf16* Q = (const attn_body::bf16*)(ws + WS_QK); const attn_body::bf16* V = (const attn_body::bf16*)(ws + WS_VU); attn_body::bf16* O = (attn_body::bf16*)(ws + WS_O16);
        constexpr int NUNITS = NB * 8 * attn_body::NQB;
        const int per = (NUNITS + G - 1) / G;
        for (int u = 0; u < per; ++u) {
            int bh, qb;
            if (G == 256) { bh = vcu >> 3; const int s = vcu & 7; qb = (u < 2) ? s : 15 - s; }
            else { const int P = (u >> 1) * G + vcu; if (P >= NUNITS / 2) break; bh = P & 31; qb = 15 - (P >> 5); }
            const int hc = 2 * (bh & 3) + (u & 1);
            attn2::attn_unit<8, (long)WS_ACAT - (long)WS_O16, (long)WS_SG - (long)WS_O16>(bh >> 2, hc * 64, 512 + hc * 64, (hc >> 1) * 128, hc * 128, qb, Q, Q, V, O, (char*)lds + RING_OFF);
        }
    }
    GRID_BAR();

    {
        pg8::Gemm g{(const pg8::bf16_t*)(ws + WS_ACAT), (const pg8::bf16_t*)(ws + WS_WOUT), 1024, nullptr}; pg8::StaticOrder S; S.init(NTOK, 1024, G, (int)blockIdx.x);
        pg8::EpiResBf16 E{args.in[I_X], (pg8::bf16_t*)out};
        pg8::gemm_phase<pg8::EpiResBf16, pg8::StaticOrder, false, true>(L + RING_OFF, g, S, E);
    }
    GRID_BAR();

    {
        const int tid = pg8::tid_opaque(), lane = tid & 63;
        LAS float* r1s = (LAS float*)(L + RING_OFF);
        LAS int* cntl = (LAS int*)(L + RING_OFF + 512);
        LAS int* basel = (LAS int*)(L + RING_OFF + 640);
        LAS float* Pl = (LAS float*)(L + RING_OFF + 1024);
        const float* fn = args.in[I_FFN_NORM]; const bf16* WRh = (const bf16*)(ws + WS_WRS); const bf16* WRl = WRh + 32 * 1024; unsigned char* XN8 = ws + WS_XN; const bf16* H1B = (const bf16*)out;
        int* toke = (int*)(ws + WS_TOKE); float* tokg = (float*)(ws + WS_TOKG); int* tokp = (int*)(ws + WS_TOKP); unsigned short* elist = (unsigned short*)(ws + WS_ELIST);
        if (tid < 32) cntl[tid] = 0;
        __syncthreads();
        for (int chunk = blockIdx.x; chunk < NTOK / 128; chunk += G) {
            const int tok0 = chunk * 128;
            for (int j0 = 0; j0 < 16; j0 += 4) {
                f32x4 v[4][4];
#pragma unroll
                for (int u = 0; u < 4; ++u) { const GAS v2u* xr = (const GAS v2u*)(H1B + (size_t)(tok0 + wave * 16 + j0 + u) * 1024) + lane;
#pragma unroll
                    for (int q = 0; q < 4; ++q) { const v2u w_ = xr[64 * q]; v[u][q] = (f32x4){bflo(w_.x), bfhi(w_.x), bflo(w_.y), bfhi(w_.y)}; } }
#pragma unroll
                for (int u = 0; u < 4; ++u) { const int m = tok0 + wave * 16 + j0 + u; float s = 0.f;
#pragma unroll
                    for (int q = 0; q < 4; ++q) s += (v[u][q].x * v[u][q].x + v[u][q].y * v[u][q].y) + (v[u][q].z * v[u][q].z + v[u][q].w * v[u][q].w);
                    const float r = 1.0f / sqrtf(wave_sum(s) * (1.f / 1024.f) + EPS);
                    GAS unsigned* o4 = (GAS unsigned*)(XN8 + (size_t)m * 1024) + lane;
#pragma unroll
                    for (int q = 0; q < 4; ++q) { const f32x4 gg = *((const GAS f32x4*)fn + lane + 64 * q);
                        o4[64 * q] = pg8::pk4_fp8(v[u][q].x * r * gg.x, v[u][q].y * r * gg.y, v[u][q].z * r * gg.z, v[u][q].w * r * gg.w); }
                    if (lane == 0) r1s[wave * 16 + j0 + u] = r; }
            }
            {
                const int g = wave & 3, kh = wave >> 2, hf = lane >> 5, li = lane & 31;
                LAS unsigned char* tile = L + RING_OFF + 36864 + wave * 8704;
                const bf16* ablk = H1B + (size_t)(tok0 + 32 * g + (lane >> 4)) * 1024 + kh * 512 + 8 * (lane & 15);
                const bf16* bh = WRh + (size_t)(kh * 32) * 512 + lane * 8; const bf16* bl = WRl + (size_t)(kh * 32) * 512 + lane * 8;
                f32x16 acc = f32x16{};
                v4u R[8];
#pragma unroll
                for (int i = 0; i < 8; ++i) R[i] = *(const GAS v4u*)(ablk + (size_t)(4 * i) * 1024);
                for (int b = 0; b < 4; ++b) {
#pragma unroll
                    for (int i = 0; i < 8; ++i) *(LAS v4u*)(tile + (4 * i + (lane >> 4)) * 272 + 16 * (lane & 15)) = R[i];
                    pg8::bf16x8 wh[8], wl[8];
#pragma unroll
                    for (int s_ = 0; s_ < 8; ++s_) { wh[s_] = *(const GAS pg8::bf16x8*)(bh + (size_t)(8 * b + s_) * 512); wl[s_] = *(const GAS pg8::bf16x8*)(bl + (size_t)(8 * b + s_) * 512); }
                    if (b < 3) {
#pragma unroll
                        for (int i = 0; i < 8; ++i) R[i] = *(const GAS v4u*)(ablk + (size_t)(4 * i) * 1024 + 128 * (b + 1)); }
#pragma unroll
                    for (int s_ = 0; s_ < 8; ++s_) {
                        const pg8::bf16x8 ah = *(const LAS pg8::bf16x8*)(tile + li * 272 + 32 * s_ + 16 * hf);
                        acc = __builtin_amdgcn_mfma_f32_32x32x16_bf16(ah, wl[s_], acc, 0, 0, 0);
                        acc = __builtin_amdgcn_mfma_f32_32x32x16_bf16(ah, wh[s_], acc, 0, 0, 0);
                    }
                }
                LAS float* Pw = Pl + (size_t)((kh * 4 + g) * 32) * 33;
#pragma unroll
                for (int r = 0; r < 16; ++r) Pw[((r & 3) + 8 * (r >> 2) + 4 * hf) * 33 + li] = acc[r];
            }
            __syncthreads();
            int ek[4] = {0, 0, 0, 0}, rk[4] = {0, 0, 0, 0};
            if (tid < 128) {
                const int g = tid >> 5, i = tid & 31; const float r1 = r1s[tid];
                const LAS float* p0 = Pl + (size_t)((0 * 4 + g) * 32 + i) * 33; const LAS float* p1 = Pl + (size_t)((1 * 4 + g) * 32 + i) * 33;
                float v[32];
#pragma unroll
                for (int e = 0; e < 32; ++e) v[e] = (p0[e] + p1[e]) * r1 + args.in[I_BROUTER][e];
                float tv[4];
#pragma unroll
                for (int k = 0; k < 4; ++k) {
                    float best = v[0]; int bi = 0;
#pragma unroll
                    for (int e = 1; e < 32; ++e) { if (v[e] > best) { best = v[e]; bi = e; } }
                    tv[k] = best; ek[k] = bi;
#pragma unroll
                    for (int e = 0; e < 32; ++e) v[e] = (e == bi) ? -INFINITY : v[e];
                }
                const float e1 = expf(tv[1] - tv[0]), e2 = expf(tv[2] - tv[0]), e3 = expf(tv[3] - tv[0]); const float inv = 1.0f / (1.0f + e1 + e2 + e3);
                const float gt[4] = {inv, e1 * inv, e2 * inv, e3 * inv};
#pragma unroll
                for (int k = 0; k < 4; ++k) { rk[k] = atomicAdd((int*)(cntl + ek[k]), 1); toke[(size_t)(tok0 + tid) * 4 + k] = ek[k]; tokg[(size_t)(tok0 + tid) * 4 + k] = gt[k]; }
            }
            __syncthreads();
            if (tid < 32) { basel[tid] = atomicAdd((int*)ctl + CW_CNT + tid, cntl[tid]); cntl[tid] = 0; }
            __syncthreads();
            if (tid < 128) {
#pragma unroll
                for (int k = 0; k < 4; ++k) { const int rank = basel[ek[k]] + rk[k]; tokp[(size_t)(tok0 + tid) * 4 + k] = rank; elist[(size_t)ek[k] * NTOK + rank] = (unsigned short)(tok0 + tid); }
            }
            __syncthreads();
        }
    }
    GRID_BAR();

    {
        const int tid = pg8::tid_opaque();
        if (tid == 0) {
            int pt = 0, cr = 0;
            for (int e = 0; e < NEXP; ++e) { const int c = (int)__hip_atomic_load(ctl + CW_CNT + e, __ATOMIC_RELAXED, __HIP_MEMORY_SCOPE_AGENT); tbl[e] = c; tbl[32 + e] = pt; tbl[65 + e] = cr; pt += (c + 255) >> 8; cr += c; }
            tbl[64] = pt; tbl[97] = cr;
        }
        __syncthreads();
        for (int t = tid; t < 576; t += 512) { int e = 0;
            for (int j = 1; j < NEXP; ++j) e += (tbl[32 + j] <= t) ? 1 : 0;
            tile_e[t] = (unsigned char)e; }
        __syncthreads();
    }


    {
        const int T = tbl[64];
        LAS unsigned short* urow = (LAS unsigned short*)(L + UROW_OFF); LAS float* ubias = (LAS float*)(L + UBIAS_OFF);
        {
            MoeOrder S{tbl, tile_e, 0, T, 8, G, vcu, true};
            {
                const int tid = pg8::tid_opaque(); pg8::Unit u; const unsigned short* elist = (const unsigned short*)(ws + WS_ELIST);
                for (int i = 0; i < MAXU && S.next(i, u); ++i) {
                    if (tid < 256) { const int r = (u.ta - tbl[32 + u.e]) * 256 + tid; urow[i * 256 + tid] = (r < tbl[u.e]) ? elist[(size_t)u.e * NTOK + r] : (unsigned short)0; }
                    else { const int j = tid - 256; ubias[i * 256 + j] = (j < 128 ? args.in[I_BGATE] : args.in[I_BUP])[u.e * 1024 + u.pn * 128 + (j & 127)]; } }
                __syncthreads();
            }
            pg8::Gemm g{(const pg8::bf16_t*)(ws + WS_XN), (const pg8::bf16_t*)(ws + WS_WGU), 512, urow};
            pg8::EpiSwiglu E{ws + WS_HDN, ubias};
            pg8::gemm_phase<pg8::EpiSwiglu, MoeOrder, true, true, true>(L + RING_OFF, g, S, E);
        }
        GRID_BAR();
        {
            MoeOrder S{tbl, tile_e, 0, T, 4, G, vcu, false};
            {   const int tid = pg8::tid_opaque(); pg8::Unit u;
                for (int i = 0; i < MAXU && S.next(i, u); ++i) { if (tid < 256) ubias[i * 256 + tid] = args.in[I_BDOWN][u.e * 1024 + u.pn * 256 + tid]; }
                __syncthreads();
            }
            pg8::Gemm g{(const pg8::bf16_t*)(ws + WS_HDN), (const pg8::bf16_t*)(ws + WS_WD), 512, nullptr};
            pg8::EpiDown E{ws + WS_Y, ubias};
            pg8::gemm_phase<pg8::EpiDown, MoeOrder, false, true, true>(L + RING_OFF, g, S, E);
        }
        GRID_BAR();
    }

    {
        const int tid = pg8::tid_opaque(), lane = tid & 63;
        const int* toke = (const int*)(ws + WS_TOKE); const float* tokg = (const float*)(ws + WS_TOKG); const int* tokp = (const int*)(ws + WS_TOKP);
        const unsigned char* Y = ws + WS_Y; unsigned char* XN = ws + WS_XN3; const bf16* H1B = (const bf16*)out; bf16* H2B = (bf16*)(ws + WS_H2B); const float* gn = args.in[I_PLE_GNORM];
        f32x4 gg[4];
#pragma unroll
        for (int j = 0; j < 4; ++j) gg[j] = *((const GAS f32x4*)gn + lane + 64 * j);
        for (int m0 = gw; m0 < NTOK; m0 += 2 * NGW) {
            int rowk[2][4]; float gk[2][4]; f32x4 v[2][4];
#pragma unroll
            for (int u = 0; u < 2; ++u) { const int m = (m0 + u * NGW < NTOK) ? m0 + u * NGW : m0;
#pragma unroll
                for (int k = 0; k < 4; ++k) { const int e = toke[(size_t)m * 4 + k]; gk[u][k] = tokg[(size_t)m * 4 + k]; rowk[u][k] = tbl[65 + e] + tokp[(size_t)m * 4 + k]; }
                const GAS v2u* xr = (const GAS v2u*)(H1B + (size_t)m * 1024) + lane;
#pragma unroll
                for (int j = 0; j < 4; ++j) { const v2u w_ = xr[64 * j]; v[u][j] = (f32x4){bflo(w_.x), bfhi(w_.x), bflo(w_.y), bfhi(w_.y)}; } }
#pragma unroll
            for (int u = 0; u < 2; ++u)
#pragma unroll
                for (int k = 0; k < 4; ++k) { const GAS unsigned* yr = (const GAS unsigned*)(Y + (size_t)rowk[u][k] * 1024) + lane; const float g_ = gk[u][k];
#pragma unroll
                    for (int j = 0; j < 4; ++j) { const f32x4 y4 = fp8x4_to_f32(yr[64 * j]); v[u][j] += y4 * g_; } }
#pragma unroll
            for (int u = 0; u < 2; ++u) { const int m = m0 + u * NGW; if (m < NTOK) {
                GAS v2u* xw = (GAS v2u*)(H2B + (size_t)m * 1024) + lane; float s = 0.f;
#pragma unroll
                for (int j = 0; j < 4; ++j) { v2u w_; w_.x = pk2(v[u][j].x, v[u][j].y); w_.y = pk2(v[u][j].z, v[u][j].w); xw[64 * j] = w_; s += (v[u][j].x * v[u][j].x + v[u][j].y * v[u][j].y) + (v[u][j].z * v[u][j].z + v[u][j].w * v[u][j].w); }
                const float r = 1.0f / sqrtf(wave_sum(s) * (1.f / 1024.f) + EPS);
                GAS unsigned* o4 = (GAS unsigned*)(XN + (size_t)m * 1024) + lane;
#pragma unroll
                for (int j = 0; j < 4; ++j) o4[64 * j] = pg8::pk4_fp8(v[u][j].x * r * gg[j].x, v[u][j].y * r * gg[j].y, v[u][j].z * r * gg[j].z, v[u][j].w * r * gg[j].w); } }
        }
    }
    GRID_BAR();

    {
        pg8::Gemm g{(const pg8::bf16_t*)(ws + WS_XN3), (const pg8::bf16_t*)(ws + WS_WG), 512, nullptr}; pg8::StaticOrder S; S.init(NTOK, 1024, G, (int)blockIdx.x);
        pg8::EpiFinal E{out, (const pg8::bf16_t*)(ws + WS_H2B), (const pg8::bf16_t*)(ws + WS_ER), (const float*)(ws + WS_SS), args.in[I_PLE_PNORM]};
        pg8::gemm_phase<pg8::EpiFinal, pg8::StaticOrder, false, true, true>(L + RING_OFF, g, S, E);
    }
}

extern "C" void kernel_launch(void* const* d_in, const int* in_sizes, int n_in, void* d_out, int out_size, void* d_ws, size_t ws_size, hipStream_t stream) {
    static int grid = 0;
    if (grid == 0) {
        if (n_in != 28 || in_sizes[0] != NTOK * DMODEL || out_size != NTOK * DMODEL || ws_size < WS_TOP) { fprintf(stderr, "kernel_launch: unexpected shapes (n_in %d, ws %zu)\n", n_in, ws_size); grid = -1; return; }
        int dev = 0, cus = 0, per_cu = 0;
        (void)hipGetDevice(&dev); (void)hipDeviceGetAttribute(&cus, hipDeviceAttributeMultiprocessorCount, dev);
        (void)hipFuncSetAttribute((const void*)mk_fwd, hipFuncAttributeMaxDynamicSharedMemorySize, LDS_BYTES);
        if (hipOccupancyMaxActiveBlocksPerMultiprocessor(&per_cu, (const void*)mk_fwd, NWAVES * 64, LDS_BYTES) != hipSuccess || per_cu < 1) per_cu = 1;
        (void)hipGetLastError();
        grid = cus * (per_cu > 1 ? 1 : per_cu);
    }
    if (grid < 0) return;
    (void)hipMemsetAsync((char*)d_ws + WS_CTL, 0, CTL_ZERO_BYTES, stream);
    Args a{};
    for (int i = 0; i < 28; ++i) a.in[i] = (const float*)d_in[i];
    a.out = (float*)d_out; a.ws = (unsigned char*)d_ws;
    void* kargs[] = {&a};
    hipError_t e = hipLaunchCooperativeKernel((const void*)mk_fwd, dim3(grid), dim3(NWAVES * 64), kargs, LDS_BYTES, stream);
    if (e != hipSuccess) fprintf(stderr, "cooperative launch failed: %s (grid %d)\n", hipGetErrorString(e), grid);
}
```

```cpp
#include <hip/hip_runtime.h>
#include <hip/hip_cooperative_groups.h>
#include <hip/hip_bf16.h>
#include <cstdio>
#include <cstdint>
#include <cmath>
namespace cg = cooperative_groups;


namespace pg8 {
#define PG8_LAS __attribute__((address_space(3)))
typedef unsigned short bf16_t;
typedef short bf16x8 __attribute__((ext_vector_type(8)));
typedef float f32x4 __attribute__((ext_vector_type(4)));
typedef float f32x2 __attribute__((ext_vector_type(2)));
typedef unsigned u32x4 __attribute__((ext_vector_type(4)));
typedef unsigned u32x2 __attribute__((ext_vector_type(2)));
constexpr int BM = 256, BK = 64, HALF = 128, HTB = HALF * BK * 2, STAGE_BYTES = 8 * HTB, NXCD = 8, WGM = 8;

__host__ __device__ __forceinline__ int lds_byte(int r, int c) { const int st = (r >> 4) * 2 + (c >> 5), rr = r & 15, cc = c & 31, ob = rr * 64 + cc * 2; return st * 1024 + (ob ^ (((ob >> 9) & 1) << 5)); }
__host__ __device__ __forceinline__ void stage_rc(int b, int& R, int& C) { const int st = b / 1024, sb = b % 1024, swz = sb ^ (((sb >> 9) & 1) << 5); R = (st >> 1) * 16 + swz / 64; C = (st & 1) * 32 + (swz % 64) / 2; }
__host__ __device__ __forceinline__ int perm32(int rho) { const int n = rho >> 4, i = rho & 15; return 8 * (i >> 2) + 4 * n + (i & 3); }

struct Unit { int ta, tb, pm, pn, e, nv, ord; };
struct Gemm { const bf16_t* A; const bf16_t* Bt; int K; const PG8_LAS unsigned short* urow; };

struct StaticOrder {
    int nM, nN, nwg, G, c;
    __host__ __device__ void init(int M, int N, int G_, int c_) { nM = M / BM; nN = N / BM; nwg = nM * nN; G = G_; c = c_; }
    __host__ __device__ bool next(int i, Unit& u) const {
        const long L = (long)i * G + c; if (L >= nwg) return false;
        int wgid = (int)L; { const int q = nwg / NXCD, r = nwg % NXCD, xcd = wgid % NXCD, off = wgid / NXCD; wgid = (xcd < r ? xcd * (q + 1) : r * (q + 1) + (xcd - r) * q) + off; }
        const int nig = WGM * nN, gid = wgid / nig, fm = gid * WGM, gsz = (nM - fm) < WGM ? (nM - fm) : WGM;
        u.pm = fm + ((wgid % nig) % gsz); u.pn = (wgid % nig) / gsz; u.ta = u.pm; u.tb = u.pn; u.e = 0; u.nv = 256; u.ord = i; return true;
    }
};

__device__ __forceinline__ unsigned cvt_pk_bf16(float lo, float hi) { unsigned r; asm volatile("v_cvt_pk_bf16_f32 %0, %1, %2" : "=v"(r) : "v"(lo), "v"(hi)); return r; }

struct EpiBf16 {
    static constexpr bool PERM = true;
    bf16_t* O; int ldc; const float* bias; int split_cols; size_t split_stride; float* ss;
    __device__ __forceinline__ void operator()(const f32x4 (&acc)[2][2][4][2], const Unit& u, int wr, int wc, int fr, int fq) const {
        const int row0 = u.pm * BM + wr * 64 + fr; int colt = u.pn * BM; bf16_t* base = O;
        if (split_cols) { const int t = colt / split_cols; base += (size_t)t * split_stride; colt -= t * split_cols; }
        const int col0 = colt + wc * 32 + 8 * fq, bcol0 = u.pn * BM + wc * 32 + 8 * fq;
        f32x4 bv[2][2];
#pragma unroll
        for (int bj = 0; bj < 2; ++bj)
#pragma unroll
            for (int n = 0; n < 2; ++n) bv[bj][n] = bias ? *(const f32x4*)(bias + bcol0 + bj * HALF + 4 * n) : (f32x4){0.f, 0.f, 0.f, 0.f};
#pragma unroll
        for (int ai = 0; ai < 2; ++ai)
#pragma unroll
            for (int m = 0; m < 4; ++m) { bf16_t* rowp = base + (size_t)(row0 + ai * HALF + m * 16) * ldc + col0;
                float q = 0.f;
#pragma unroll
                for (int bj = 0; bj < 2; ++bj) { f32x4 v0 = acc[ai][bj][m][0] + bv[bj][0], v1 = acc[ai][bj][m][1] + bv[bj][1];
                    q += (v0[0] * v0[0] + v0[1] * v0[1]) + (v0[2] * v0[2] + v0[3] * v0[3]) + (v1[0] * v1[0] + v1[1] * v1[1]) + (v1[2] * v1[2] + v1[3] * v1[3]);
                    u32x4 w; w.x = cvt_pk_bf16(v0[0], v0[1]); w.y = cvt_pk_bf16(v0[2], v0[3]); w.z = cvt_pk_bf16(v1[0], v1[1]); w.w = cvt_pk_bf16(v1[2], v1[3]);
                    *(u32x4*)(rowp + bj * HALF) = w; }
                if (ss) { q += __shfl_xor(q, 16); q += __shfl_xor(q, 32); if (fq == 0) atomicAdd(ss + row0 + ai * HALF + m * 16, q); } }
    }
};
struct EpiQKVU {
    static constexpr bool PERM = true;
    bf16_t* QK; bf16_t* VU; const float* cs; const float* qn; const float* kn; float c2;
    __device__ __forceinline__ void operator()(const f32x4 (&acc)[2][2][4][2], const Unit& u, int wr, int wc, int fr, int fq) const {
        const int row0 = u.pm * BM + wr * 64 + fr, tcol = 64 * wc + 8 * fq;
        if (u.pn >= 4) {
#pragma unroll
            for (int ai = 0; ai < 2; ++ai)
#pragma unroll
                for (int m = 0; m < 4; ++m) { bf16_t* rowp = VU + (size_t)(row0 + ai * HALF + m * 16) * 1024 + (u.pn - 4) * BM + tcol;
#pragma unroll
                    for (int bj = 0; bj < 2; ++bj) { const f32x4 v0 = acc[ai][bj][m][0], v1 = acc[ai][bj][m][1];
                        u32x4 w; w.x = cvt_pk_bf16(v0[0], v0[1]); w.y = cvt_pk_bf16(v0[2], v0[3]); w.z = cvt_pk_bf16(v1[0], v1[1]); w.w = cvt_pk_bf16(v1[2], v1[3]);
                        *(u32x4*)(rowp + 32 * bj) = w; } }
        } else {
            const bool isq = u.pn < 2; const float* gn = isq ? qn : kn; const float osc = isq ? c2 : 1.0f;
            f32x4 g4[2][2];
#pragma unroll
            for (int bj = 0; bj < 2; ++bj)
#pragma unroll
                for (int n = 0; n < 2; ++n) g4[bj][n] = *(const f32x4*)(gn + ((bj == 0 && fq < 2) ? 8 * n + 4 * fq : 32 * bj + 8 * fq + 4 * n));
#pragma unroll
            for (int ai = 0; ai < 2; ++ai)
#pragma unroll
                for (int m = 0; m < 4; ++m) { const int row = row0 + ai * HALF + m * 16;
                    f32x4 c4 = (f32x4){1.f, 1.f, 1.f, 1.f}, s4 = (f32x4){0.f, 0.f, 0.f, 0.f};
                    if (fq < 2) { c4 = *(const f32x4*)(cs + (size_t)row * 16 + 4 * fq); s4 = *(const f32x4*)(cs + (size_t)row * 16 + 8 + 4 * fq); }
                    f32x4 v[2][2]; float ss = 0.f;
#pragma unroll
                    for (int bj = 0; bj < 2; ++bj)
#pragma unroll
                        for (int n = 0; n < 2; ++n) { v[bj][n] = acc[ai][bj][m][n]; ss += (v[bj][n][0] * v[bj][n][0] + v[bj][n][1] * v[bj][n][1]) + (v[bj][n][2] * v[bj][n][2] + v[bj][n][3] * v[bj][n][3]); }
                    { auto r16 = __builtin_amdgcn_permlane16_swap(__float_as_uint(ss), __float_as_uint(ss), false, false); ss = __uint_as_float(r16[0]) + __uint_as_float(r16[1]);
                      auto r32 = __builtin_amdgcn_permlane32_swap(__float_as_uint(ss), __float_as_uint(ss), false, false); ss = __uint_as_float(r32[0]) + __uint_as_float(r32[1]); }
                    const float r = __builtin_amdgcn_rsqf(ss * (1.f / 64.f) + 1e-6f);
#pragma unroll
                    for (int bj = 0; bj < 2; ++bj)
#pragma unroll
                        for (int n = 0; n < 2; ++n) v[bj][n] = v[bj][n] * g4[bj][n] * r;
                    { const f32x4 t1 = v[0][0], t2 = v[0][1]; v[0][0] = t1 * c4 - t2 * s4; v[0][1] = t2 * c4 + t1 * s4; }
                    bf16_t* rowp = QK + (size_t)row * 1024 + u.pn * BM + tcol;
#pragma unroll
                    for (int bj = 0; bj < 2; ++bj) { const f32x4 v0 = v[bj][0] * osc, v1 = v[bj][1] * osc;
                        u32x4 w; w.x = cvt_pk_bf16(v0[0], v0[1]); w.y = cvt_pk_bf16(v0[2], v0[3]); w.z = cvt_pk_bf16(v1[0], v1[1]); w.w = cvt_pk_bf16(v1[2], v1[3]);
                        *(u32x4*)(rowp + 32 * bj) = w; } }
        }
    }
};
__device__ __forceinline__ f32x2 swiglu2(f32x2 g, f32x2 u) {
    g.x = fminf(g.x, 7.0f); g.y = fminf(g.y, 7.0f);
    u.x = __builtin_amdgcn_fmed3f(u.x, -7.0f, 7.0f); u.y = __builtin_amdgcn_fmed3f(u.y, -7.0f, 7.0f);
    f32x2 e = g * (-1.702f * 1.4426950408889634f);
    e.x = __builtin_amdgcn_exp2f(e.x); e.y = __builtin_amdgcn_exp2f(e.y);
    f32x2 d = e + 1.0f;
    d.x = __builtin_amdgcn_rcpf(d.x); d.y = __builtin_amdgcn_rcpf(d.y);
    return (u + 1.0f) * (g * d);
}
__device__ __forceinline__ unsigned pk4_fp8(float a, float b, float c, float d) { int w = 0; w = __builtin_amdgcn_cvt_pk_fp8_f32(a, b, w, false); w = __builtin_amdgcn_cvt_pk_fp8_f32(c, d, w, true); return (unsigned)w; }
struct EpiSwiglu {
    static constexpr bool PERM = true;
    unsigned char* H; const PG8_LAS float* ub;
    __device__ __forceinline__ void operator()(const f32x4 (&acc)[2][2][4][2], const Unit& u, int wr, int wc, int fr, int fq) const {
        const int row0 = u.pm * BM + wr * 64 + fr, hcol0 = u.pn * HALF + wc * 32 + 8 * fq;
        f32x4 g4[2], u4[2];
#pragma unroll
        for (int n = 0; n < 2; ++n) { g4[n] = *(const PG8_LAS f32x4*)(ub + u.ord * 256 + wc * 32 + 8 * fq + 4 * n); u4[n] = *(const PG8_LAS f32x4*)(ub + u.ord * 256 + 128 + wc * 32 + 8 * fq + 4 * n); }
#pragma unroll
        for (int ai = 0; ai < 2; ++ai)
#pragma unroll
            for (int m = 0; m < 4; ++m) { unsigned char* rowp = H + (size_t)(row0 + ai * HALF + m * 16) * 1024 + hcol0;
                float h[8];
#pragma unroll
                for (int n = 0; n < 2; ++n) { const f32x4 gv = acc[ai][0][m][n] * 0.03125f + g4[n], uv = acc[ai][1][m][n] * 0.03125f + u4[n];
                    const f32x2 h0 = swiglu2((f32x2){gv[0], gv[1]}, (f32x2){uv[0], uv[1]}), h1 = swiglu2((f32x2){gv[2], gv[3]}, (f32x2){uv[2], uv[3]});
                    h[4 * n] = h0.x; h[4 * n + 1] = h0.y; h[4 * n + 2] = h1.x; h[4 * n + 3] = h1.y; }
                u32x2 w; w.x = pk4_fp8(h[0], h[1], h[2], h[3]); w.y = pk4_fp8(h[4], h[5], h[6], h[7]);
                *(u32x2*)rowp = w; }
    }
};
struct EpiDown {
    static constexpr bool PERM = true;
    unsigned char* Y; const PG8_LAS float* ub;
    __device__ __forceinline__ void operator()(const f32x4 (&acc)[2][2][4][2], const Unit& u, int wr, int wc, int fr, int fq) const {
        const int col0 = u.pn * BM + wc * 32 + 8 * fq;
        f32x4 bv[2][2];
#pragma unroll
        for (int bj = 0; bj < 2; ++bj)
#pragma unroll
            for (int n = 0; n < 2; ++n) bv[bj][n] = *(const PG8_LAS f32x4*)(ub + u.ord * 256 + wc * 32 + 8 * fq + bj * HALF + 4 * n);
#pragma unroll
        for (int ai = 0; ai < 2; ++ai)
#pragma unroll
            for (int m = 0; m < 4; ++m) { const int r = wr * 64 + fr + ai * HALF + m * 16; unsigned char* rowp = Y + (size_t)(u.pm + r) * 1024 + col0;
                if (r < u.nv) {
#pragma unroll
                    for (int bj = 0; bj < 2; ++bj) { f32x4 v0 = acc[ai][bj][m][0] * 0.03125f + bv[bj][0], v1 = acc[ai][bj][m][1] * 0.03125f + bv[bj][1];
                        u32x2 w; w.x = pk4_fp8(v0[0], v0[1], v0[2], v0[3]); w.y = pk4_fp8(v1[0], v1[1], v1[2], v1[3]);
                        *(u32x2*)(rowp + bj * HALF) = w; } } }
    }
};
struct EpiResBf16 {
    static constexpr bool PERM = true;
    const float* base; bf16_t* H;
    __device__ __forceinline__ void operator()(const f32x4 (&acc)[2][2][4][2], const Unit& u, int wr, int wc, int fr, int fq) const {
        const int row0 = u.pm * BM + wr * 64 + fr, col0 = u.pn * BM + wc * 32 + 8 * fq;
#pragma unroll
        for (int ai = 0; ai < 2; ++ai)
#pragma unroll
            for (int m = 0; m < 4; ++m) { const size_t off = (size_t)(row0 + ai * HALF + m * 16) * 1024 + col0;
#pragma unroll
                for (int bj = 0; bj < 2; ++bj) { const f32x4 b0 = *(const f32x4*)(base + off + bj * HALF), b1 = *(const f32x4*)(base + off + bj * HALF + 4);
                    const f32x4 v0 = b0 + acc[ai][bj][m][0], v1 = b1 + acc[ai][bj][m][1];
                    u32x4 w; w.x = cvt_pk_bf16(v0[0], v0[1]); w.y = cvt_pk_bf16(v0[2], v0[3]); w.z = cvt_pk_bf16(v1[0], v1[1]); w.w = cvt_pk_bf16(v1[2], v1[3]);
                    *(u32x4*)(H + off + bj * HALF) = w; }
                if (m & 1) asm volatile("" ::: "memory"); }
    }
};
struct EpiF8SS {
    static constexpr bool PERM = true;
    unsigned char* O; int ldc; float* ss;
    __device__ __forceinline__ void operator()(const f32x4 (&acc)[2][2][4][2], const Unit& u, int wr, int wc, int fr, int fq) const {
        const int row0 = u.pm * BM + wr * 64 + fr, col0 = u.pn * BM + wc * 32 + 8 * fq;
#pragma unroll
        for (int ai = 0; ai < 2; ++ai)
#pragma unroll
            for (int m = 0; m < 4; ++m) { unsigned char* rowp = O + (size_t)(row0 + ai * HALF + m * 16) * ldc + col0;
                float q = 0.f;
#pragma unroll
                for (int bj = 0; bj < 2; ++bj) { const f32x4 v0 = acc[ai][bj][m][0], v1 = acc[ai][bj][m][1];
                    q += (v0[0] * v0[0] + v0[1] * v0[1]) + (v0[2] * v0[2] + v0[3] * v0[3]) + (v1[0] * v1[0] + v1[1] * v1[1]) + (v1[2] * v1[2] + v1[3] * v1[3]);
                    u32x2 w; w.x = pk4_fp8(v0[0] * 16.0f, v0[1] * 16.0f, v0[2] * 16.0f, v0[3] * 16.0f); w.y = pk4_fp8(v1[0] * 16.0f, v1[1] * 16.0f, v1[2] * 16.0f, v1[3] * 16.0f);
                    *(u32x2*)(rowp + bj * HALF) = w; }
                q += __shfl_xor(q, 16); q += __shfl_xor(q, 32); if (fq == 0) atomicAdd(ss + row0 + ai * HALF + m * 16, q); }
    }
};
struct EpiFinal {
    static constexpr bool PERM = false;
    float* out; const bf16_t* H2; const unsigned char* ER; const float* ss; const float* pn;
    __device__ __forceinline__ void operator()(const f32x4 (&acc)[2][2][4][2], const Unit& u, int wr, int wc, int fr, int fq) const {
        const int row0 = u.pm * BM + wr * 64 + fr, col0 = u.pn * BM + wc * 32 + 4 * fq;
        f32x4 pv[2][2];
#pragma unroll
        for (int bj = 0; bj < 2; ++bj)
#pragma unroll
            for (int n = 0; n < 2; ++n) pv[bj][n] = *(const f32x4*)(pn + col0 + bj * HALF + n * 16);
#pragma unroll
        for (int ai = 0; ai < 2; ++ai)
#pragma unroll
            for (int m = 0; m < 4; ++m) { const int row = row0 + ai * HALF + m * 16; const size_t off = (size_t)row * 1024 + col0;
                const float re = 0.0625f / sqrtf(ss[row] * (1.f / 1024.f) + 1e-6f);
#pragma unroll
                for (int bj = 0; bj < 2; ++bj)
#pragma unroll
                    for (int n = 0; n < 2; ++n) { const size_t o = off + bj * HALF + n * 16; const u32x2 hw = *(const u32x2*)(H2 + o); const unsigned ew = *(const unsigned*)(ER + o);
                        f32x4 b; b[0] = __uint_as_float(hw.x << 16); b[1] = __uint_as_float(hw.x & 0xffff0000u); b[2] = __uint_as_float(hw.y << 16); b[3] = __uint_as_float(hw.y & 0xffff0000u);
                        f32x4 e; { const f32x2 lo_ = __builtin_amdgcn_cvt_pk_f32_fp8((int)ew, false), hi_ = __builtin_amdgcn_cvt_pk_f32_fp8((int)ew, true); e[0] = lo_.x; e[1] = lo_.y; e[2] = hi_.x; e[3] = hi_.y; }
                        f32x4 r;
#pragma unroll
                        for (int j = 0; j < 4; ++j) { const float sg = __builtin_amdgcn_rcpf(1.0f + __builtin_amdgcn_exp2f((-1.4426950408889634f * 0.03125f) * acc[ai][bj][m][n][j])); r[j] = b[j] + sg * (e[j] * re * pv[bj][n][j]); }
                        *(f32x4*)(out + o) = r; }
                if (m & 1) asm volatile("" ::: "memory"); }
    }
};

typedef int v8i __attribute__((ext_vector_type(8)));
typedef int v4i __attribute__((ext_vector_type(4)));
__device__ __forceinline__ v8i cat8(bf16x8 a, bf16x8 b) { const v4i x = __builtin_bit_cast(v4i, a), y = __builtin_bit_cast(v4i, b); return __builtin_shufflevector(x, y, 0, 1, 2, 3, 4, 5, 6, 7); }
__device__ __forceinline__ void mfma16z(f32x4& acc, bf16x8 a, bf16x8 b) { asm volatile("v_mfma_f32_16x16x32_bf16 %0, %1, %2, 0" : "+v"(acc) : "v"(a), "v"(b)); }
__device__ __forceinline__ void mfma8z(f32x4& acc, v8i a, v8i b, int sc) { asm volatile("v_mfma_scale_f32_16x16x128_f8f6f4 %0, %1, %2, 0, %3, %3 op_sel_hi:[0,0,0]" : "+v"(acc) : "v"(a), "v"(b), "v"(sc)); }
__device__ __forceinline__ void mfma8(f32x4& acc, v8i a, v8i b, int sc) { asm volatile("v_mfma_scale_f32_16x16x128_f8f6f4 %0, %1, %2, %0, %3, %3 op_sel_hi:[0,0,0]" : "+v"(acc) : "v"(a), "v"(b), "v"(sc)); }
__device__ __forceinline__ int tid_opaque() { int t; asm volatile("v_mov_b32 %0, %1" : "=v"(t) : "v"(threadIdx.x)); return t; }
__device__ __forceinline__ void a_offs(const Gemm& g, const Unit& u, int R0, unsigned c2, unsigned (&o)[2][2]) {
    const PG8_LAS unsigned short* t = g.urow + u.ord * 256 + R0;
#pragma unroll
    for (int h = 0; h < 2; ++h) {
        const unsigned r0 = t[h * HALF], r1 = t[h * HALF + 64];
        o[h][0] = (r0 * (unsigned)g.K) * 2u + c2; o[h][1] = (r1 * (unsigned)g.K) * 2u + c2; }
}

template <class Epi, class Sched, bool GATHER, bool ALIGN_EPI, bool F8 = false, bool G64 = false>
__device__ __forceinline__ void gemm_phase(PG8_LAS unsigned char* lds, const Gemm g, const Sched& S, const Epi& E) {
    const int tid = tid_opaque(), wid = __builtin_amdgcn_readfirstlane(tid >> 6), lane = tid & 63, wr = wid >> 2, wc = wid & 3, fr = lane & 15, fq = lane >> 4;
    const int K = g.K, nt = K / BK;
    int R0, C0; stage_rc(tid * 16, R0, C0);
    if constexpr (F8) { const int j = C0 >> 3; C0 = ((((j & 3) << 1) | (j >> 2)) << 3) | (C0 & 7); }
    unsigned voffA[2], voffB[2];
    { const int Rb0 = G64 ? (64 * (R0 >> 5) + perm32(R0 & 31)) : Epi::PERM ? ((R0 & ~31) + perm32(R0 & 31)) : R0;
      voffA[0] = (unsigned)(R0 * K + C0) * 2u; voffA[1] = voffA[0] + (unsigned)(64 * K) * 2u;
      voffB[0] = (unsigned)(Rb0 * K + C0) * 2u; voffB[1] = voffB[0] + (unsigned)((G64 ? 128 : 64) * K) * 2u; }
    const size_t kstep = (size_t)(BK * 2);
    const size_t hstep = (size_t)HALF * K * 2;
    const size_t tstep = 2 * hstep;
    const size_t hstepB = G64 ? (size_t)32 * K * 2 : hstep;
    const unsigned ldsw = (unsigned)wid * 1024u;
    const int aoff = lds_byte(wr * 64 + fr, fq * 8), boff = lds_byte(wc * 32 + fr, fq * 8);
    constexpr int CHS = 1024;
    int sc8 = 0x7f7f7f7f; asm volatile("" : "+v"(sc8));
#define PG8_SA(b, h) (((b) * 2 + (h)) * HTB)
#define PG8_SB(b, h) ((4 + (b) * 2 + (h)) * HTB)
#define PG8_STAGE(bufoff, gbase, voff) do { _Pragma("unroll") for (int _i = 0; _i < 2; ++_i) \
        __builtin_amdgcn_global_load_lds((const unsigned*)((const char*)(gbase) + (voff)[_i]), (PG8_LAS unsigned*)(lds + (bufoff) + ldsw + _i * 8192), 16, 0, 0); } while (0)
#define PG8_STAGE_AC(bufoff, kb, h) do { if constexpr (GATHER) { PG8_STAGE(bufoff, Ab + (kb), co[h]); } else { PG8_STAGE(bufoff, cA + (kb) + (h) * hstep, voffA); } } while (0)
#define PG8_STAGE_AX(bufoff, nx, kb, kbn, h) do { if constexpr (GATHER) { unsigned _o[2]; _o[0] = (nx) ? no[h][0] : co[h][0]; _o[1] = (nx) ? no[h][1] : co[h][1]; PG8_STAGE(bufoff, Ab + ((nx) ? (kbn) : (kb)), _o); } \
        else { PG8_STAGE(bufoff, ((nx) ? nA + (kbn) : cA + (kb)) + (h) * hstep, voffA); } } while (0)
#define PG8_LDA(dst, b, h) do { _Pragma("unroll") for (int m = 0; m < 4; ++m) _Pragma("unroll") for (int k = 0; k < 2; ++k) dst[m][k] = *(const PG8_LAS bf16x8*)(lds + PG8_SA(b, h) + aoff + m * 2048 + k * CHS); } while (0)
#define PG8_LDB(dst, b, h) do { _Pragma("unroll") for (int n = 0; n < 2; ++n) _Pragma("unroll") for (int k = 0; k < 2; ++k) dst[n][k] = *(const PG8_LAS bf16x8*)(lds + PG8_SB(b, h) + boff + n * 2048 + k * CHS); } while (0)
#define PG8_MMA(ai, bj, At, Bt) do { __builtin_amdgcn_s_setprio(1); _Pragma("unroll") for (int m = 0; m < 4; ++m) _Pragma("unroll") for (int n = 0; n < 2; ++n) { \
        if constexpr (F8) { mfma8(acc[ai][bj][m][n], cat8(Bt[n][0], Bt[n][1]), cat8(At[m][0], At[m][1]), sc8); } \
        else { _Pragma("unroll") for (int k = 0; k < 2; ++k) acc[ai][bj][m][n] = __builtin_amdgcn_mfma_f32_16x16x32_bf16(Bt[n][k], At[m][k], acc[ai][bj][m][n], 0, 0, 0); } } \
        __builtin_amdgcn_s_setprio(0); } while (0)
#define PG8_MMAZ(ai, bj, At, Bt) do { __builtin_amdgcn_s_setprio(1); \
        if constexpr (F8) { _Pragma("unroll") for (int m = 0; m < 4; ++m) _Pragma("unroll") for (int n = 0; n < 2; ++n) mfma8z(acc[ai][bj][m][n], cat8(Bt[n][0], Bt[n][1]), cat8(At[m][0], At[m][1]), sc8); } \
        else { _Pragma("unroll") for (int m = 0; m < 4; ++m) _Pragma("unroll") for (int n = 0; n < 2; ++n) mfma16z(acc[ai][bj][m][n], Bt[n][0], At[m][0]); \
               asm volatile("s_nop 7" ::: "memory"); \
               _Pragma("unroll") for (int m = 0; m < 4; ++m) _Pragma("unroll") for (int n = 0; n < 2; ++n) acc[ai][bj][m][n] = __builtin_amdgcn_mfma_f32_16x16x32_bf16(Bt[n][1], At[m][1], acc[ai][bj][m][n], 0, 0, 0); } \
        __builtin_amdgcn_s_setprio(0); } while (0)
#define PG8_WAIT_V(n) asm volatile("s_waitcnt vmcnt(" #n ")" ::: "memory")
#define PG8_WAIT_L(n) asm volatile("s_waitcnt lgkmcnt(" #n ")" ::: "memory")
#define PG8_BAR __builtin_amdgcn_s_barrier()
#define PG8_SCHED __builtin_amdgcn_sched_barrier(0)
    Unit cur, nxt; int ui = 0;
    if (!S.next(0, cur)) return;
    f32x4 acc[2][2][4][2];
    {
#pragma unroll
    for (int a = 0; a < 2; ++a)
#pragma unroll
        for (int b = 0; b < 2; ++b)
#pragma unroll
            for (int m = 0; m < 4; ++m)
#pragma unroll
                for (int n = 0; n < 2; ++n) acc[a][b][m][n] = (f32x4){0.f, 0.f, 0.f, 0.f};
    }
    bf16x8 At[4][2], B0[2][2], B1[2][2];
    const char* const Ab = (const char*)g.A;
    const char* cA = Ab + (GATHER ? (size_t)0 : (size_t)cur.ta * tstep);
    const char* cB = (const char*)g.Bt + (size_t)cur.tb * tstep;
    unsigned co[2][2], no[2][2];
    const unsigned c2 = (unsigned)C0 * 2u;
    if constexpr (GATHER) a_offs(g, cur, R0, c2, co);
    PG8_STAGE(PG8_SB(0, 0), cB, voffB); PG8_STAGE(PG8_SB(0, 1), cB + hstepB, voffB); PG8_STAGE_AC(PG8_SA(0, 0), 0, 0); PG8_STAGE_AC(PG8_SA(0, 1), 0, 1);
    if (wr == 1) PG8_BAR;
    PG8_WAIT_V(2); PG8_BAR;
    PG8_STAGE(PG8_SB(1, 0), cB + kstep, voffB); PG8_STAGE_AC(PG8_SA(1, 0), kstep, 0); PG8_STAGE(PG8_SB(1, 1), cB + hstepB + kstep, voffB);
    PG8_WAIT_V(6); PG8_BAR;
    for (;;) {
        const bool has_next = S.next(ui + 1, nxt);
        const char* nB = has_next ? (const char*)g.Bt + (size_t)nxt.tb * tstep : cB;
        const char* nA = (has_next && !GATHER) ? Ab + (size_t)nxt.ta * tstep : cA;
        if constexpr (GATHER) {
            if (has_next) a_offs(g, nxt, R0, c2, no);
            else {
#pragma unroll
                for (int h = 0; h < 2; ++h) { no[h][0] = co[h][0]; no[h][1] = co[h][1]; } } }
        for (int t = 0; t < nt; t += 2) {
            const bool last = (t == nt - 2);
            const size_t k1 = (size_t)(t + 1) * kstep, k2 = (size_t)(t + 2) * kstep, k3 = (size_t)(t + 3) * kstep;
            const char* b2 = last ? nB : cB + k2;
            const char* b3 = b2 + kstep;
            PG8_LDB(B0, 0, 0); PG8_LDB(B1, 0, 1); PG8_SCHED; PG8_LDA(At, 0, 0); PG8_STAGE_AC(PG8_SA(1, 1), k1, 1);
            PG8_WAIT_V(8); PG8_WAIT_L(0); PG8_BAR; if (t == 0) { PG8_MMAZ(0, 0, At, B0); PG8_MMAZ(0, 1, At, B1); } else { PG8_MMA(0, 0, At, B0); PG8_MMA(0, 1, At, B1); } PG8_BAR; PG8_SCHED;
            PG8_LDA(At, 0, 1); PG8_STAGE(PG8_SB(0, 0), b2, voffB); PG8_STAGE(PG8_SB(0, 1), b2 + hstepB, voffB); PG8_STAGE_AX(PG8_SA(0, 0), last, k2, (size_t)0, 0);
            PG8_WAIT_V(8); PG8_WAIT_L(0); PG8_BAR; if (t == 0) { PG8_MMAZ(1, 0, At, B0); PG8_MMAZ(1, 1, At, B1); } else { PG8_MMA(1, 0, At, B0); PG8_MMA(1, 1, At, B1); } PG8_BAR; PG8_SCHED;
            PG8_LDB(B0, 1, 0); PG8_LDB(B1, 1, 1); PG8_SCHED; PG8_LDA(At, 1, 0); PG8_STAGE_AX(PG8_SA(0, 1), last, k2, (size_t)0, 1);
            PG8_WAIT_V(8); PG8_WAIT_L(0); PG8_BAR; PG8_MMA(0, 0, At, B0); PG8_MMA(0, 1, At, B1); PG8_BAR; PG8_SCHED;
            PG8_LDA(At, 1, 1); PG8_STAGE(PG8_SB(1, 0), b3, voffB); PG8_STAGE(PG8_SB(1, 1), b3 + hstepB, voffB); PG8_STAGE_AX(PG8_SA(1, 0), last, k3, kstep, 0);
            PG8_WAIT_V(8); PG8_WAIT_L(0); PG8_BAR; PG8_MMA(1, 0, At, B0); PG8_MMA(1, 1, At, B1); PG8_BAR; PG8_SCHED;
        }
        if constexpr (ALIGN_EPI) { if (wr == 0) PG8_BAR; }
        if constexpr (F8) asm volatile("s_nop 15\n\ts_nop 15" ::: "memory");
        { const int te = tid_opaque() & 63; E(acc, cur, wr, wc, te & 15, te >> 4); }
        if (!has_next) break;
        cur = nxt; cB = nB; cA = nA; ++ui;
        if constexpr (GATHER) {
#pragma unroll
            for (int h = 0; h < 2; ++h) { co[h][0] = no[h][0]; co[h][1] = no[h][1]; } }
        if constexpr (ALIGN_EPI) { if (wr == 1) PG8_BAR; }
    }
    PG8_WAIT_V(0);
    if constexpr (!ALIGN_EPI) { if (wr == 0) PG8_BAR; }
    PG8_BAR;
#undef PG8_SA
#undef PG8_SB
#undef PG8_STAGE
#undef PG8_STAGE_AC
#undef PG8_STAGE_AX
#undef PG8_LDA
#undef PG8_LDB
#undef PG8_MMA
#undef PG8_WAIT_V
#undef PG8_WAIT_L
#undef PG8_BAR
#undef PG8_SCHED
}
}

namespace attn_body {
using bf16=__hip_bfloat16;
using bf16x8=__attribute__((ext_vector_type(8)))short;
using s16x4=__attribute__((ext_vector_type(4)))short;
using f32x16=__attribute__((ext_vector_type(16)))float;
using u32x4=__attribute__((ext_vector_type(4)))unsigned;
constexpr int SEQ=4096,D=64,DM=1024;
constexpr int NW=8,QBLK=32,QB=QBLK*NW,KVBLK=64,NQB=SEQ/QB;
__device__ __forceinline__ int crow(int r,int hi){return (r&3)+8*(r>>2)+4*hi;}
#define SBAR() __builtin_amdgcn_sched_barrier(0)
__device__ __forceinline__ void cmask(f32x16&p0,f32x16&p1,int jb,int qrel,int hi){
  const float NEG=-INFINITY; int kb=64*jb+4*hi;
  #pragma unroll
  for(int r=0;r<16;++r){int kv=kb+(r&3)+8*(r>>2); if(kv>qrel)p0[r]=NEG; if(kv+32>qrel)p1[r]=NEG;}
}
constexpr int NSLOT=3, SLOTB=8192;
constexpr int LDS_K=0, LDS_V=NSLOT*SLOTB, LDS_WS=2*NSLOT*SLOTB, LDS_OST=LDS_WS+NW*64*4, LDS_BYTES=LDS_OST+NW*4096;
constexpr float C2=0.125f*1.4426950408889634f;
__device__ __forceinline__ void glds16(const void*gsrc,unsigned lds_dst){unsigned keep;
  asm volatile("s_mov_b32 %0, m0\n\ts_mov_b32 m0, %2\n\ts_nop 0\n\tglobal_load_lds_dwordx4 %1, off\n\ts_mov_b32 m0, %0":"=&s"(keep):"v"(gsrc),"s"(lds_dst):"memory");}
__device__ __forceinline__ float max3f(float a,float b,float c){float r;asm("v_max3_f32 %0, %1, %2, %3":"=v"(r):"v"(a),"v"(b),"v"(c));return r;}
__device__ __forceinline__ float max2f(float a,float b){float r;asm("v_max_f32_e32 %0, %1, %2":"=v"(r):"v"(a),"v"(b));return r;}
__device__ __forceinline__ float fadd_s(float a,float b){float r;asm("v_add_f32_e32 %0, %1, %2":"=v"(r):"v"(a),"v"(b));return r;}
__device__ __forceinline__ float fsub_s(float a,float b){float r;asm("v_sub_f32_e32 %0, %1, %2":"=v"(r):"v"(a),"v"(b));return r;}
typedef float f32x2_t __attribute__((ext_vector_type(2))); typedef __bf16 bf16x2_t __attribute__((ext_vector_type(2)));
__device__ __forceinline__ unsigned cvtpk_s(float lo,float hi){f32x2_t v={lo,hi};bf16x2_t b=__builtin_convertvector(v,bf16x2_t);return __builtin_bit_cast(unsigned,b);}
#define WAIT_BAR(N) asm volatile("s_waitcnt vmcnt(" #N ") lgkmcnt(0)\n\ts_barrier":::"memory")

__device__ __forceinline__ void qkt(f32x16&p0,f32x16&p1,const char*Kslot,const bf16x8*qr,const f32x16&negm,int r32,int hi){
  const char*kb=Kslot+hi*1024+r32*16;
  #pragma unroll
  for(int d0=0;d0<4;++d0){
    const bf16x8 b0=*reinterpret_cast<const bf16x8*>(kb+d0*2048);
    const bf16x8 b1=*reinterpret_cast<const bf16x8*>(kb+d0*2048+512);
    if(d0==0){p0=__builtin_amdgcn_mfma_f32_32x32x16_bf16(b0,qr[0],negm,0,0,0);p1=__builtin_amdgcn_mfma_f32_32x32x16_bf16(b1,qr[0],negm,0,0,0);}
    else{p0=__builtin_amdgcn_mfma_f32_32x32x16_bf16(b0,qr[d0],p0,0,0,0);p1=__builtin_amdgcn_mfma_f32_32x32x16_bf16(b1,qr[d0],p1,0,0,0);}}
}
typedef __attribute__((address_space(3))) const char* lds_cptr;
typedef short v4i16_t __attribute__((ext_vector_type(4)));
__device__ __forceinline__ void kload8(bf16x8*kf,lds_cptr kp){
  kf[0]=*(const __attribute__((address_space(3))) bf16x8*)(kp);      kf[1]=*(const __attribute__((address_space(3))) bf16x8*)(kp+512);
  kf[2]=*(const __attribute__((address_space(3))) bf16x8*)(kp+2048); kf[3]=*(const __attribute__((address_space(3))) bf16x8*)(kp+2560);
  kf[4]=*(const __attribute__((address_space(3))) bf16x8*)(kp+4096); kf[5]=*(const __attribute__((address_space(3))) bf16x8*)(kp+4608);
  kf[6]=*(const __attribute__((address_space(3))) bf16x8*)(kp+6144); kf[7]=*(const __attribute__((address_space(3))) bf16x8*)(kp+6656);
}
__device__ __forceinline__ void kload2(bf16x8*kf,lds_cptr kp,int j){ kf[2*j]=*(const __attribute__((address_space(3))) bf16x8*)(kp+j*2048); kf[2*j+1]=*(const __attribute__((address_space(3))) bf16x8*)(kp+j*2048+512); }
__device__ __forceinline__ s16x4 vtr(lds_cptr p){ return __builtin_bit_cast(s16x4,__builtin_amdgcn_ds_read_tr16_b64_v4i16((__attribute__((address_space(3))) v4i16_t*)p)); }
__device__ __forceinline__ float rowmax(const f32x16&p0,const f32x16&p1){
  float a=max3f(p0[0],p0[1],p1[0]),b=max3f(p0[2],p0[3],p1[1]);a=max3f(a,p1[2],p1[3]);
  #pragma unroll
  for(int r=4;r<16;r+=4){a=max3f(a,p0[r],p0[r+1]);b=max3f(b,p0[r+2],p0[r+3]);a=max3f(a,p1[r],p1[r+1]);b=max3f(b,p1[r+2],p1[r+3]);}
  const float m=max2f(a,b);
  auto rr=__builtin_amdgcn_permlane32_swap(__float_as_uint(m),__float_as_uint(m),false,false);
  return max2f(__uint_as_float(rr[0]),__uint_as_float(rr[1]));
}
__device__ __forceinline__ void pv(f32x16*o,int vb,bf16x8 pa0,bf16x8 pa1,bf16x8 pa2,bf16x8 pa3){
  #pragma unroll
  for(int d0=0;d0<2;++d0){s16x4 lo[4],hi[4];
    #pragma unroll
    for(int ks=0;ks<4;++ks){
      asm volatile("ds_read_b64_tr_b16 %0,%1 offset:%c2":"=&v"(lo[ks]):"v"(vb),"i"(d0*4096+ks*1024):"memory");
      asm volatile("ds_read_b64_tr_b16 %0,%1 offset:%c2":"=&v"(hi[ks]):"v"(vb),"i"(d0*4096+ks*1024+512):"memory");}
    asm volatile("s_waitcnt lgkmcnt(0)":::"memory");SBAR();
    #define PK(k) (bf16x8){lo[k][0],lo[k][1],lo[k][2],lo[k][3],hi[k][0],hi[k][1],hi[k][2],hi[k][3]}
    o[d0]=__builtin_amdgcn_mfma_f32_32x32x16_bf16(pa0,PK(0),o[d0],0,0,0);
    o[d0]=__builtin_amdgcn_mfma_f32_32x32x16_bf16(pa1,PK(1),o[d0],0,0,0);
    o[d0]=__builtin_amdgcn_mfma_f32_32x32x16_bf16(pa2,PK(2),o[d0],0,0,0);
    o[d0]=__builtin_amdgcn_mfma_f32_32x32x16_bf16(pa3,PK(3),o[d0],0,0,0);
    #undef PK
  }
}
#define ATTN_STORE16(p,v) (*(u32x4*)(p)=(v))
template<int THRL> __device__ __forceinline__ void attn_unit(int b,int qc,int kc,int vc,int oc,int qb,const bf16*Q,const bf16*__restrict__ K,const bf16*__restrict__ V,bf16*O,char*shm){
  const int tid=threadIdx.x,lane=tid&63,r32=lane&31,hi=lane>>5; const int wid=__builtin_amdgcn_readfirstlane(tid>>6);
  const long rowbase=(long)b*SEQ; const int q0=qb*QB;
  const bf16*Qw=Q+(rowbase+q0+wid*QBLK)*DM+qc;
  const bf16*Kh=K+rowbase*DM+kc,*Vh=V+rowbase*DM+vc;
  const unsigned lds0=(unsigned)(uintptr_t)shm;
  float*wsf=(float*)(shm+LDS_WS)+wid*64;
  const bf16*ksrc=Kh+(long)lane*DM+wid*8;
  const bf16*vsrc=Vh+(long)(16*(wid&3)+(lane>>2))*DM+(wid>>2)*32+(lane&3)*8;
  const unsigned kdst=lds0+LDS_K+wid*1024, vdst=lds0+LDS_V+wid*1024;
  #define DMA_K(t,slot) glds16(ksrc+(long)(t)*KVBLK*DM,(unsigned)__builtin_amdgcn_readfirstlane(kdst+(slot)))
  #define DMA_V(t,slot) glds16(vsrc+(long)(t)*KVBLK*DM,(unsigned)__builtin_amdgcn_readfirstlane(vdst+(slot)))
  const int vb0=(int)(lds0+LDS_V)+((lane>>4)&1)*32+(lane&3)*8+(4*hi+((lane&15)>>2))*64;
  const char*Kbase=shm+LDS_K; bf16x8 kf[8];
  const lds_cptr shm3=(lds_cptr)shm; const lds_cptr kp0=shm3+LDS_K+hi*1024+r32*16; const lds_cptr vp0=shm3+LDS_V+((lane>>4)&1)*32+(lane&3)*8+(4*hi+((lane&15)>>2))*64;
  const int NT=(q0+QB)/KVBLK;
  DMA_K(0,0);DMA_V(0,0);DMA_K(1,SLOTB);
  bf16x8 qr[4];
  #pragma unroll
  for(int d0=0;d0<4;++d0)qr[d0]=*reinterpret_cast<const bf16x8*>(&Qw[(long)r32*DM+d0*16+hi*8]);
  float mhat=0.f,l_reg=0.f;f32x16 o[2];o[0]=f32x16{};o[1]=f32x16{};f32x16 negm=f32x16{};asm volatile("":"+v"(negm));
  const int qrel=wid*QBLK+r32;
  #define CMASK(P0,P1,t) do{int jb_=(t)-(NT-4); if(jb_>=0)cmask(P0,P1,jb_,qrel,hi);}while(0)
  bool resc=false;
  #define START(P0,P1) do{ const float rm=rowmax(P0,P1); resc=false; \
    { const float dl=rm; mhat=fadd_s(mhat,dl); \
      _Pragma("unroll") for(int r=0;r<16;++r){P0[r]=fsub_s(P0[r],dl);P1[r]=fsub_s(P1[r],dl);} \
      _Pragma("unroll") for(int r=0;r<16;++r)negm[r]=-mhat; asm volatile("":"+v"(negm)); } \
    _Pragma("unroll") for(int r=0;r<16;++r)P0[r]=__builtin_amdgcn_exp2f(P0[r]); }while(0)
  #define RESC() do{ if(resc){ asm volatile("s_waitcnt lgkmcnt(0)":::"memory"); \
      _Pragma("unroll") for(int d_=0;d_<2;++d_) _Pragma("unroll") for(int r=0;r<16;++r)o[d_][r]*=wsf[crow(r,hi)]; } }while(0)
  f32x16 pA0,pA1,pB0,pB1;
  int sl_prev=0,sl_cur=0,sl_next=SLOTB;
  #define ROT() do{sl_prev=sl_cur;sl_cur=sl_next;sl_next=(sl_next==(NSLOT-1)*SLOTB)?0:sl_next+SLOTB;}while(0)
  DMA_K(2,2*SLOTB);
  WAIT_BAR(3);
  qkt(pA0,pA1,Kbase,qr,negm,r32,hi);asm volatile("s_nop 15\n\ts_nop 7":"+v"(pA0),"+v"(pA1));CMASK(pA0,pA1,0);
  START(pA0,pA1);
  _Pragma("unroll") for(int r=0;r<16;++r)pA1[r]=__builtin_amdgcn_exp2f(pA1[r]);
  WAIT_BAR(0);
  DMA_K(3,0);DMA_V(1,SLOTB);
  ROT();
  kload8(kf,kp0+sl_cur);
  WAIT_BAR(2);
  s16x4 vlo[8],vhi[8]; u32x4 pw0,pw1,pw2,pw3;
  #define PKW(P,B) cvtpk_s(P[B],P[B+1])
  #define PAF(k) __builtin_bit_cast(bf16x8,pw##k)
  #define VFR(i) (bf16x8){vlo[i][0],vlo[i][1],vlo[i][2],vlo[i][3],vhi[i][0],vhi[i][1],vhi[i][2],vhi[i][3]}
  #define PIN(x) asm volatile("":"+v"(x))
  #define MX3(a,b,c) __builtin_fmaxf(__builtin_fmaxf((a),(b)),(c))
  #define GAPA(MF,A0,A1,A2,A3,W0,W1,PW) do{ MF; sacc+=A0; sacc+=A1; sacc+=A2; sacc+=A3; PIN(sacc); W0; W1; PIN(PW); SBAR(); }while(0)
  #define EX(v) __builtin_amdgcn_exp2f(v)
  #define GAPB(MF,X,B) do{ MF; X[B]=EX(X[B]); X[B+1]=EX(X[B+1]); X[B+2]=EX(X[B+2]); X[B+3]=EX(X[B+3]); PIN(X); SBAR(); }while(0)
  #define VRD(i) do{ vlo[i]=vtr(vp_+(((i)>>2)*4096+((i)&3)*1024)); vhi[i]=vtr(vp_+(((i)>>2)*4096+((i)&3)*1024+512)); }while(0)
  #define KRD(G,j) do{ if(G){ kload2(kf,kp0+sl_next,j); SBAR(); } }while(0)
  #define STEP(C0,C1,P0,P1,t,GK,GV,GL) do{ SBAR(); \
    const lds_cptr vp_=vp0+sl_prev; \
    VRD(0); SBAR(); float sacc=(P0[0]+P0[1]); \
    GAPA(C0=__builtin_amdgcn_mfma_f32_32x32x16_bf16(kf[0],qr[0],negm,0,0,0), P0[2],P0[3],P0[4],P0[5],     pw0[0]=PKW(P0,0), pw0[1]=PKW(P0,2), pw0); \
    VRD(4); SBAR(); GAPA(C1=__builtin_amdgcn_mfma_f32_32x32x16_bf16(kf[1],qr[0],negm,0,0,0), P0[6],P0[7],P0[8],P0[9],     pw0[2]=PKW(P0,4), pw0[3]=PKW(P0,6), pw0); \
    VRD(1); SBAR(); GAPA(C0=__builtin_amdgcn_mfma_f32_32x32x16_bf16(kf[2],qr[1],C0,0,0,0),   P0[10],P0[11],P0[12],P0[13], pw1[0]=PKW(P0,8), pw1[1]=PKW(P0,10), pw1); \
    VRD(5); SBAR(); GAPA(C1=__builtin_amdgcn_mfma_f32_32x32x16_bf16(kf[3],qr[1],C1,0,0,0),   P0[14],P0[15],P1[0],P1[1],   pw1[2]=PKW(P0,12),pw1[3]=PKW(P0,14), pw1); \
    VRD(2); SBAR(); GAPA(C0=__builtin_amdgcn_mfma_f32_32x32x16_bf16(kf[4],qr[2],C0,0,0,0),   P1[2],P1[3],P1[4],P1[5],     pw2[0]=PKW(P1,0), pw2[1]=PKW(P1,2), pw2); \
    VRD(6); SBAR(); GAPA(C1=__builtin_amdgcn_mfma_f32_32x32x16_bf16(kf[5],qr[2],C1,0,0,0),   P1[6],P1[7],P1[8],P1[9],     pw2[2]=PKW(P1,4), pw2[3]=PKW(P1,6), pw2); \
    VRD(3); SBAR(); GAPA(C0=__builtin_amdgcn_mfma_f32_32x32x16_bf16(kf[6],qr[3],C0,0,0,0),   P1[10],P1[11],P1[12],P1[13], pw3[0]=PKW(P1,8), pw3[1]=PKW(P1,10), pw3); \
    VRD(7); SBAR(); GAPA(C1=__builtin_amdgcn_mfma_f32_32x32x16_bf16(kf[7],qr[3],C1,0,0,0),   P1[14],P1[15],0.f,0.f,       pw3[2]=PKW(P1,12),pw3[3]=PKW(P1,14), pw3); \
    l_reg+=sacc; \
    if(GK){DMA_K((t)+3,sl_cur);} if(GV){DMA_V((t)+1,sl_next);} \
    CMASK(C0,C1,t); \
    { float a=MX3(C0[0],C0[1],C1[0]),b=MX3(C0[2],C0[3],C1[1]); a=MX3(a,C1[2],C1[3]); \
      _Pragma("unroll") for(int r=4;r<16;r+=4){a=MX3(a,C0[r],C0[r+1]);b=MX3(b,C0[r+2],C0[r+3]);a=MX3(a,C1[r],C1[r+1]);b=MX3(b,C1[r+2],C1[r+3]);} \
      float rm=__builtin_fmaxf(a,b); { auto rr=__builtin_amdgcn_permlane32_swap(__float_as_uint(rm),__float_as_uint(rm),false,false); rm=__builtin_fmaxf(__uint_as_float(rr[0]),__uint_as_float(rr[1])); } \
      resc=false; \
      if(__builtin_expect(__any(rm>(float)THRL),0)){ const float dl=__builtin_fmaxf(rm,0.f); mhat+=dl; \
        _Pragma("unroll") for(int r=0;r<16;++r){C0[r]-=dl;C1[r]-=dl;} \
        _Pragma("unroll") for(int r=0;r<16;++r)negm[r]=-mhat; asm volatile("":"+v"(negm)); \
        const float f=__builtin_amdgcn_exp2f(-dl); l_reg*=f; if(hi==0)wsf[r32]=f; resc=true; } } \
    SBAR(); \
    GAPB(o[0]=__builtin_amdgcn_mfma_f32_32x32x16_bf16(PAF(0),VFR(0),o[0],0,0,0), C0,0); \
    GAPB(o[1]=__builtin_amdgcn_mfma_f32_32x32x16_bf16(PAF(0),VFR(4),o[1],0,0,0), C0,4); \
    KRD(GL,0); GAPB(o[0]=__builtin_amdgcn_mfma_f32_32x32x16_bf16(PAF(1),VFR(1),o[0],0,0,0), C0,8); \
    KRD(GL,1); GAPB(o[1]=__builtin_amdgcn_mfma_f32_32x32x16_bf16(PAF(1),VFR(5),o[1],0,0,0), C0,12); \
    KRD(GL,2); GAPB(o[0]=__builtin_amdgcn_mfma_f32_32x32x16_bf16(PAF(2),VFR(2),o[0],0,0,0), C1,0); \
    KRD(GL,3); GAPB(o[1]=__builtin_amdgcn_mfma_f32_32x32x16_bf16(PAF(2),VFR(6),o[1],0,0,0), C1,4); \
    GAPB(o[0]=__builtin_amdgcn_mfma_f32_32x32x16_bf16(PAF(3),VFR(3),o[0],0,0,0), C1,8); \
    GAPB(o[1]=__builtin_amdgcn_mfma_f32_32x32x16_bf16(PAF(3),VFR(7),o[1],0,0,0), C1,12); \
    }while(0)
  int t=1;
  #undef CMASK
  #define CMASK(P0,P1,t) do{}while(0)
  for(;t+5<NT;t+=2){
    STEP(pB0,pB1,pA0,pA1,t,true,true,true);     WAIT_BAR(2); RESC(); ROT();
    STEP(pA0,pA1,pB0,pB1,t+1,true,true,true);   WAIT_BAR(2); RESC(); ROT();
  }
  #undef CMASK
  #define CMASK(P0,P1,t) do{int jb_=(t)-(NT-4); if(jb_>=0)cmask(P0,P1,jb_,qrel,hi);}while(0)
  #define ENDW(tt) do{ if((tt)+3<NT){WAIT_BAR(2);} else if((tt)+2<NT){WAIT_BAR(1);} else {WAIT_BAR(0);} }while(0)
  for(;t+1<NT;t+=2){
    STEP(pB0,pB1,pA0,pA1,t,(t+3<NT),(t+1<NT),(t+1<NT));       ENDW(t);   RESC(); ROT();
    STEP(pA0,pA1,pB0,pB1,t+1,(t+4<NT),(t+2<NT),(t+2<NT));     ENDW(t+1); RESC(); ROT();
  }
  STEP(pB0,pB1,pA0,pA1,NT-1,false,false,false); RESC();
  { float sacc=pB0[0]+pB0[1]; _Pragma("unroll") for(int r=2;r<16;++r)sacc+=pB0[r]; _Pragma("unroll") for(int r=0;r<16;++r)sacc+=pB1[r]; l_reg+=sacc;
    pw0=(u32x4){PKW(pB0,0),PKW(pB0,2),PKW(pB0,4),PKW(pB0,6)};pw1=(u32x4){PKW(pB0,8),PKW(pB0,10),PKW(pB0,12),PKW(pB0,14)};pw2=(u32x4){PKW(pB1,0),PKW(pB1,2),PKW(pB1,4),PKW(pB1,6)};pw3=(u32x4){PKW(pB1,8),PKW(pB1,10),PKW(pB1,12),PKW(pB1,14)};
    SBAR(); pv(o,vb0+sl_cur,PAF(0),PAF(1),PAF(2),PAF(3)); }
  #undef PKW
  #undef PAF
  #undef VFR
  #undef PIN
  #undef MX3
  #undef GAPA
  #undef GAPB
  #undef EX
  #undef VRD
  #undef KRD
  #undef STEP
  #undef ENDW
  {auto rr=__builtin_amdgcn_permlane32_swap(__float_as_uint(l_reg),__float_as_uint(l_reg),false,false);l_reg=__uint_as_float(rr[0])+__uint_as_float(rr[1]);}
  if(hi==0)wsf[32+r32]=l_reg;asm volatile("s_waitcnt lgkmcnt(0)":::"memory");
  float rli[16];
  #pragma unroll
  for(int r=0;r<16;++r)rli[r]=__builtin_amdgcn_rcpf(wsf[32+crow(r,hi)]);
  bf16*Ow=O+(rowbase+q0+wid*QBLK)*DM+oc;
  { bf16*stg=(bf16*)(shm+LDS_OST)+wid*2048;
    #pragma unroll
    for(int r=0;r<16;++r){const int orow=crow(r,hi);
      #pragma unroll
      for(int d0=0;d0<2;++d0)stg[orow*64+d0*32+r32]=__float2bfloat16(o[d0][r]*rli[r]);}
    asm volatile("s_waitcnt lgkmcnt(0)":::"memory");
    #pragma unroll
    for(int i=0;i<4;++i){const int row=i*8+(lane>>3),ch=lane&7; const u32x4 v=*(const u32x4*)(stg+row*64+ch*8); ATTN_STORE16(Ow+(long)row*DM+ch*8,v);} }
  asm volatile("s_waitcnt lgkmcnt(0)\n\ts_barrier":::"memory");
  #undef DMA_K
  #undef DMA_V
  #undef CMASK
  #undef START
  #undef RESC
  #undef ROT
}
constexpr int ATTN_LDS_BYTES=LDS_BYTES;
#undef SBAR
#undef WAIT_BAR
}

namespace attn2 {
using namespace attn_body;
constexpr int NKS=4, SLOTK=8192, NVS=3, SLOTV=16384;
constexpr int A2_K=0, A2_V=NKS*SLOTK, A2_WS=A2_V+NVS*SLOTV, A2_OST=A2_WS+NW*64*4, A2_BYTES=A2_OST+NW*4096;
#define SBAR() __builtin_amdgcn_sched_barrier(0)
#define WAIT_BAR(N) asm volatile("s_waitcnt vmcnt(" #N ") lgkmcnt(0)\n\ts_barrier":::"memory")
typedef __attribute__((address_space(3))) const bf16x8* lds_b8;
typedef float f32x4_t __attribute__((ext_vector_type(4)));
__device__ __forceinline__ bf16x8 KL(lds_cptr p){ return *(lds_b8)p; }
__device__ __forceinline__ void glds16s(const void*sbase,unsigned voff,unsigned lds_dst){unsigned keep;
  asm volatile("s_mov_b32 %0, m0\n\ts_mov_b32 m0, %3\n\ts_nop 0\n\tglobal_load_lds_dwordx4 %1, %2\n\ts_mov_b32 m0, %0":"=&s"(keep):"v"(voff),"s"(sbase),"s"(lds_dst):"memory");}
__device__ __forceinline__ void pv4(f32x16*o,int vb,bf16x8 pa0,bf16x8 pa1,bf16x8 pa2,bf16x8 pa3){
  #pragma unroll
  for(int d0=0;d0<4;++d0){s16x4 lo[4],hi[4];
    #pragma unroll
    for(int ks=0;ks<4;++ks){
      asm volatile("ds_read_b64_tr_b16 %0,%1 offset:%c2":"=&v"(lo[ks]):"v"(vb),"i"(d0*4096+ks*1024):"memory");
      asm volatile("ds_read_b64_tr_b16 %0,%1 offset:%c2":"=&v"(hi[ks]):"v"(vb),"i"(d0*4096+ks*1024+512):"memory");}
    asm volatile("s_waitcnt lgkmcnt(0)":::"memory");SBAR();
    #define PK(k) (bf16x8){lo[k][0],lo[k][1],lo[k][2],lo[k][3],hi[k][0],hi[k][1],hi[k][2],hi[k][3]}
    o[d0]=__builtin_amdgcn_mfma_f32_32x32x16_bf16(pa0,PK(0),o[d0],0,0,0);
    o[d0]=__builtin_amdgcn_mfma_f32_32x32x16_bf16(pa1,PK(1),o[d0],0,0,0);
    o[d0]=__builtin_amdgcn_mfma_f32_32x32x16_bf16(pa2,PK(2),o[d0],0,0,0);
    o[d0]=__builtin_amdgcn_mfma_f32_32x32x16_bf16(pa3,PK(3),o[d0],0,0,0);
    #undef PK
  }
}
template<int THRL,long A_OFF,long SG_OFF> __device__ __forceinline__ void attn_unit(int b,int qc,int kc,int vc,int oc,int qb,const bf16*Q,const bf16*__restrict__ K,const bf16*__restrict__ V,bf16*O,char*shm){
  const int MODE=(oc>>7)&1;
  int tid; asm volatile("v_mov_b32 %0, %1" : "=v"(tid) : "v"(threadIdx.x));
  const int lane=tid&63,r32=lane&31,hi=lane>>5; const int wid=__builtin_amdgcn_readfirstlane(tid>>6);
  const long rowbase=(long)b*SEQ; const int q0=qb*QB;
  const bf16*Qw=Q+(rowbase+q0+wid*QBLK)*DM+qc;
  const bf16*Kh=K+rowbase*DM+kc,*Vh=V+rowbase*DM+vc;
  const unsigned lds0=(unsigned)(uintptr_t)shm;
  float*wsf=(float*)(shm+A2_WS)+wid*64;
  const unsigned koff=(unsigned)(lane*DM+wid*8)*2u;
  const unsigned voff=(unsigned)((16*(wid&3)+(lane>>2))*DM+(wid>>2)*32+(lane&3)*8)*2u;
  const unsigned kdst=lds0+A2_K+wid*1024, vdst=lds0+A2_V+wid*1024;
  #define DMA_K(t) glds16s(Kh+(long)(t)*KVBLK*DM,koff,(unsigned)__builtin_amdgcn_readfirstlane(kdst+(((t)&3)*SLOTK)))
  #define DMA_V(t,slot) do{ glds16s(Vh+(long)(t)*KVBLK*DM,voff,(unsigned)__builtin_amdgcn_readfirstlane(vdst+(slot))); glds16s(Vh+(long)(t)*KVBLK*DM+64,voff,(unsigned)__builtin_amdgcn_readfirstlane(vdst+(slot)+8192)); }while(0)
  const char*Kbase=shm+A2_K;
  const lds_cptr shm3=(lds_cptr)shm; const lds_cptr kp0=shm3+A2_K+hi*1024+r32*16; const lds_cptr vp0=shm3+A2_V+((lane>>4)&1)*32+(lane&3)*8+(4*hi+((lane&15)>>2))*64;
  const int NT=(q0+QB)/KVBLK;
  DMA_K(0);DMA_V(0,0);DMA_K(1);
  bf16x8 qr[4];
  #pragma unroll
  for(int d0=0;d0<4;++d0)qr[d0]=*reinterpret_cast<const bf16x8*>(&Qw[(long)r32*DM+d0*16+hi*8]);
  float mhat=0.f,l_reg=0.f;f32x16 o[4];o[0]=f32x16{};o[1]=f32x16{};o[2]=f32x16{};o[3]=f32x16{};f32x16 negm=f32x16{};asm volatile("":"+v"(negm));
  const int qrel=wid*QBLK+r32;
  #define CMASK(P0,P1,t) do{int jb_=(t)-(NT-4); if(jb_>=0)cmask(P0,P1,jb_,qrel,hi);}while(0)
  bool resc=false;
  #define START(P0,P1) do{ const float rm=rowmax(P0,P1); resc=false; \
    { const float dl=rm; mhat=fadd_s(mhat,dl); \
      _Pragma("unroll") for(int r=0;r<16;++r){P0[r]=fsub_s(P0[r],dl);P1[r]=fsub_s(P1[r],dl);} \
      _Pragma("unroll") for(int r=0;r<16;++r)negm[r]=-mhat; asm volatile("":"+v"(negm)); } \
    _Pragma("unroll") for(int r=0;r<16;++r)P0[r]=__builtin_amdgcn_exp2f(P0[r]); }while(0)
  #define RESC() do{ if(resc){ asm volatile("s_waitcnt lgkmcnt(0)":::"memory"); \
      _Pragma("unroll") for(int d_=0;d_<4;++d_) _Pragma("unroll") for(int r=0;r<16;++r)o[d_][r]*=wsf[crow(r,hi)]; } }while(0)
  f32x16 pA0,pA1,pB0,pB1;
  int vs_prev=0,vs_cur=0,vs_next=SLOTV;
  #define ROT() do{vs_prev=vs_cur;vs_cur=vs_next;vs_next=(vs_next==(NVS-1)*SLOTV)?0:vs_next+SLOTV;}while(0)
  DMA_K(2);
  WAIT_BAR(4);
  qkt(pA0,pA1,Kbase,qr,negm,r32,hi);asm volatile("s_nop 15\n\ts_nop 7":"+v"(pA0),"+v"(pA1));CMASK(pA0,pA1,0);
  START(pA0,pA1);
  _Pragma("unroll") for(int r=0;r<16;++r)pA1[r]=__builtin_amdgcn_exp2f(pA1[r]);
  WAIT_BAR(0);
  DMA_K(3);DMA_V(1,SLOTV);
  ROT();
  bf16x8 kn0=KL(kp0+SLOTK),kn1=KL(kp0+SLOTK+512);
  s16x4 vlo[8],vhi[8]; u32x4 pw0,pw1,pw2,pw3;
  #define PKW(P,B) cvtpk_s(P[B],P[B+1])
  #define PAF(k) __builtin_bit_cast(bf16x8,pw##k)
  #define VFR(i) (bf16x8){vlo[i][0],vlo[i][1],vlo[i][2],vlo[i][3],vhi[i][0],vhi[i][1],vhi[i][2],vhi[i][3]}
  #define PIN(x) asm volatile("":"+v"(x))
  #define MX3(a,b,c) __builtin_fmaxf(__builtin_fmaxf((a),(b)),(c))
  #define GAPA(MF,A0,A1,A2,A3,W0,W1,PW) do{ MF; sacc+=A0; sacc+=A1; sacc+=A2; sacc+=A3; PIN(sacc); W0; W1; PIN(PW); SBAR(); }while(0)
  #define EX(v) __builtin_amdgcn_exp2f(v)
  #define GAPB(MF,X,B) do{ MF; X[B]=EX(X[B]); X[B+1]=EX(X[B+1]); PIN(X); SBAR(); }while(0)
  #define GAPB3(MF,X,B) do{ MF; X[B]=EX(X[B]); X[B+1]=EX(X[B+1]); X[B+2]=EX(X[B+2]); PIN(X); SBAR(); }while(0)
  #define GAPB4(MF,X,B) do{ MF; X[B]=EX(X[B]); X[B+1]=EX(X[B+1]); X[B+2]=EX(X[B+2]); X[B+3]=EX(X[B+3]); PIN(X); SBAR(); }while(0)
  #define VRD(i) do{ vlo[i]=vtr(vp_+(((i)>>2)*4096+((i)&3)*1024)); vhi[i]=vtr(vp_+(((i)>>2)*4096+((i)&3)*1024+512)); }while(0)
  #define VRH(i) do{ vlo[i]=vtr(vp_+(8192+((i)>>2)*4096+((i)&3)*1024)); vhi[i]=vtr(vp_+(8192+((i)>>2)*4096+((i)&3)*1024+512)); SBAR(); }while(0)
  #define STEP(C0,C1,P0,P1,t,GK,GV,GL) do{ SBAR(); \
    const lds_cptr vp_=vp0+vs_prev; const lds_cptr kq_=kp0+(((t)&3)*SLOTK); \
    bf16x8 ka0=kn0,ka1=kn1,kb0,kb1; \
    kb0=KL(kq_+2048); kb1=KL(kq_+2560); VRD(0); SBAR(); float sacc=(P0[0]+P0[1]); \
    GAPA(C0=__builtin_amdgcn_mfma_f32_32x32x16_bf16(ka0,qr[0],negm,0,0,0), P0[2],P0[3],P0[4],P0[5],     pw0[0]=PKW(P0,0), pw0[1]=PKW(P0,2), pw0); \
    VRD(4); SBAR(); GAPA(C1=__builtin_amdgcn_mfma_f32_32x32x16_bf16(ka1,qr[0],negm,0,0,0), P0[6],P0[7],P0[8],P0[9],     pw0[2]=PKW(P0,4), pw0[3]=PKW(P0,6), pw0); \
    ka0=KL(kq_+4096); ka1=KL(kq_+4608); VRD(1); SBAR(); GAPA(C0=__builtin_amdgcn_mfma_f32_32x32x16_bf16(kb0,qr[1],C0,0,0,0),   P0[10],P0[11],P0[12],P0[13], pw1[0]=PKW(P0,8), pw1[1]=PKW(P0,10), pw1); \
    VRD(5); SBAR(); GAPA(C1=__builtin_amdgcn_mfma_f32_32x32x16_bf16(kb1,qr[1],C1,0,0,0),   P0[14],P0[15],P1[0],P1[1],   pw1[2]=PKW(P0,12),pw1[3]=PKW(P0,14), pw1); \
    kb0=KL(kq_+6144); kb1=KL(kq_+6656); VRD(2); SBAR(); GAPA(C0=__builtin_amdgcn_mfma_f32_32x32x16_bf16(ka0,qr[2],C0,0,0,0),   P1[2],P1[3],P1[4],P1[5],     pw2[0]=PKW(P1,0), pw2[1]=PKW(P1,2), pw2); \
    VRD(6); SBAR(); GAPA(C1=__builtin_amdgcn_mfma_f32_32x32x16_bf16(ka1,qr[2],C1,0,0,0),   P1[6],P1[7],P1[8],P1[9],     pw2[2]=PKW(P1,4), pw2[3]=PKW(P1,6), pw2); \
    VRD(3); SBAR(); GAPA(C0=__builtin_amdgcn_mfma_f32_32x32x16_bf16(kb0,qr[3],C0,0,0,0),   P1[10],P1[11],P1[12],P1[13], pw3[0]=PKW(P1,8), pw3[1]=PKW(P1,10), pw3); \
    VRD(7); SBAR(); GAPA(C1=__builtin_amdgcn_mfma_f32_32x32x16_bf16(kb1,qr[3],C1,0,0,0),   P1[14],P1[15],0.f,0.f,       pw3[2]=PKW(P1,12),pw3[3]=PKW(P1,14), pw3); \
    l_reg+=sacc; \
    if(GK){DMA_K((t)+3);} if(GV){DMA_V((t)+1,vs_next);} \
    CMASK(C0,C1,t); \
      \
    float mxa,mxb; \
    o[0]=__builtin_amdgcn_mfma_f32_32x32x16_bf16(PAF(0),VFR(0),o[0],0,0,0); \
    mxa=MX3(C0[0],C0[1],C1[0]); mxb=MX3(C0[2],C0[3],C1[1]); mxa=MX3(mxa,C1[2],C1[3]); mxa=MX3(mxa,C0[4],C0[5]); mxb=MX3(mxb,C0[6],C0[7]); mxa=MX3(mxa,C1[4],C1[5]); mxb=MX3(mxb,C1[6],C1[7]); PIN(mxa); PIN(mxb); SBAR(); VRH(0); \
    o[1]=__builtin_amdgcn_mfma_f32_32x32x16_bf16(PAF(0),VFR(4),o[1],0,0,0); \
    mxa=MX3(mxa,C0[8],C0[9]); mxb=MX3(mxb,C0[10],C0[11]); mxa=MX3(mxa,C1[8],C1[9]); mxb=MX3(mxb,C1[10],C1[11]); mxa=MX3(mxa,C0[12],C0[13]); mxb=MX3(mxb,C0[14],C0[15]); mxa=MX3(mxa,C1[12],C1[13]); mxb=MX3(mxb,C1[14],C1[15]); PIN(mxa); PIN(mxb); SBAR(); VRH(4); \
    o[0]=__builtin_amdgcn_mfma_f32_32x32x16_bf16(PAF(1),VFR(1),o[0],0,0,0); \
    { float rm=__builtin_fmaxf(mxa,mxb); { auto rr=__builtin_amdgcn_permlane32_swap(__float_as_uint(rm),__float_as_uint(rm),false,false); rm=__builtin_fmaxf(__uint_as_float(rr[0]),__uint_as_float(rr[1])); } \
      resc=false; \
      if(__builtin_expect(__any(rm>(float)THRL),0)){ const float dl=__builtin_fmaxf(rm,0.f); mhat+=dl; \
        _Pragma("unroll") for(int r=0;r<16;++r){C0[r]-=dl;C1[r]-=dl;} \
        _Pragma("unroll") for(int r=0;r<16;++r)negm[r]=-mhat; asm volatile("":"+v"(negm)); \
        const float f=__builtin_amdgcn_exp2f(-dl); l_reg*=f; if(hi==0)wsf[r32]=f; resc=true; } } \
    SBAR(); VRH(1); \
    GAPB4(o[1]=__builtin_amdgcn_mfma_f32_32x32x16_bf16(PAF(1),VFR(5),o[1],0,0,0), C0,0);  VRH(5); \
    GAPB3(o[0]=__builtin_amdgcn_mfma_f32_32x32x16_bf16(PAF(2),VFR(2),o[0],0,0,0), C0,4);  VRH(2); \
    GAPB3(o[1]=__builtin_amdgcn_mfma_f32_32x32x16_bf16(PAF(2),VFR(6),o[1],0,0,0), C0,7);  VRH(6); \
    GAPB3(o[0]=__builtin_amdgcn_mfma_f32_32x32x16_bf16(PAF(3),VFR(3),o[0],0,0,0), C0,10); VRH(3); \
    GAPB3(o[1]=__builtin_amdgcn_mfma_f32_32x32x16_bf16(PAF(3),VFR(7),o[1],0,0,0), C0,13); VRH(7); \
    GAPB(o[2]=__builtin_amdgcn_mfma_f32_32x32x16_bf16(PAF(0),VFR(0),o[2],0,0,0), C1,0); \
    GAPB(o[3]=__builtin_amdgcn_mfma_f32_32x32x16_bf16(PAF(0),VFR(4),o[3],0,0,0), C1,2); \
    if(GL){ kn0=KL(kp0+((((t)+1)&3)*SLOTK)); kn1=KL(kp0+((((t)+1)&3)*SLOTK)+512); SBAR(); } \
    GAPB(o[2]=__builtin_amdgcn_mfma_f32_32x32x16_bf16(PAF(1),VFR(1),o[2],0,0,0), C1,4); \
    GAPB(o[3]=__builtin_amdgcn_mfma_f32_32x32x16_bf16(PAF(1),VFR(5),o[3],0,0,0), C1,6); \
    GAPB(o[2]=__builtin_amdgcn_mfma_f32_32x32x16_bf16(PAF(2),VFR(2),o[2],0,0,0), C1,8); \
    GAPB(o[3]=__builtin_amdgcn_mfma_f32_32x32x16_bf16(PAF(2),VFR(6),o[3],0,0,0), C1,10); \
    GAPB(o[2]=__builtin_amdgcn_mfma_f32_32x32x16_bf16(PAF(3),VFR(3),o[2],0,0,0), C1,12); \
    GAPB(o[3]=__builtin_amdgcn_mfma_f32_32x32x16_bf16(PAF(3),VFR(7),o[3],0,0,0), C1,14); \
    }while(0)
  int t=1;
  #undef CMASK
  #define CMASK(P0,P1,t) do{}while(0)
  for(;t+5<NT;t+=2){
    STEP(pB0,pB1,pA0,pA1,t,true,true,true);     WAIT_BAR(3); RESC(); ROT();
    STEP(pA0,pA1,pB0,pB1,t+1,true,true,true);   WAIT_BAR(3); RESC(); ROT();
  }
  #undef CMASK
  #define CMASK(P0,P1,t) do{int jb_=(t)-(NT-4); if(jb_>=0)cmask(P0,P1,jb_,qrel,hi);}while(0)
  #define ENDW(tt) do{ if((tt)+3<NT){WAIT_BAR(3);} else if((tt)+2<NT){WAIT_BAR(2);} else {WAIT_BAR(0);} }while(0)
  for(;t+1<NT;t+=2){
    STEP(pB0,pB1,pA0,pA1,t,(t+3<NT),(t+1<NT),(t+1<NT));       ENDW(t);   RESC(); ROT();
    STEP(pA0,pA1,pB0,pB1,t+1,(t+4<NT),(t+2<NT),(t+2<NT));     ENDW(t+1); RESC(); ROT();
  }
  STEP(pB0,pB1,pA0,pA1,NT-1,false,false,false); RESC();
  { float sacc=pB0[0]+pB0[1]; _Pragma("unroll") for(int r=2;r<16;++r)sacc+=pB0[r]; _Pragma("unroll") for(int r=0;r<16;++r)sacc+=pB1[r]; l_reg+=sacc;
    pw0=(u32x4){PKW(pB0,0),PKW(pB0,2),PKW(pB0,4),PKW(pB0,6)};pw1=(u32x4){PKW(pB0,8),PKW(pB0,10),PKW(pB0,12),PKW(pB0,14)};pw2=(u32x4){PKW(pB1,0),PKW(pB1,2),PKW(pB1,4),PKW(pB1,6)};pw3=(u32x4){PKW(pB1,8),PKW(pB1,10),PKW(pB1,12),PKW(pB1,14)};
    SBAR(); pv4(o,(int)(unsigned)(uintptr_t)vp0+vs_cur,PAF(0),PAF(1),PAF(2),PAF(3)); }
  #undef PKW
  #undef PAF
  #undef VFR
  #undef PIN
  #undef MX3
  #undef GAPA
  #undef GAPB
  #undef GAPB3
  #undef GAPB4
  #undef EX
  #undef VRD
  #undef VRH
  #undef STEP
  #undef ENDW
  {auto rr=__builtin_amdgcn_permlane32_swap(__float_as_uint(l_reg),__float_as_uint(l_reg),false,false);l_reg=__uint_as_float(rr[0])+__uint_as_float(rr[1]);}
  if(hi==0)wsf[32+r32]=l_reg;asm volatile("s_waitcnt lgkmcnt(0)":::"memory");
  float rli[16];
  #pragma unroll
  for(int r=0;r<16;++r)rli[r]=__builtin_amdgcn_rcpf(wsf[32+crow(r,hi)]);
  bf16*Ow=O+(rowbase+q0+wid*QBLK)*DM+oc;
  bf16*stg=(bf16*)(shm+A2_OST)+wid*2048;
  if(MODE==0){
    #pragma unroll
    for(int hf=0;hf<2;++hf){
      #pragma unroll
      for(int r=0;r<16;++r){const int orow=crow(r,hi);
        #pragma unroll
        for(int d0=0;d0<2;++d0)stg[orow*64+d0*32+r32]=__float2bfloat16(o[2*hf+d0][r]*rli[r]);}
      asm volatile("s_waitcnt lgkmcnt(0)":::"memory");
      #pragma unroll
      for(int i=0;i<4;++i){const int row=i*8+(lane>>3),ch=lane&7; const u32x4 v=*(const u32x4*)(stg+row*64+ch*8); ATTN_STORE16(Ow+(long)row*DM+hf*64+ch*8,v);}
      asm volatile("s_waitcnt lgkmcnt(0)":::"memory"); }
  } else {
    const bf16*O1w=Ow-128; bf16*Aw=(bf16*)((char*)O+A_OFF)+(rowbase+q0+wid*QBLK)*DM+(oc>>8)*128; const float*subln=(const float*)((const char*)O+SG_OFF); const float lam=subln[128];
    asm volatile("s_waitcnt vmcnt(0)":::"memory");
    float dv[2][4][8]; float ssq[4]={0.f,0.f,0.f,0.f};
    #pragma unroll
    for(int hf=0;hf<2;++hf){
      #pragma unroll
      for(int r=0;r<16;++r){const int orow=crow(r,hi);
        #pragma unroll
        for(int d0=0;d0<2;++d0)stg[orow*64+d0*32+r32]=__float2bfloat16(o[2*hf+d0][r]*rli[r]);}
      asm volatile("s_waitcnt lgkmcnt(0)":::"memory");
      #pragma unroll
      for(int i=0;i<4;++i){const int row=i*8+(lane>>3),ch=lane&7; const u32x4 v=*(const u32x4*)(stg+row*64+ch*8); const u32x4 a=*(const u32x4*)(O1w+(long)row*DM+hf*64+ch*8);
        #pragma unroll
        for(int j=0;j<4;++j){ const float d0_=__uint_as_float(a[j]<<16)-lam*__uint_as_float(v[j]<<16), d1_=__uint_as_float(a[j]&0xffff0000u)-lam*__uint_as_float(v[j]&0xffff0000u);
          dv[hf][i][2*j]=d0_; dv[hf][i][2*j+1]=d1_; ssq[i]+=d0_*d0_+d1_*d1_; } }
      asm volatile("s_waitcnt lgkmcnt(0)":::"memory"); }
    #pragma unroll
    for(int i=0;i<4;++i){ float q_=ssq[i]; q_+=__shfl_xor(q_,1); q_+=__shfl_xor(q_,2); q_+=__shfl_xor(q_,4); ssq[i]=1.0f/sqrtf(q_*(1.f/128.f)+1e-6f); }
    #pragma unroll
    for(int hf=0;hf<2;++hf){ const int ch=lane&7;
      const f32x4_t g0=*(const f32x4_t*)(subln+hf*64+ch*8), g1=*(const f32x4_t*)(subln+hf*64+ch*8+4);
      #pragma unroll
      for(int i=0;i<4;++i){const int row=i*8+(lane>>3); const float r_=ssq[i]; u32x4 w;
        w[0]=cvtpk_s(dv[hf][i][0]*r_*g0[0],dv[hf][i][1]*r_*g0[1]); w[1]=cvtpk_s(dv[hf][i][2]*r_*g0[2],dv[hf][i][3]*r_*g0[3]);
        w[2]=cvtpk_s(dv[hf][i][4]*r_*g1[0],dv[hf][i][5]*r_*g1[1]); w[3]=cvtpk_s(dv[hf][i][6]*r_*g1[2],dv[hf][i][7]*r_*g1[3]);
        ATTN_STORE16(Aw+(long)row*DM+hf*64+ch*8,w);} }
  }
  asm volatile("s_waitcnt lgkmcnt(0)\n\ts_barrier":::"memory");
  #undef DMA_K
  #undef DMA_V
  #undef CMASK
  #undef START
  #undef RESC
  #undef ROT
}
#undef SBAR
#undef WAIT_BAR
}

constexpr int NWAVES = 8;
constexpr int NB = 8, SEQ = 4096, DMODEL = 1024, NTOK = NB * SEQ;
constexpr int DINP = 2048, NEXP = 32, TOPK = 4, PLE = 256;
constexpr float EPS = 1e-6f;
constexpr int PMAXROWS = NTOK * TOPK + NEXP * 256;

constexpr size_t MiB = 1u << 20, KiB = 1u << 10;
constexpr size_t WS_CTL = 0, CTL_ZERO_BYTES = 192 * KiB;
constexpr size_t WS_SS = 64 * KiB;
constexpr size_t WS_TOKE = 192 * KiB, WS_TOKG = WS_TOKE + 512 * KiB, WS_TOKP = WS_TOKG + 512 * KiB;
constexpr size_t WS_WRS = 2304 * KiB;
constexpr size_t WS_SG = 2432 * KiB;
constexpr size_t WS_CS = 4 * MiB;
constexpr size_t WS_WGU = 6 * MiB;
constexpr size_t WS_WD = 70 * MiB;
constexpr size_t WS_WG = 102 * MiB;
constexpr size_t WS_WP = 104 * MiB;
constexpr size_t WS_XN = 105 * MiB;
constexpr size_t WS_R = 169 * MiB;
constexpr size_t WS_QK = WS_R, WS_VU = WS_R + 64 * MiB, WS_ACAT = WS_R + 128 * MiB, WS_O16 = WS_R + 192 * MiB, WS_WIN = WS_R + 256 * MiB, WS_WOUT = WS_R + 260 * MiB;
constexpr size_t WS_HDN = 137 * MiB;
constexpr size_t WS_Y = 273 * MiB;
constexpr size_t WS_XN3 = 137 * MiB, WS_PB = 432 * MiB, WS_ER = 448 * MiB;
constexpr size_t WS_END = WS_Y + 128 * MiB;
constexpr size_t WS_H2B = 169 * MiB;
constexpr size_t WS_TOP = 522 * MiB;
constexpr size_t WS_ELIST = 520 * MiB;
static_assert(WS_END <= WS_PB && WS_ER + 64 * MiB <= 560 * MiB && WS_WOUT + 2 * MiB <= WS_PB && WS_END <= 560 * MiB && WS_WOUT + 2 * MiB <= 560 * MiB && WS_HDN + (size_t)PMAXROWS * 1024 <= WS_Y, "d_ws map");
constexpr int CW_CNT = 0;
constexpr int CW_BAR = 1024;

constexpr int RING_OFF = 0, RING_BYTES = 131072;
constexpr int LDSCTL_OFF = RING_BYTES;
constexpr int TBL_OFF = LDSCTL_OFF + 512;
constexpr int TILE_E_OFF = LDSCTL_OFF + 1024;
constexpr int MAXU = 18;
constexpr int UROW_OFF = LDSCTL_OFF + 2048;
constexpr int UBIAS_OFF = UROW_OFF + MAXU * 512;
constexpr int LDS_BYTES = 163840;
static_assert(UBIAS_OFF + MAXU * 1024 <= LDS_BYTES, "LDS map");

#define GAS __attribute__((address_space(1)))
#define LAS __attribute__((address_space(3)))
typedef unsigned short bf16;
typedef unsigned v4u __attribute__((ext_vector_type(4)));
typedef unsigned v2u __attribute__((ext_vector_type(2)));
typedef float f32x4 __attribute__((ext_vector_type(4)));
typedef float f32x16 __attribute__((ext_vector_type(16)));
#define LDS_WAIT() asm volatile("s_waitcnt lgkmcnt(0)" ::: "memory")
#define VM_WAIT() asm volatile("s_waitcnt vmcnt(0)" ::: "memory")
__device__ __forceinline__ unsigned f2bf(float f) { unsigned u = __builtin_bit_cast(unsigned, f); return (u + 0x7fffu + ((u >> 16) & 1u)) >> 16; }
__device__ __forceinline__ unsigned pk2(float lo, float hi) { return f2bf(lo) | (f2bf(hi) << 16); }
__device__ __forceinline__ float bflo(unsigned w) { return __uint_as_float(w << 16); }
__device__ __forceinline__ float bfhi(unsigned w) { return __uint_as_float(w & 0xffff0000u); }
typedef float f32x2 __attribute__((ext_vector_type(2)));
__device__ __forceinline__ f32x4 fp8x4_to_f32(unsigned w) { const f32x2 lo = __builtin_amdgcn_cvt_pk_f32_fp8((int)w, false), hi = __builtin_amdgcn_cvt_pk_f32_fp8((int)w, true); return (f32x4){lo.x, lo.y, hi.x, hi.y}; }
__device__ __forceinline__ float wave_sum(float v) {
#pragma unroll
    for (int o = 1; o < 64; o <<= 1) v += __shfl_xor(v, o);
    return v;
}


#define XB_TMO      128
#define XB_XCNT(j)  (256  + 64 * (j))
#define XB_XSUB(j)  (1280 + 64 * (j))
#define XB_XGEN(j)  (2304 + 64 * (j))
#define XB_TOP      3328
#define XB_TOPGEN   3392
#define XCD_BAR_WORDS 3456
#define XB_SPIN_CAP (1u << 22)
__device__ __forceinline__ unsigned xb_ld(unsigned* p)              { return __hip_atomic_load(p, __ATOMIC_RELAXED, __HIP_MEMORY_SCOPE_AGENT); }
__device__ __forceinline__ unsigned xb_add(unsigned* p, unsigned v) { return __hip_atomic_fetch_add(p, v, __ATOMIC_RELAXED, __HIP_MEMORY_SCOPE_AGENT); }
__device__ __forceinline__ unsigned xb_xcc_id() { return (unsigned)__builtin_amdgcn_s_getreg((3 << 11) | 20) & 0xFu; }
#define XB_SPIN(cond, bar) do { unsigned _sp = 0; while (cond) { __builtin_amdgcn_s_sleep(1); \
    if ((++_sp & 255u) == 0u) { if (xb_ld(&(bar)[XB_TMO])) break; if (_sp > XB_SPIN_CAP) { atomicAdd(&(bar)[XB_TMO], 1u); break; } } } } while (0)
struct XcdBarrier { unsigned* bar; unsigned x; volatile LAS unsigned* st; };
__device__ __forceinline__ XcdBarrier xcd_barrier_post(unsigned* bar, volatile LAS unsigned* st) {
    XcdBarrier b; b.bar = bar; b.x = xb_xcc_id(); b.st = st;
    if (threadIdx.x == 0) (void)xb_add(&bar[XB_XCNT(b.x)], 1u);
    return b;
}
__device__ __forceinline__ void xcd_barrier_complete(unsigned* bar, unsigned x, unsigned& nloc, unsigned& nx) {
    const unsigned G = gridDim.x * gridDim.y * gridDim.z;
    unsigned sum, cnt, mine, sp = 0u;
    for (;;) {
        sum = 0u; cnt = 0u; mine = 0u;
#pragma unroll
        for (unsigned j = 0; j < 16; ++j) { const unsigned c = xb_ld(&bar[XB_XCNT(j)]); sum += c; cnt += (c > 0u) ? 1u : 0u; mine = (j == x) ? c : mine; }
        if (sum == G) break;
        __builtin_amdgcn_s_sleep(1);
        if ((++sp & 255u) == 0u) { if (xb_ld(&bar[XB_TMO])) break; if (sp > XB_SPIN_CAP) { atomicAdd(&bar[XB_TMO], 1u); break; } }
    }
    nloc = mine > 0u ? mine : 1u; nx = cnt > 0u ? cnt : 1u;
}
__device__ __forceinline__ void xcd_barrier(const XcdBarrier& b) {
    asm volatile("s_waitcnt vmcnt(0)" ::: "memory");
    __syncthreads();
    if (threadIdx.x == 0) {
        unsigned* bar = b.bar;
        __builtin_amdgcn_s_waitcnt(0);
        unsigned nloc = b.st[0], nx = b.st[1];
        if (nloc == 0u) { xcd_barrier_complete(bar, b.x, nloc, nx); b.st[0] = nloc; b.st[1] = nx; }
        const unsigned old = xb_add(&bar[XB_XSUB(b.x)], 1u);
        const unsigned gen = old / nloc;
        if (old + 1u == (gen + 1u) * nloc) {
            __builtin_amdgcn_fence(__ATOMIC_RELEASE, "agent");
            asm volatile("s_waitcnt vmcnt(0)" ::: "memory");
            const unsigned og = xb_add(&bar[XB_TOP], 1u);
            const unsigned tg = og / nx;
            if (og + 1u == (tg + 1u) * nx) xb_add(&bar[XB_TOPGEN], 1u);
            else XB_SPIN(xb_ld(&bar[XB_TOPGEN]) == tg, bar);
            __builtin_amdgcn_fence(__ATOMIC_ACQUIRE, "agent");
            xb_add(&bar[XB_XGEN(b.x)], 1u);
            asm volatile("s_waitcnt vmcnt(0)" ::: "memory");
        } else {
            XB_SPIN(xb_ld(&bar[XB_XGEN(b.x)]) == gen, bar);
            __builtin_amdgcn_fence(__ATOMIC_ACQUIRE, "agent");
            asm volatile("s_waitcnt vmcnt(0)" ::: "memory");
        }
    }
    __syncthreads();
}

struct Args { const float* in[28]; float* out; unsigned char* ws; };
enum { I_X = 0, I_P, I_POS, I_ATTN_NORM, I_WIN, I_QNORM, I_KNORM, I_LQ1, I_LK1, I_LQ2, I_LK2, I_SUBLN, I_WPOOL, I_PSCALE, I_WOUT, I_FFN_NORM, I_WROUTER, I_BROUTER,
       I_WGATE, I_BGATE, I_WUP, I_BUP, I_WDOWN, I_BDOWN, I_PLE_GNORM, I_WPLE_GATE, I_WPLE_PROJ, I_PLE_PNORM };

__device__ __forceinline__ void tr_load(const float* W, int ldw, int k0, int n0, LAS float* scr, int lane) {
    float t[32];
#pragma unroll
    for (int i = 0; i < 32; ++i) t[i] = __builtin_nontemporal_load(W + (size_t)(k0 + 2 * i + (lane >> 5)) * ldw + n0 + (lane & 31));
#pragma unroll
    for (int i = 0; i < 32; ++i) scr[(2 * i + (lane >> 5)) * 33 + (lane & 31)] = t[i];
    LDS_WAIT(); asm volatile("" ::: "memory");
}
__device__ __forceinline__ void tr_item(const float* W, int ldw, int k0, int n0, bf16* WT, int ldt, int drow0, int dcol0, LAS float* scr, int lane, bool permq = false) {
    tr_load(W, ldw, k0, n0, scr, lane);
    const int c = lane & 7;
#pragma unroll
    for (int j = 0; j < 4; ++j) { const int n = (lane >> 3) + 8 * j; const LAS float* s = scr + (8 * c) * 33 + n;
        v4u o; o.x = pk2(s[0 * 33], s[1 * 33]); o.y = pk2(s[2 * 33], s[3 * 33]); o.z = pk2(s[4 * 33], s[5 * 33]); o.w = pk2(s[6 * 33], s[7 * 33]);
        const int nd = (permq && n < 16) ? ((n & 3) | ((n & 4) << 1) | ((n & 8) >> 1)) : n;
        *(GAS v4u*)(WT + (size_t)(drow0 + nd) * ldt + dcol0 + k0 + 8 * c) = o; }
    LDS_WAIT(); asm volatile("" ::: "memory");
}
__device__ __forceinline__ void tr_item8(const float* W, int ldw, int k0, int n0, unsigned char* WT, int ldt, int drow0, float sc, LAS float* scr, int lane) {
    tr_load(W, ldw, k0, n0, scr, lane);
    const int c = lane & 7;
#pragma unroll
    for (int j = 0; j < 4; ++j) { const int n = (lane >> 3) + 8 * j; const LAS float* s = scr + (8 * c) * 33 + n;
        v2u o; o.x = pg8::pk4_fp8(s[0 * 33] * sc, s[1 * 33] * sc, s[2 * 33] * sc, s[3 * 33] * sc); o.y = pg8::pk4_fp8(s[4 * 33] * sc, s[5 * 33] * sc, s[6 * 33] * sc, s[7 * 33] * sc);
        *(GAS v2u*)(WT + (size_t)(drow0 + n) * ldt + k0 + 8 * c) = o; }
    LDS_WAIT(); asm volatile("" ::: "memory");
}

__device__ __forceinline__ void tr_quad8(const float* W, int ldw, int k0, int n0, unsigned char* WT, int ldt, int drow0, float sc, LAS float* scr, int lane) {
    f32x4 v[4][8];
    const int r = lane >> 3, c = lane & 7;
    const float* src = W + (size_t)(k0 + r) * ldw + n0 + 4 * c;
#pragma unroll
    for (int s = 0; s < 4; ++s)
#pragma unroll
        for (int m = 0; m < 8; ++m) v[s][m] = *(const GAS f32x4*)(src + (size_t)(8 * m) * ldw + 32 * s);
#ifdef DBL_LOADS
    { f32x4 w[4][8];
#pragma unroll
    for (int s = 0; s < 4; ++s)
#pragma unroll
        for (int m = 0; m < 8; ++m) w[s][m] = *(const GAS f32x4*)(src + (size_t)(8 * m + 64 * ((k0 >> 6) & 1 ? -1 : 1)) * ldw + 32 * s);
#pragma unroll
    for (int s = 0; s < 4; ++s)
#pragma unroll
        for (int m = 0; m < 8; ++m) asm volatile("" :: "v"(w[s][m])); }
#endif
#pragma unroll
    for (int s = 0; s < 4; ++s) {
#pragma unroll
        for (int m = 0; m < 8; ++m) *(LAS f32x4*)(scr + 4 * ((8 * m + r) * 8 + (c ^ m))) = v[s][m];
        LDS_WAIT(); asm volatile("" ::: "memory");
#pragma unroll
        for (int j = 0; j < 4; ++j) { const int n = r + 8 * j; const LAS float* p = scr + 256 * c + 4 * ((n >> 2) ^ c) + (n & 3);
            v2u o; o.x = pg8::pk4_fp8(p[0] * sc, p[32] * sc, p[64] * sc, p[96] * sc); o.y = pg8::pk4_fp8(p[128] * sc, p[160] * sc, p[192] * sc, p[224] * sc);
            *(GAS v2u*)(WT + (size_t)(drow0 + 32 * s + n) * ldt + k0 + 8 * c) = o;
#ifdef DBL_STORES
            *(GAS v2u*)(WT + (size_t)(drow0 + 32 * s + n) * ldt + k0 + 8 * c + (size_t)200 * 1024 * 1024) = o;
#endif
            }
        LDS_WAIT(); asm volatile("" ::: "memory");
    }
}

template<int W> __device__ __forceinline__ void pool_item(const bf16* VU, bf16* ACAT, int m0, int g, int lane) {
    const int sub = lane >> 4, mt = m0 + 16 * sub, t0 = mt & (SEQ - 1);
    const size_t off = (size_t)mt * 1024 + 512 + g * 128 + (lane & 15) * 8;
    const bf16* src = VU + off; bf16* dst = ACAT + off;
    v4u rows[W + 15];
#pragma unroll
    for (int k = 0; k < W - 1; ++k) { rows[k] = (v4u){0u, 0u, 0u, 0u}; if (t0 > 0) rows[k] = *(const GAS v4u*)(src + (long)(k - (W - 1)) * 1024); }
#pragma unroll
    for (int k = W - 1; k < W + 15; ++k) rows[k] = *(const GAS v4u*)(src + (long)(k - (W - 1)) * 1024);
    float S[8];
#pragma unroll
    for (int i = 0; i < 8; ++i) S[i] = 0.f;
#pragma unroll
    for (int k = 0; k < W - 1; ++k) { const v4u r = rows[k]; const float f[8] = {bflo(r.x), bfhi(r.x), bflo(r.y), bfhi(r.y), bflo(r.z), bfhi(r.z), bflo(r.w), bfhi(r.w)};
#pragma unroll
        for (int i = 0; i < 8; ++i) S[i] += f[i]; }
#pragma unroll
    for (int j = 0; j < 16; ++j) {
        const v4u r = rows[W - 1 + j]; const float f[8] = {bflo(r.x), bfhi(r.x), bflo(r.y), bfhi(r.y), bflo(r.z), bfhi(r.z), bflo(r.w), bfhi(r.w)};
        const int t = t0 + j, cnt = (t + 1 < W) ? t + 1 : W; const float ic = 1.0f / (float)cnt;
        float pz[8];
#pragma unroll
        for (int i = 0; i < 8; ++i) { S[i] += f[i]; pz[i] = S[i] * ic - f[i]; }
        v4u op; op.x = pk2(pz[0], pz[1]); op.y = pk2(pz[2], pz[3]); op.z = pk2(pz[4], pz[5]); op.w = pk2(pz[6], pz[7]);
        *(GAS v4u*)(dst + (size_t)j * 1024) = op;
        const v4u q = rows[j]; const float o[8] = {bflo(q.x), bfhi(q.x), bflo(q.y), bfhi(q.y), bflo(q.z), bfhi(q.z), bflo(q.w), bfhi(q.w)};
#pragma unroll
        for (int i = 0; i < 8; ++i) S[i] -= o[i];
    }
}

struct MoeOrder {
    const LAS int* tbl;
    const LAS unsigned char* te;
    int tile0, ntile, npn, G, vc; bool gu;
    __device__ __forceinline__ bool next(int i, pg8::Unit& u) const {
        const int U = i * G + vc; if (U >= ntile * npn) return false;
        const int tl = U / npn, pn = U - tl * npn, tau = gu ? tile0 + tl : tile0 + ntile - 1 - tl;
        const int e = (int)te[tau];
        const int tloc = tau - tbl[32 + e];
        u.e = e; u.pn = pn; u.tb = e * npn + pn; u.ord = i;
        if (gu) { u.ta = tau; u.pm = tau; u.nv = 256; }
        else { u.ta = tau; u.pm = tbl[65 + e] + tloc * 256; const int rem = tbl[e] - tloc * 256; u.nv = rem < 256 ? rem : 256; }
        return true;
    }
};

__global__ void __launch_bounds__(NWAVES * 64, 2) mk_fwd(Args args) {
    extern __shared__ __attribute__((aligned(16))) unsigned char lds[];
    cg::grid_group grid = cg::this_grid();
    LAS unsigned char* L = (LAS unsigned char*)lds;
    const int wave = __builtin_amdgcn_readfirstlane(threadIdx.x >> 6);
    const int G = gridDim.x;
    const int vcu = (G % 8 == 0) ? ((int)blockIdx.x % 8) * (G / 8) + (int)blockIdx.x / 8 : (int)blockIdx.x;
    const int gw = vcu * NWAVES + wave, NGW = G * NWAVES;
    unsigned char* ws = args.ws;
    unsigned* ctl = (unsigned*)(ws + WS_CTL);
    float* out = args.out;
    LAS int* tbl = (LAS int*)(L + TBL_OFF);
    LAS unsigned char* tile_e = (LAS unsigned char*)(L + TILE_E_OFF);
    volatile LAS unsigned* MISC = (volatile LAS unsigned*)(L + LDSCTL_OFF);
    if (threadIdx.x < 64) MISC[threadIdx.x] = 0u;
    __syncthreads();
    XcdBarrier xbar = xcd_barrier_post(ctl + CW_BAR, MISC + 8);
#define GRID_BAR() do { xcd_barrier(xbar); } while (0)

    grid.sync();
    {
        const int tid = pg8::tid_opaque(), lane = tid & 63;
        LAS float* scr = (LAS float*)(L + RING_OFF + wave * 16384);
        constexpr int IT_WIN = 16 * 64, IT_WOUT = 8 * 32, IT_WG = 512, IT_WP = 4 * 32;
        constexpr int NITEMS = IT_WIN + IT_WOUT + IT_WG + IT_WP;
        for (int it = gw; it < NITEMS; it += NGW) {
            int r = it;
            if (r < IT_WIN) { const int kb = r / 64, nb = r % 64; tr_item(args.in[I_WIN], DINP, 64 * kb, 32 * nb, (bf16*)(ws + WS_WIN), 1024, 32 * nb, 0, scr, lane, nb < 32 && !(nb & 1)); continue; } r -= IT_WIN;
            if (r < IT_WOUT) { const int kb = r / 32, nb = r % 32; tr_item(args.in[I_WOUT], 1024, 64 * kb, 32 * nb, (bf16*)(ws + WS_WOUT), 1024, 32 * nb, 0, scr, lane); continue; } r -= IT_WOUT;
            if (r < IT_WG) { const int kb = r / 32, nb = r % 32; tr_item8(args.in[I_WPLE_GATE], 1024, 64 * kb, 32 * nb, ws + WS_WG, 1024, 32 * nb, 32.0f, scr, lane); continue; } r -= IT_WG;
            { const int kb = r / 32, nb = r % 32; tr_item(args.in[I_WPLE_PROJ], 1024, 64 * kb, 32 * nb, (bf16*)(ws + WS_WP), 256, 32 * nb, 0, scr, lane); }
        }
#pragma unroll 1
        for (int pass = 0; pass < 2; ++pass) {
            if ((wave < NWAVES / 2) == (pass == 0)) {
                if (gw == 0) { float* SG = (float*)(ws + WS_SG); SG[lane] = args.in[I_SUBLN][lane] * 0.8f; SG[64 + lane] = args.in[I_SUBLN][64 + lane] * 0.8f;
                    const float s1 = wave_sum(args.in[I_LQ1][lane] * args.in[I_LK1][lane]), s2 = wave_sum(args.in[I_LQ2][lane] * args.in[I_LK2][lane]); if (lane == 0) SG[128] = expf(s1) - expf(s2) + 0.2f; }
                { const float* wr = args.in[I_WROUTER]; const float* fn = args.in[I_FFN_NORM]; bf16* WRh = (bf16*)(ws + WS_WRS); bf16* WRl = WRh + 32 * 1024;
                  for (int idx = blockIdx.x * 512 + tid; idx < 1024 * 32; idx += G * 512) {
                      const int j = idx & 7, e = (idx >> 3) & 31, hf_ = (idx >> 8) & 1, q = (idx >> 9) & 31, kh_ = idx >> 14, k = 512 * kh_ + 16 * q + 8 * hf_ + j; const float v = wr[k * 32 + e] * fn[k];
                      const unsigned h = f2bf(v); WRh[idx] = (bf16)h; WRl[idx] = (bf16)f2bf(v - __uint_as_float(h << 16)); } }
                { const int* pos = (const int*)args.in[I_POS]; float* cs = (float*)(ws + WS_CS);
                  for (int idx = blockIdx.x * 512 + tid; idx < NTOK * 8; idx += G * 512) {
                      const int t = idx >> 3, i = idx & 7;
                      const float fr = i == 0 ? 1.0f : i == 1 ? 0.1939227432012558f : i == 2 ? 0.03760603070259094f : i == 3 ? 0.007292664609849453f : i == 4 ? 0.0014142135623842478f :
                                       i == 5 ? 0.00027424818836152554f : i == 6 ? 5.318296098266728e-05f : 1.0313386155758053e-05f;
                      const float ang = (float)pos[t] * fr;
                      const double a = (double)ang, k = __builtin_rint(a * 0.15915494309189535), rr = a - k * 6.283185307179586;
                      const float rf = (float)rr;
                      cs[t * 16 + i] = __cosf(rf); cs[t * 16 + 8 + i] = __sinf(rf);
                  } }
            } else {
                { const float* p = args.in[I_P]; bf16* PB = (bf16*)(ws + WS_PB);
                  constexpr size_t N4 = (size_t)NTOK * PLE / 4; const size_t st = (size_t)G * 512;
                  for (size_t base = (size_t)blockIdx.x * 512 + tid; base < N4; base += 8 * st) {
                      f32x4 a[8];
#pragma unroll
                      for (int u = 0; u < 8; ++u) { const size_t idx = base + u * st; a[u] = *((const GAS f32x4*)p + (idx < N4 ? idx : base)); }
#pragma unroll
                      for (int u = 0; u < 8; ++u) { const size_t idx = base + u * st; if (idx < N4) { v2u w; w.x = pk2(a[u].x, a[u].y); w.y = pk2(a[u].z, a[u].w); *((GAS v2u*)PB + idx) = w; } }
                  } }
                { const float* x = args.in[I_X]; const float* gn = args.in[I_ATTN_NORM]; bf16* XN = (bf16*)(ws + WS_XN);
                  f32x4 gg[4];
#pragma unroll
                  for (int j = 0; j < 4; ++j) gg[j] = *((const GAS f32x4*)gn + lane + 64 * j);
                  for (int m0 = gw; m0 < NTOK; m0 += 4 * NGW) {
                      f32x4 v[4][4]; float s[4] = {0.f, 0.f, 0.f, 0.f};
#pragma unroll
                      for (int u = 0; u < 4; ++u) { const int m = (m0 + u * NGW < NTOK) ? m0 + u * NGW : m0; const GAS f32x4* xr = (const GAS f32x4*)(x + (size_t)m * 1024) + lane;
#pragma unroll
                          for (int j = 0; j < 4; ++j) v[u][j] = xr[64 * j]; }
#pragma unroll
                      for (int u = 0; u < 4; ++u) {
#pragma unroll
                          for (int j = 0; j < 4; ++j) s[u] += (v[u][j].x * v[u][j].x + v[u][j].y * v[u][j].y) + (v[u][j].z * v[u][j].z + v[u][j].w * v[u][j].w); }
#pragma unroll
                      for (int u = 0; u < 4; ++u) { const int m = m0 + u * NGW; if (m < NTOK) {
                          const float r = 1.0f / sqrtf(wave_sum(s[u]) * (1.f / 1024.f) + EPS);
                          GAS unsigned long long* o8 = (GAS unsigned long long*)(XN + (size_t)m * 1024) + lane;
#pragma unroll
                          for (int j = 0; j < 4; ++j) o8[64 * j] = (unsigned long long)pk2(v[u][j].x * r * gg[j].x, v[u][j].y * r * gg[j].y) | ((unsigned long long)pk2(v[u][j].z * r * gg[j].z, v[u][j].w * r * gg[j].w) << 32); } }
                  } }
            }
        }
    }
    GRID_BAR();


    {
        pg8::Gemm g{(const pg8::bf16_t*)(ws + WS_XN), (const pg8::bf16_t*)(ws + WS_WIN), 1024, nullptr}; pg8::StaticOrder S; S.init(NTOK, DINP, G, (int)blockIdx.x);
        pg8::EpiQKVU E{(pg8::bf16_t*)(ws + WS_QK), (pg8::bf16_t*)(ws + WS_VU), (const float*)(ws + WS_CS), args.in[I_QNORM], args.in[I_KNORM], attn_body::C2};
        pg8::gemm_phase<pg8::EpiQKVU, pg8::StaticOrder, false, true, false, true>(L + RING_OFF, g, S, E);
    }
    {
        pg8::Gemm g{(const pg8::bf16_t*)(ws + WS_PB), (const pg8::bf16_t*)(ws + WS_WP), 256, nullptr}; pg8::StaticOrder S; S.init(NTOK, 1024, G, (int)blockIdx.x);
        pg8::EpiF8SS E{ws + WS_ER, 1024, (float*)(ws + WS_SS)};
        pg8::gemm_phase<pg8::EpiF8SS, pg8::StaticOrder, false, true>(L + RING_OFF, g, S, E);
    }
    GRID_BAR();

    {
        const attn_body::bf16* Q = (const attn_body::bf16*)(ws + WS_QK); const attn_body::bf16* V = (const attn_body::bf16*)(ws + WS_VU); attn_body::bf16* O = (attn_body::bf16*)(ws + WS_O16);
        constexpr int NUNITS = NB * 8 * attn_body::NQB;
        const int per = (NUNITS + G - 1) / G;
        const int trslot = (vcu % 5 < per) ? vcu % 5 : per;
        for (int u = 0; u <= per; ++u) {
            if (u == trslot) {
                const int lane = pg8::tid_opaque() & 63;
                LAS float* scr = (LAS float*)(L + RING_OFF + wave * 16384);
                __syncthreads();
                {
                    const float* wpool = args.in[I_WPOOL]; const float* ps = args.in[I_PSCALE]; const float* wout = args.in[I_WOUT]; bf16* WT = (bf16*)(ws + WS_WOUT);
                    for (int tile = wave * G + vcu; tile < 16 * 32; tile += NWAVES * G) {
                        const int gc0 = (tile >> 5) * 32, n0 = (tile & 31) * 32, g = gc0 >> 7, hf = lane >> 5, li = lane & 31;
                        const float* ap = wpool + (size_t)(gc0 + li) * 128 + 64 * hf; const float* pp = ps + g * 128 + 64 * hf;
                        const float* bp = wout + (size_t)(512 + g * 128 + 64 * hf) * 1024 + n0 + li;
                        f32x16 acc = f32x16{};
                        for (int qh = 0; qh < 16; qh += 8) {
                            f32x4 a4[8], p4[8]; float bv[32];
#pragma unroll
                            for (int q = 0; q < 8; ++q) { a4[q] = *(const GAS f32x4*)(ap + 4 * (qh + q)); p4[q] = *(const GAS f32x4*)(pp + 4 * (qh + q)); }
#pragma unroll
                            for (int i = 0; i < 32; ++i) bv[i] = bp[(size_t)(4 * qh + i) * 1024];
#pragma unroll
                            for (int q = 0; q < 8; ++q) {
                                acc = __builtin_amdgcn_mfma_f32_32x32x2f32(a4[q].x * p4[q].x, bv[4 * q + 0], acc, 0, 0, 0);
                                acc = __builtin_amdgcn_mfma_f32_32x32x2f32(a4[q].y * p4[q].y, bv[4 * q + 1], acc, 0, 0, 0);
                                acc = __builtin_amdgcn_mfma_f32_32x32x2f32(a4[q].z * p4[q].z, bv[4 * q + 2], acc, 0, 0, 0);
                                acc = __builtin_amdgcn_mfma_f32_32x32x2f32(a4[q].w * p4[q].w, bv[4 * q + 3], acc, 0, 0, 0);
                            }
                        }
#pragma unroll
                        for (int r4 = 0; r4 < 4; ++r4) { v2u w; w.x = pk2(acc[4 * r4], acc[4 * r4 + 1]); w.y = pk2(acc[4 * r4 + 2], acc[4 * r4 + 3]);
                            *(GAS v2u*)(WT + (size_t)(n0 + li) * 1024 + 512 + gc0 + 8 * r4 + 4 * hf) = w; }
                    }
                }
                for (int item = gw; item < (NTOK / 64) * 4; item += NGW) {
                    const int g = item & 3, m0 = (item >> 2) * 64; const bf16* VUp = (const bf16*)(ws + WS_VU); bf16* AC = (bf16*)(ws + WS_ACAT);
                    if (g == 0) pool_item<2>(VUp, AC, m0, g, lane); else if (g == 1) pool_item<4>(VUp, AC, m0, g, lane); else if (g == 2) pool_item<8>(VUp, AC, m0, g, lane); else pool_item<16>(VUp, AC, m0, g, lane);
                }
                const bool bal = (G == 256 && per == 4);
                const int q5 = vcu / 5, r5 = vcu - 5 * q5;
                const int tq0 = bal ? 8 * (30 * q5 + (r5 == 0 ? 0 : r5 == 1 ? 6 : r5 == 2 ? 11 : r5 == 3 ? 16 : 23)) + wave : gw, tqs = bal ? 8 : NGW, tqn = bal ? (r5 == 0 ? 6 : r5 < 3 ? 5 : 7) : (NEXP * 3 * 128 + NGW - 1) / NGW;
                for (int jq = 0; jq < tqn; ++jq) { const int qi = tq0 + tqs * jq; if (qi >= NEXP * 3 * 128) break;
                    const int ng = qi & 7, kb = (qi >> 3) & 15, em = qi >> 7, e = em / 3, mat = em - 3 * e, n0 = 128 * ng;
                    if (mat == 2) tr_quad8(args.in[I_WDOWN] + (size_t)e * 1024 * 1024, 1024, 64 * kb, n0, ws + WS_WD, 1024, e * 1024 + n0, 32.0f, scr, lane);
                    else tr_quad8(args.in[mat == 0 ? I_WGATE : I_WUP] + (size_t)e * 1024 * 1024, 1024, 64 * kb, n0, ws + WS_WGU, 1024, e * 2048 + ng * 256 + mat * 128, 32.0f, scr, lane);
                }
                __syncthreads();
            }
            if (u == per) break;
            int bh, qb;
            if (G == 256) { bh = vcu >> 3; const int s = vcu & 7; qb = (u < 2) ? s : 15 - s; }
            else { const int P = (u >> 1) * G + vcu; if (P >= NUNITS / 2) continue; bh = P & 31; qb = 15 - (P >> 5); }
            const int hc = 2 * (bh & 3) + (u & 1);
            attn2::attn_unit<8, (long)WS_ACAT - (long)WS_O16, (long)WS_SG - (long)WS_O16>(bh >> 2, hc * 64, 512 + hc * 64, (hc >> 1) * 128, hc * 128, qb, Q, Q, V, O, (char*)lds + RING_OFF);
        }
    }
    GRID_BAR();

    {
        pg8::Gemm g{(const pg8::bf16_t*)(ws + WS_ACAT), (const pg8::bf16_t*)(ws + WS_WOUT), 1024, nullptr}; pg8::StaticOrder S; S.init(NTOK, 1024, G, (int)blockIdx.x);
        pg8::EpiResBf16 E{args.in[I_X], (pg8::bf16_t*)out};
        pg8::gemm_phase<pg8::EpiResBf16, pg8::StaticOrder, false, true>(L + RING_OFF, g, S, E);
    }
    GRID_BAR();

    {
        const int tid = pg8::tid_opaque(), lane = tid & 63;
        LAS float* r1s = (LAS float*)(L + RING_OFF);
        LAS int* cntl = (LAS int*)(L + RING_OFF + 512);
        LAS int* basel = (LAS int*)(L + RING_OFF + 640);
        LAS float* Pl = (LAS float*)(L + RING_OFF + 1024);
        const float* fn = args.in[I_FFN_NORM]; const bf16* WRh = (const bf16*)(ws + WS_WRS); const bf16* WRl = WRh + 32 * 1024; unsigned char* XN8 = ws + WS_XN; const bf16* H1B = (const bf16*)out;
        int* toke = (int*)(ws + WS_TOKE); float* tokg = (float*)(ws + WS_TOKG); int* tokp = (int*)(ws + WS_TOKP); unsigned short* elist = (unsigned short*)(ws + WS_ELIST);
        if (tid < 32) cntl[tid] = 0;
        __syncthreads();
        for (int chunk = blockIdx.x; chunk < NTOK / 128; chunk += G) {
            const int tok0 = chunk * 128;
            {   f32x4 gg[4];
#pragma unroll
                for (int q = 0; q < 4; ++q) gg[q] = *((const GAS f32x4*)fn + lane + 64 * q);
            for (int j0 = 0; j0 < 16; j0 += 8) {
                v2u rw[8][4];
#pragma unroll
                for (int u = 0; u < 8; ++u) { const GAS v2u* xr = (const GAS v2u*)(H1B + (size_t)(tok0 + wave * 16 + j0 + u) * 1024) + lane;
#pragma unroll
                    for (int q = 0; q < 4; ++q) rw[u][q] = xr[64 * q]; }
#pragma unroll
                for (int u = 0; u < 8; ++u) { const int m = tok0 + wave * 16 + j0 + u; float s = 0.f; f32x4 v[4];
#pragma unroll
                    for (int q = 0; q < 4; ++q) { const v2u w_ = rw[u][q]; v[q] = (f32x4){bflo(w_.x), bfhi(w_.x), bflo(w_.y), bfhi(w_.y)}; s += (v[q].x * v[q].x + v[q].y * v[q].y) + (v[q].z * v[q].z + v[q].w * v[q].w); }
                    const float r = 1.0f / sqrtf(wave_sum(s) * (1.f / 1024.f) + EPS);
                    GAS unsigned* o4 = (GAS unsigned*)(XN8 + (size_t)m * 1024) + lane;
#pragma unroll
                    for (int q = 0; q < 4; ++q) o4[64 * q] = pg8::pk4_fp8(v[q].x * r * gg[q].x, v[q].y * r * gg[q].y, v[q].z * r * gg[q].z, v[q].w * r * gg[q].w);
                    if (lane == 0) r1s[wave * 16 + j0 + u] = r; }
            } }
            {
                const int g = wave & 3, kh = wave >> 2, hf = lane >> 5, li = lane & 31;
                LAS unsigned char* tile = L + RING_OFF + 36864 + wave * 8704;
                const bf16* ablk = H1B + (size_t)(tok0 + 32 * g + (lane >> 4)) * 1024 + kh * 512 + 8 * (lane & 15);
                const bf16* bh = WRh + (size_t)(kh * 32) * 512 + lane * 8; const bf16* bl = WRl + (size_t)(kh * 32) * 512 + lane * 8;
                f32x16 acc = f32x16{};
                v4u R[8];
#pragma unroll
                for (int i = 0; i < 8; ++i) R[i] = *(const GAS v4u*)(ablk + (size_t)(4 * i) * 1024);
                for (int b = 0; b < 4; ++b) {
#pragma unroll
                    for (int i = 0; i < 8; ++i) *(LAS v4u*)(tile + (4 * i + (lane >> 4)) * 272 + 16 * (lane & 15)) = R[i];
                    pg8::bf16x8 wh[8], wl[8];
#pragma unroll
                    for (int s_ = 0; s_ < 8; ++s_) { wh[s_] = *(const GAS pg8::bf16x8*)(bh + (size_t)(8 * b + s_) * 512); wl[s_] = *(const GAS pg8::bf16x8*)(bl + (size_t)(8 * b + s_) * 512); }
                    if (b < 3) {
#pragma unroll
                        for (int i = 0; i < 8; ++i) R[i] = *(const GAS v4u*)(ablk + (size_t)(4 * i) * 1024 + 128 * (b + 1)); }
#pragma unroll
                    for (int s_ = 0; s_ < 8; ++s_) {
                        const pg8::bf16x8 ah = *(const LAS pg8::bf16x8*)(tile + li * 272 + 32 * s_ + 16 * hf);
                        acc = __builtin_amdgcn_mfma_f32_32x32x16_bf16(ah, wl[s_], acc, 0, 0, 0);
                        acc = __builtin_amdgcn_mfma_f32_32x32x16_bf16(ah, wh[s_], acc, 0, 0, 0);
                    }
                }
                LAS float* Pw = Pl + (size_t)((kh * 4 + g) * 32) * 33;
#pragma unroll
                for (int r = 0; r < 16; ++r) Pw[((r & 3) + 8 * (r >> 2) + 4 * hf) * 33 + li] = acc[r];
            }
            __syncthreads();
            int ek[4] = {0, 0, 0, 0}, rk[4] = {0, 0, 0, 0};
            if (tid < 128) {
                const int g = tid >> 5, i = tid & 31; const float r1 = r1s[tid];
                const LAS float* p0 = Pl + (size_t)((0 * 4 + g) * 32 + i) * 33; const LAS float* p1 = Pl + (size_t)((1 * 4 + g) * 32 + i) * 33;
                float v[32];
#pragma unroll
                for (int e = 0; e < 32; ++e) v[e] = (p0[e] + p1[e]) * r1 + args.in[I_BROUTER][e];
                float tv[4];
#pragma unroll
                for (int k = 0; k < 4; ++k) {
                    float best = v[0]; int bi = 0;
#pragma unroll
                    for (int e = 1; e < 32; ++e) { if (v[e] > best) { best = v[e]; bi = e; } }
                    tv[k] = best; ek[k] = bi;
#pragma unroll
                    for (int e = 0; e < 32; ++e) v[e] = (e == bi) ? -INFINITY : v[e];
                }
                const float e1 = expf(tv[1] - tv[0]), e2 = expf(tv[2] - tv[0]), e3 = expf(tv[3] - tv[0]); const float inv = 1.0f / (1.0f + e1 + e2 + e3);
                const float gt[4] = {inv, e1 * inv, e2 * inv, e3 * inv};
#pragma unroll
                for (int k = 0; k < 4; ++k) { rk[k] = atomicAdd((int*)(cntl + ek[k]), 1); toke[(size_t)(tok0 + tid) * 4 + k] = ek[k]; tokg[(size_t)(tok0 + tid) * 4 + k] = gt[k]; }
            }
            __syncthreads();
            if (tid < 32) { basel[tid] = atomicAdd((int*)ctl + CW_CNT + tid, cntl[tid]); cntl[tid] = 0; }
            __syncthreads();
            if (tid < 128) {
#pragma unroll
                for (int k = 0; k < 4; ++k) { const int rank = basel[ek[k]] + rk[k]; tokp[(size_t)(tok0 + tid) * 4 + k] = rank; elist[(size_t)ek[k] * NTOK + rank] = (unsigned short)(tok0 + tid); }
            }
            __syncthreads();
        }
    }
    GRID_BAR();

    {
        const int tid = pg8::tid_opaque();
        if (tid < NEXP) tbl[tid] = (int)__hip_atomic_load(ctl + CW_CNT + tid, __ATOMIC_RELAXED, __HIP_MEMORY_SCOPE_AGENT);
        __syncthreads();
        if (tid == 0) {
            int pt = 0, cr = 0;
            for (int e = 0; e < NEXP; ++e) { const int c = tbl[e]; tbl[32 + e] = pt; tbl[65 + e] = cr; pt += (c + 255) >> 8; cr += c; }
            tbl[64] = pt; tbl[97] = cr;
        }
        __syncthreads();
        for (int t = tid; t < 576; t += 512) { int e = 0;
            for (int j = 1; j < NEXP; ++j) e += (tbl[32 + j] <= t) ? 1 : 0;
            tile_e[t] = (unsigned char)e; }
        __syncthreads();
    }


    {
        const int T = tbl[64];
        LAS unsigned short* urow = (LAS unsigned short*)(L + UROW_OFF); LAS float* ubias = (LAS float*)(L + UBIAS_OFF);
        {
            MoeOrder S{tbl, tile_e, 0, T, 8, G, vcu, true};
            {
                const int tid = pg8::tid_opaque(); pg8::Unit u; const unsigned short* elist = (const unsigned short*)(ws + WS_ELIST);
                unsigned short rv[MAXU]; float bv[MAXU]; bool ok = true; int nu = 0;
#pragma unroll
                for (int i = 0; i < MAXU; ++i) { rv[i] = 0; bv[i] = 0.f; ok = ok && S.next(i, u);
                    if (ok) { nu = i + 1;
                        if (tid < 256) { const int r = (u.ta - tbl[32 + u.e]) * 256 + tid; if (r < tbl[u.e]) rv[i] = elist[(size_t)u.e * NTOK + r]; }
                        else { const int j = tid - 256; bv[i] = (j < 128 ? args.in[I_BGATE] : args.in[I_BUP])[u.e * 1024 + u.pn * 128 + (j & 127)]; } } }
#pragma unroll
                for (int i = 0; i < MAXU; ++i) if (i < nu) { if (tid < 256) urow[i * 256 + tid] = rv[i]; else ubias[i * 256 + tid - 256] = bv[i]; }
                __syncthreads();
            }
            pg8::Gemm g{(const pg8::bf16_t*)(ws + WS_XN), (const pg8::bf16_t*)(ws + WS_WGU), 512, urow};
            pg8::EpiSwiglu E{ws + WS_HDN, ubias};
            pg8::gemm_phase<pg8::EpiSwiglu, MoeOrder, true, true, true>(L + RING_OFF, g, S, E);
        }
        GRID_BAR();
        {
            MoeOrder S{tbl, tile_e, 0, T, 4, G, vcu, false};
            {   const int tid = pg8::tid_opaque(); pg8::Unit u;
                float bv[MAXU]; bool ok = true; int nu = 0;
#pragma unroll
                for (int i = 0; i < MAXU; ++i) { bv[i] = 0.f; ok = ok && S.next(i, u); if (ok) { nu = i + 1; if (tid < 256) bv[i] = args.in[I_BDOWN][u.e * 1024 + u.pn * 256 + tid]; } }
#pragma unroll
                for (int i = 0; i < MAXU; ++i) if (i < nu && tid < 256) ubias[i * 256 + tid] = bv[i];
                __syncthreads();
            }
            pg8::Gemm g{(const pg8::bf16_t*)(ws + WS_HDN), (const pg8::bf16_t*)(ws + WS_WD), 512, nullptr};
            pg8::EpiDown E{ws + WS_Y, ubias};
            pg8::gemm_phase<pg8::EpiDown, MoeOrder, false, true, true>(L + RING_OFF, g, S, E);
        }
        GRID_BAR();
    }

    {
        const int tid = pg8::tid_opaque(), lane = tid & 63;
        const int* toke = (const int*)(ws + WS_TOKE); const float* tokg = (const float*)(ws + WS_TOKG); const int* tokp = (const int*)(ws + WS_TOKP);
        const unsigned char* Y = ws + WS_Y; unsigned char* XN = ws + WS_XN3; const bf16* H1B = (const bf16*)out; bf16* H2B = (bf16*)(ws + WS_H2B); const float* gn = args.in[I_PLE_GNORM];
        f32x4 gg[4];
#pragma unroll
        for (int j = 0; j < 4; ++j) gg[j] = *((const GAS f32x4*)gn + lane + 64 * j);
        for (int m0 = gw; m0 < NTOK; m0 += 2 * NGW) {
            int rowk[2][4]; float gk[2][4]; f32x4 v[2][4];
#pragma unroll
            for (int u = 0; u < 2; ++u) { const int m = (m0 + u * NGW < NTOK) ? m0 + u * NGW : m0;
#pragma unroll
                for (int k = 0; k < 4; ++k) { const int e = toke[(size_t)m * 4 + k]; gk[u][k] = tokg[(size_t)m * 4 + k]; rowk[u][k] = tbl[65 + e] + tokp[(size_t)m * 4 + k]; }
                const GAS v2u* xr = (const GAS v2u*)(H1B + (size_t)m * 1024) + lane;
#pragma unroll
                for (int j = 0; j < 4; ++j) { const v2u w_ = xr[64 * j]; v[u][j] = (f32x4){bflo(w_.x), bfhi(w_.x), bflo(w_.y), bfhi(w_.y)}; } }
#pragma unroll
            for (int u = 0; u < 2; ++u)
#pragma unroll
                for (int k = 0; k < 4; ++k) { const GAS unsigned* yr = (const GAS unsigned*)(Y + (size_t)rowk[u][k] * 1024) + lane; const float g_ = gk[u][k];
#pragma unroll
                    for (int j = 0; j < 4; ++j) { const f32x4 y4 = fp8x4_to_f32(yr[64 * j]); v[u][j] += y4 * g_; } }
#pragma unroll
            for (int u = 0; u < 2; ++u) { const int m = m0 + u * NGW; if (m < NTOK) {
                GAS v2u* xw = (GAS v2u*)(H2B + (size_t)m * 1024) + lane; float s = 0.f;
#pragma unroll
                for (int j = 0; j < 4; ++j) { v2u w_; w_.x = pk2(v[u][j].x, v[u][j].y); w_.y = pk2(v[u][j].z, v[u][j].w); xw[64 * j] = w_; s += (v[u][j].x * v[u][j].x + v[u][j].y * v[u][j].y) + (v[u][j].z * v[u][j].z + v[u][j].w * v[u][j].w); }
                const float r = 1.0f / sqrtf(wave_sum(s) * (1.f / 1024.f) + EPS);
                GAS unsigned* o4 = (GAS unsigned*)(XN + (size_t)m * 1024) + lane;
#pragma unroll
                for (int j = 0; j < 4; ++j) o4[64 * j] = pg8::pk4_fp8(v[u][j].x * r * gg[j].x, v[u][j].y * r * gg[j].y, v[u][j].z * r * gg[j].z, v[u][j].w * r * gg[j].w); } }
        }
    }
    GRID_BAR();

    {
        pg8::Gemm g{(const pg8::bf16_t*)(ws + WS_XN3), (const pg8::bf16_t*)(ws + WS_WG), 512, nullptr}; pg8::StaticOrder S; S.init(NTOK, 1024, G, (int)blockIdx.x);
        pg8::EpiFinal E{out, (const pg8::bf16_t*)(ws + WS_H2B), (const unsigned char*)(ws + WS_ER), (const float*)(ws + WS_SS), args.in[I_PLE_PNORM]};
        pg8::gemm_phase<pg8::EpiFinal, pg8::StaticOrder, false, true, true>(L + RING_OFF, g, S, E);
    }
}

extern "C" void kernel_launch(void* const* d_in, const int* in_sizes, int n_in, void* d_out, int out_size, void* d_ws, size_t ws_size, hipStream_t stream) {
    static int grid = 0;
    if (grid == 0) {
        if (n_in != 28 || in_sizes[0] != NTOK * DMODEL || out_size != NTOK * DMODEL || ws_size < WS_TOP) { fprintf(stderr, "kernel_launch: unexpected shapes (n_in %d, ws %zu)\n", n_in, ws_size); grid = -1; return; }
        int dev = 0, cus = 0, per_cu = 0;
        (void)hipGetDevice(&dev); (void)hipDeviceGetAttribute(&cus, hipDeviceAttributeMultiprocessorCount, dev);
        (void)hipFuncSetAttribute((const void*)mk_fwd, hipFuncAttributeMaxDynamicSharedMemorySize, LDS_BYTES);
        if (hipOccupancyMaxActiveBlocksPerMultiprocessor(&per_cu, (const void*)mk_fwd, NWAVES * 64, LDS_BYTES) != hipSuccess || per_cu < 1) per_cu = 1;
        (void)hipGetLastError();
        grid = cus * (per_cu > 1 ? 1 : per_cu);
    }
    if (grid < 0) return;
    (void)hipMemsetAsync((char*)d_ws + WS_CTL, 0, CTL_ZERO_BYTES, stream);
    Args a{};
    for (int i = 0; i < 28; ++i) a.in[i] = (const float*)d_in[i];
    a.out = (float*)d_out; a.ws = (unsigned char*)d_ws;
    void* kargs[] = {&a};
    hipError_t e = hipLaunchCooperativeKernel((const void*)mk_fwd, dim3(grid), dim3(NWAVES * 64), kargs, LDS_BYTES, stream);
    if (e != hipSuccess) fprintf(stderr, "cooperative launch failed: %s (grid %d)\n", hipGetErrorString(e), grid);
}
```
